# Optimizing an MI355X kernel written in HIP

```python
import math
import jax, jax.numpy as jnp
from jax import lax
import numpy as np


D_MODEL = 2048
BATCH = 2
SEQ = 4096
DEPTH = 1

GRID_W = 64
CTX_LEN = 256
CHUNK = 128
A_HEADS = 8
A_DIM = 128
A_WIDTH = A_HEADS * A_DIM
R_HEADS = 8
R_DK = 128
R_DV = 128
R_WIDTH = R_HEADS * R_DV
MIX_WIDTH = A_WIDTH + R_WIDTH
IN_COLS = 2 * A_WIDTH + 2 * R_HEADS * R_DK + 2 * R_WIDTH
SPLITS = [A_WIDTH, 2 * A_WIDTH, 2 * A_WIDTH + R_HEADS * R_DK, 2 * A_WIDTH + 2 * R_HEADS * R_DK,
          2 * A_WIDTH + 2 * R_HEADS * R_DK + R_WIDTH]
ROPE_BASE = 10000.0
N_EXPERTS = 64
TOP_K = 8
N_GROUPS = 8
TOPK_GROUPS = 4
EXPERT_HIDDEN = 512
SHARED_HIDDEN = 512
ROUTED_SCALE = 2.5
MOE_BLOCK = 128
EPS = 1e-6

kernel_name = 'hybrid_gmlp_retention_moe_dit'


def rmsnorm(x, g):
    x32 = x.astype(jnp.float32)
    y = x32 * lax.rsqrt(jnp.mean(x32 * x32, axis=-1, keepdims=True) + EPS)
    return y.astype(x.dtype) * g


def layernorm(x, g):
    x32 = x.astype(jnp.float32)
    mu = jnp.mean(x32, axis=-1, keepdims=True)
    var = jnp.mean(jnp.square(x32 - mu), axis=-1, keepdims=True)
    return ((x32 - mu) * lax.rsqrt(var + EPS)).astype(x.dtype) * g


def head_groupnorm(o, g):
    B_, T, H, dv = o.shape
    o32 = o.astype(jnp.float32)
    mu = jnp.mean(o32, axis=-1, keepdims=True)
    var = jnp.mean(jnp.square(o32 - mu), axis=-1, keepdims=True)
    y = (o32 - mu) * lax.rsqrt(var + EPS)
    return y.reshape(B_, T, H * dv).astype(o.dtype) * g


def modulate(h, shift, scale):
    return h * (1.0 + scale) + shift


def apply_rope(x, cos, sin):
    half = x.shape[-1] // 2
    x1, x2 = x[..., :half], x[..., half:]
    return jnp.concatenate([x1 * cos - x2 * sin, x1 * sin + x2 * cos], axis=-1).astype(x.dtype)


def chunk_mlp(u, v, ln_g, w_s, b_s):
    B_, T, _ = u.shape
    nc = T // CHUNK
    u = jax.nn.gelu(u)
    v = layernorm(jax.nn.gelu(v), ln_g)
    v = v.reshape(B_, nc, CHUNK, A_HEADS, A_DIM)
    s = jnp.einsum('hpq,bcqhd->bcphd', w_s, v) + b_s.T[None, None, :, :, None]
    return u * s.reshape(B_, T, A_WIDTH)


def retention_scan(q, k, v, log_gamma, s0):
    B_, T, H, dk = q.shape
    dv = v.shape[-1]
    nc = T // CHUNK
    f32 = jnp.float32
    qc = q.astype(f32).reshape(B_, nc, CHUNK, H, dk).transpose(1, 0, 3, 2, 4)
    kc = k.astype(f32).reshape(B_, nc, CHUNK, H, dk).transpose(1, 0, 3, 2, 4)
    vc = v.astype(f32).reshape(B_, nc, CHUNK, H, dv).transpose(1, 0, 3, 2, 4)
    lg = log_gamma.astype(f32)[:, None]
    pos = jnp.arange(CHUNK, dtype=f32)
    diff = pos[:, None] - pos[None, :]
    d_in = jnp.where(diff[None] >= 0, jnp.exp(lg[:, :, None] * jnp.maximum(diff, 0.0)[None]), 0.0)
    q_decay = jnp.exp(lg * (pos + 1.0))
    k_decay = jnp.exp(lg * (CHUNK - 1.0 - pos))
    c_decay = jnp.exp(lg[:, 0] * CHUNK)

    def step(S, inp):
        qi, ki, vi = inp
        scores = jnp.einsum('bhnd,bhmd->bhnm', qi, ki) * d_in[None]
        inner = jnp.einsum('bhnm,bhmv->bhnv', scores, vi)
        cross = jnp.einsum('bhnd,bhdv->bhnv', qi, S) * q_decay[None, :, :, None]
        S_new = S * c_decay[None, :, None, None] + jnp.einsum('bhmd,bhmv->bhdv', ki * k_decay[None, :, :, None], vi)
        return S_new, inner + cross

    s_fin, out = lax.scan(step, s0.astype(f32), (qc, kc, vc))
    out = out.transpose(1, 0, 3, 2, 4).reshape(B_, T, H, dv).astype(v.dtype)
    return out, s_fin


def context_states(k, v, lg_f, lg_b):
    L = k.shape[1]
    f32 = jnp.float32
    pos = jnp.arange(L, dtype=f32)
    wf = jnp.exp(lg_f.astype(f32)[:, None] * (L - 1.0 - pos))
    wb = jnp.exp(lg_b.astype(f32)[:, None] * pos)
    k32, v32 = k.astype(f32), v.astype(f32)
    sf = jnp.einsum('hl,blhd,blhv->bhdv', wf, k32, v32)
    sb = jnp.einsum('hl,blhd,blhv->bhdv', wb, k32, v32)
    return sf, sb


def mix_tokens(p, s0_f, s0_b, rope, a_ln_g, a_ws, a_bs, a_out_g, lg_f, lg_b, gn_g, w_out):
    B_, T, _ = p.shape
    u, va, q, k, vr, gate = jnp.split(p, SPLITS, axis=-1)
    a = rmsnorm(chunk_mlp(u, va, a_ln_g, a_ws, a_bs), a_out_g)
    q = q.reshape(B_, T, R_HEADS, R_DK)
    k = k.reshape(B_, T, R_HEADS, R_DK)
    vr = vr.reshape(B_, T, R_HEADS, R_DV)
    if rope is not None:
        q = apply_rope(q, rope[0], rope[1])
        k = apply_rope(k, rope[0], rope[1])
    k = k * (R_DK ** -0.5)
    o_f, s_f = retention_scan(q, k, vr, lg_f, s0_f)
    o_b, s_b = retention_scan(q[:, ::-1], k[:, ::-1], vr[:, ::-1], lg_b, s0_b)
    o = o_f + o_b[:, ::-1]
    r = head_groupnorm(o, gn_g) * jax.nn.silu(gate)
    return jnp.concatenate([a, r], axis=-1) @ w_out, s_f, s_b


def moe(h, router_w, router_bias, w1, w3, w2, ws1, ws3, ws2):
    B_, T, D = h.shape
    xt = h.reshape(B_ * T, D)
    N = xt.shape[0]
    s = jax.nn.sigmoid((xt @ router_w).astype(jnp.float32))
    sel = s + router_bias.astype(jnp.float32)
    grp = sel.reshape(N, N_GROUPS, N_EXPERTS // N_GROUPS)
    grp_score = lax.top_k(grp, 2)[0].sum(-1)
    _, gidx = lax.top_k(grp_score, TOPK_GROUPS)
    gmask = jax.nn.one_hot(gidx, N_GROUPS, dtype=jnp.float32).sum(1)
    emask = jnp.repeat(gmask, N_EXPERTS // N_GROUPS, axis=1)
    _, eidx = lax.top_k(jnp.where(emask > 0, sel, -jnp.inf), TOP_K)
    w = jnp.take_along_axis(s, eidx, axis=-1)
    w = w / jnp.sum(w, axis=-1, keepdims=True) * ROUTED_SCALE
    NK = N * TOP_K
    e_flat = eidx.reshape(-1)
    tok_flat = jnp.repeat(jnp.arange(N, dtype=jnp.int32), TOP_K)
    w_flat = w.reshape(-1)
    order = jnp.argsort(e_flat)
    se, st, sw = e_flat[order], tok_flat[order], w_flat[order]
    counts = jnp.zeros((N_EXPERTS,), jnp.int32).at[e_flat].add(1)
    start = jnp.cumsum(counts) - counts
    padded = (counts + MOE_BLOCK - 1) // MOE_BLOCK * MOE_BLOCK
    pend = jnp.cumsum(padded)
    pstart = pend - padded
    dest = pstart[se] + (jnp.arange(NK, dtype=jnp.int32) - start[se])
    n_blocks = -(-NK // MOE_BLOCK) + N_EXPERTS
    P = n_blocks * MOE_BLOCK
    tok_buf = jnp.full((P,), N, jnp.int32).at[dest].set(st)
    w_buf = jnp.zeros((P,), jnp.float32).at[dest].set(sw)
    blk_expert = jnp.minimum(jnp.searchsorted(pend, jnp.arange(n_blocks, dtype=jnp.int32) * MOE_BLOCK, side='right'),
                             N_EXPERTS - 1)
    xpad = jnp.concatenate([xt, jnp.zeros((1, D), xt.dtype)], axis=0)

    def run_block(args):
        tok, ex = args
        xb = xpad[tok]
        hid = jax.nn.silu(xb @ w1[ex]) * (xb @ w3[ex])
        return hid @ w2[ex]

    yb = lax.map(run_block, (tok_buf.reshape(n_blocks, MOE_BLOCK), blk_expert))
    contrib = (yb.reshape(P, D) * w_buf[:, None]).astype(xt.dtype)
    routed = jnp.zeros((N + 1, D), xt.dtype).at[tok_buf].add(contrib)[:N]
    shared = (jax.nn.silu(xt @ ws1) * (xt @ ws3)) @ ws2
    return (routed + shared).reshape(B_, T, D)


def setup_inputs(seed: int = 0) -> dict:
    key = jax.random.key(seed)
    ks = jax.random.split(key, 32)
    f32 = jnp.float32
    D = D_MODEL
    nrm = lambda k, shape, scale: jax.random.normal(k, shape, f32) * scale
    base_lg = jnp.log(1.0 - 2.0 ** (-5.0 - jnp.arange(R_HEADS, dtype=f32)))
    return {
        'x': nrm(ks[0], (BATCH, SEQ, D), 1.0),
        'c': nrm(ks[1], (BATCH, D), 1.0),
        'ctx': nrm(ks[2], (BATCH, CTX_LEN, D), 1.0),
        'c_ctx': nrm(ks[3], (D,), 1.0),
        'w_mod': nrm(ks[4], (DEPTH, D, 6 * D), 0.5 * D ** -0.5),
        'b_mod': nrm(ks[5], (DEPTH, 6 * D), 0.02),
        'norm1_g': 1.0 + nrm(ks[6], (DEPTH, D), 0.02),
        'norm2_g': 1.0 + nrm(ks[7], (DEPTH, D), 0.02),
        'w_in': nrm(ks[8], (DEPTH, D, IN_COLS), D ** -0.5),
        'a_ln_g': 1.0 + nrm(ks[9], (DEPTH, A_WIDTH), 0.02),
        'a_ws': nrm(ks[10], (DEPTH, A_HEADS, CHUNK, CHUNK), CHUNK ** -0.5),
        'a_bs': 1.0 + nrm(ks[11], (DEPTH, A_HEADS, CHUNK), 0.02),
        'a_out_g': 1.0 + nrm(ks[12], (DEPTH, A_WIDTH), 0.02),
        'ret_log_decay_f': base_lg[None] * (1.0 + nrm(ks[13], (DEPTH, R_HEADS), 0.05)),
        'ret_log_decay_b': base_lg[None] * (1.0 + nrm(ks[14], (DEPTH, R_HEADS), 0.05)),
        'ret_gn_g': 1.0 + nrm(ks[15], (DEPTH, R_WIDTH), 0.02),
        'w_out': nrm(ks[16], (DEPTH, MIX_WIDTH, D), MIX_WIDTH ** -0.5),
        'router_w': nrm(ks[17], (DEPTH, D, N_EXPERTS), D ** -0.5),
        'router_bias': nrm(ks[18], (DEPTH, N_EXPERTS), 0.01),
        'exp_w1': nrm(ks[19], (DEPTH, N_EXPERTS, D, EXPERT_HIDDEN), D ** -0.5),
        'exp_w3': nrm(ks[20], (DEPTH, N_EXPERTS, D, EXPERT_HIDDEN), D ** -0.5),
        'exp_w2': nrm(ks[21], (DEPTH, N_EXPERTS, EXPERT_HIDDEN, D), EXPERT_HIDDEN ** -0.5),
        'sh_w1': nrm(ks[22], (DEPTH, D, SHARED_HIDDEN), D ** -0.5),
        'sh_w3': nrm(ks[23], (DEPTH, D, SHARED_HIDDEN), D ** -0.5),
        'sh_w2': nrm(ks[24], (DEPTH, SHARED_HIDDEN, D), SHARED_HIDDEN ** -0.5),
        'final_g': 1.0 + nrm(ks[25], (D,), 0.02),
    }


def reference(x, c, ctx, c_ctx, w_mod, b_mod, norm1_g, norm2_g, w_in, a_ln_g, a_ws, a_bs, a_out_g,
              ret_log_decay_f, ret_log_decay_b, ret_gn_g, w_out, router_w, router_bias,
              exp_w1, exp_w3, exp_w2, sh_w1, sh_w3, sh_w2, final_g):
    B_, T, D = x.shape
    ROWS = T // GRID_W
    row = jnp.repeat(jnp.arange(ROWS, dtype=jnp.float32), GRID_W)
    col = jnp.tile(jnp.arange(GRID_W, dtype=jnp.float32), ROWS)
    n_freq = R_DK // 4
    inv = ROPE_BASE ** (-jnp.arange(n_freq, dtype=jnp.float32) / n_freq)
    ang = jnp.concatenate([row[:, None] * inv, col[:, None] * inv], axis=-1)
    rope = (jnp.cos(ang)[None, :, None, :], jnp.sin(ang)[None, :, None, :])
    kv_lo, kv_hi = SPLITS[2], SPLITS[4]
    for l in range(DEPTH):
        last = l == DEPTH - 1
        mod_x = (jax.nn.silu(c) @ w_mod[l] + b_mod[l])[:, None, :]
        mod_c = (jax.nn.silu(c_ctx) @ w_mod[l] + b_mod[l])[None, None, :]
        sh1x, sc1x, g1x, sh2x, sc2x, g2x = jnp.split(mod_x, 6, axis=-1)
        sh1c, sc1c, g1c, sh2c, sc2c, g2c = jnp.split(mod_c, 6, axis=-1)
        mix_args = (a_ln_g[l], a_ws[l], a_bs[l], a_out_g[l], ret_log_decay_f[l], ret_log_decay_b[l],
                    ret_gn_g[l], w_out[l])
        hc = modulate(rmsnorm(ctx, norm1_g[l]), sh1c, sc1c)
        if last:
            pkv = hc @ w_in[l][:, kv_lo:kv_hi]
            kc_, vc_ = jnp.split(pkv, 2, axis=-1)
            kc_ = kc_.reshape(B_, CTX_LEN, R_HEADS, R_DK) * (R_DK ** -0.5)
            vc_ = vc_.reshape(B_, CTX_LEN, R_HEADS, R_DV)
            s0_f, s0_b = context_states(kc_, vc_, ret_log_decay_f[l], ret_log_decay_b[l])
        else:
            zero_s = jnp.zeros((B_, R_HEADS, R_DK, R_DV), jnp.float32)
            out_c, s0_f, s0_b = mix_tokens(hc @ w_in[l], zero_s, zero_s, None, *mix_args)
        hx = modulate(rmsnorm(x, norm1_g[l]), sh1x, sc1x)
        out_x, _, _ = mix_tokens(hx @ w_in[l], s0_f, s0_b, rope, *mix_args)
        x = x + g1x * out_x
        moe_args = (router_w[l], router_bias[l], exp_w1[l], exp_w3[l], exp_w2[l], sh_w1[l], sh_w3[l], sh_w2[l])
        hx2 = modulate(rmsnorm(x, norm2_g[l]), sh2x, sc2x)
        if last:
            x = x + g2x * moe(hx2, *moe_args)
        else:
            ctx = ctx + g1c * out_c
            hc2 = modulate(rmsnorm(ctx, norm2_g[l]), sh2c, sc2c)
            y = moe(jnp.concatenate([hc2, hx2], axis=1), *moe_args)
            ctx = ctx + g2c * y[:, :CTX_LEN]
            x = x + g2x * y[:, CTX_LEN:]
    return rmsnorm(x, final_g)
```

```cpp
#include <hip/hip_runtime.h>
#include <cstdio>
#include <cstdint>

#ifndef PROBE_DUP
#define PROBE_DUP 0
#endif
#ifndef MK_N_LAUNCHES
#define MK_N_LAUNCHES 1
#endif

#define LAS __attribute__((address_space(3)))
#define GAS __attribute__((address_space(1)))
typedef _Float16 f16;
typedef _Float16 f16x8 __attribute__((ext_vector_type(8)));
typedef _Float16 f16x4 __attribute__((ext_vector_type(4)));
typedef _Float16 f16x2 __attribute__((ext_vector_type(2)));
typedef float f32x4 __attribute__((ext_vector_type(4)));
typedef float f32x2 __attribute__((ext_vector_type(2)));
typedef unsigned u32x4 __attribute__((ext_vector_type(4)));
typedef unsigned u32x2 __attribute__((ext_vector_type(2)));
typedef GAS unsigned gu32;

constexpr int DM = 2048, NB = 2, SEQ = 4096, NTOK = NB * SEQ, CTXL = 256, NCTX = NB * CTXL, CHK = 128, NCH = SEQ / CHK;
constexpr int AW = 1024, INC = 6144, NH = 8, HD = 128;
constexpr int NE = 64, NE1 = 65, TOPK = 8, EH = 512, NSLOT = 9;
constexpr int NROWS_IN = NTOK + NCTX;
constexpr int MAXTILES = 360;
constexpr int MAXROWS = MAXTILES * 256;
constexpr float EPS = 1e-6f;
constexpr int NPHASE = 14;
constexpr int NWAVES = 8;

constexpr size_t MiB = 1u << 20;
constexpr size_t WS_CTL = 0, CTL_ZERO_BYTES = 1 * MiB;
constexpr size_t WS_MOD = 1 * MiB;
constexpr size_t WS_ROPE = WS_MOD + 256 * 1024;
constexpr size_t WS_VSTAT = 4 * MiB;
constexpr size_t WS_EIDX = WS_ROPE + 64 * 1024;
constexpr size_t WS_EW = WS_EIDX + 256 * 1024;
constexpr size_t WS_TILEE = WS_EW + 256 * 1024;
constexpr size_t WS_ROWTOK = 2 * MiB;
constexpr size_t WS_ROWDST = WS_ROWTOK + 512 * 1024;
constexpr size_t WS_ROWW = WS_ROWDST + 512 * 1024;
constexpr size_t WS_RWT = 5 * MiB;
constexpr size_t WS_CNT = 5 * MiB + 512 * 1024;
constexpr size_t WS_W13T = 8 * MiB;
constexpr size_t WS_W2T = WS_W13T + 260 * MiB;
constexpr size_t WS_WINT = WS_W2T + 130 * MiB;
constexpr size_t WS_WOUTT = WS_WINT + 24 * MiB;
constexpr size_t WS_X1 = WS_WOUTT + 8 * MiB;
constexpr size_t WS_HX2 = WS_X1 + 64 * MiB;
constexpr size_t WS_HID = WS_HX2 + 32 * MiB;
constexpr size_t WS_OVL = WS_HID + 90 * MiB;
static_assert(WS_OVL == 616 * MiB, "map");
constexpr size_t WS_HX = WS_OVL;
constexpr size_t WS_CBUF = WS_OVL + 34 * MiB;
constexpr size_t WS_ARAW = WS_CBUF;
constexpr size_t WS_PB = WS_CBUF + 32 * MiB;
constexpr size_t WS_AR = WS_CBUF + 64 * MiB;
constexpr size_t WS_OUTX = WS_CBUF + 96 * MiB;
constexpr size_t WS_PBUF = WS_OVL + 238 * MiB;
constexpr size_t WS_CK = WS_PBUF + 96 * MiB;
constexpr size_t WS_CV = WS_CK + 1 * MiB;
constexpr size_t WS_ST = WS_CV + 1 * MiB;
constexpr size_t WS_YS = WS_OVL;
constexpr size_t WS_END = 1024 * MiB;
static_assert(WS_ST + 70 * MiB <= WS_END && WS_YS + 288 * MiB <= WS_END && WS_OUTX + 64 * MiB <= WS_PBUF, "map");
constexpr int CW_BAR = 4096;

constexpr int RING_OFF = 0, RING_BYTES = 131072;
constexpr int LDS_BYTES = 147456;
constexpr int LDSCTL_OFF = LDS_BYTES - 1024, MISC_OFF = LDSCTL_OFF + 320;

#define RLX_AGENT __ATOMIC_RELAXED, __HIP_MEMORY_SCOPE_AGENT
#define LDS_WAIT() asm volatile("s_waitcnt lgkmcnt(0)" ::: "memory")
#define FENCE() do { asm volatile("" ::: "memory"); __builtin_amdgcn_sched_barrier(0); } while (0)
#define VM_WAIT() asm volatile("s_waitcnt vmcnt(0)" ::: "memory")

#define XB_TMO      128
#define XB_XCNT(j)  (256  + 64 * (j))
#define XB_XSUB(j)  (1280 + 64 * (j))
#define XB_XGEN(j)  (2304 + 64 * (j))
#define XB_TOP      3328
#define XB_TOPGEN   3392
#define XCD_BAR_WORDS 3456
#define XB_SPIN_CAP (1u << 18)
__device__ __forceinline__ unsigned xb_ld(unsigned* p)              { return __hip_atomic_load(p, __ATOMIC_RELAXED, __HIP_MEMORY_SCOPE_AGENT); }
__device__ __forceinline__ unsigned xb_add(unsigned* p, unsigned v) { return __hip_atomic_fetch_add(p, v, __ATOMIC_RELAXED, __HIP_MEMORY_SCOPE_AGENT); }
__device__ __forceinline__ unsigned xb_xcc_id() { return (unsigned)__builtin_amdgcn_s_getreg((3 << 11) | 20) & 0xFu; }
#define XB_SPIN(cond, bar) do { unsigned _sp = 0; while (cond) { __builtin_amdgcn_s_sleep(1); \
    if ((++_sp & 255u) == 0u) { if (xb_ld(&(bar)[XB_TMO])) break; if (_sp > XB_SPIN_CAP) { atomicAdd(&(bar)[XB_TMO], 1u); break; } } } } while (0)
struct XcdBarrier { unsigned* bar; volatile LAS unsigned* st; };
__device__ __forceinline__ void xcd_barrier_post(unsigned* bar) {
    if (threadIdx.x == 0) (void)xb_add(&bar[XB_XCNT(xb_xcc_id())], 1u);
}
__device__ __forceinline__ void xcd_barrier_complete(unsigned* bar, unsigned x, unsigned& nloc, unsigned& nx) {
    const unsigned G = gridDim.x * gridDim.y * gridDim.z;
    unsigned sum, cnt, mine, sp = 0u;
    for (;;) {
        sum = 0u; cnt = 0u; mine = 0u;
#pragma unroll
        for (unsigned j = 0; j < 16; ++j) { const unsigned c = xb_ld(&bar[XB_XCNT(j)]); sum += c; cnt += (c > 0u) ? 1u : 0u; mine = (j == x) ? c : mine; }
        if (sum == G) break;
        __builtin_amdgcn_s_sleep(1);
        if ((++sp & 255u) == 0u) { if (xb_ld(&bar[XB_TMO])) break; if (sp > XB_SPIN_CAP) { atomicAdd(&bar[XB_TMO], 1u); break; } }
    }
    nloc = mine > 0u ? mine : 1u; nx = cnt > 0u ? cnt : 1u;
}
__device__ __forceinline__ void xcd_barrier(const XcdBarrier& b) {
    asm volatile("s_waitcnt vmcnt(0)" ::: "memory");
    __syncthreads();
    if (threadIdx.x == 0) {
        unsigned* bar = b.bar; const unsigned bx = xb_xcc_id();
        __builtin_amdgcn_s_waitcnt(0);
        unsigned nloc = b.st[0], nx = b.st[1];
        if (nloc == 0u) { xcd_barrier_complete(bar, bx, nloc, nx); b.st[0] = nloc; b.st[1] = nx; }
        const unsigned old = xb_add(&bar[XB_XSUB(bx)], 1u);
        const unsigned gen = old / nloc;
        if (old + 1u == (gen + 1u) * nloc) {
            __builtin_amdgcn_fence(__ATOMIC_RELEASE, "agent");
            asm volatile("s_waitcnt vmcnt(0)" ::: "memory");
            const unsigned og = xb_add(&bar[XB_TOP], 1u);
            const unsigned tg = og / nx;
            if (og + 1u == (tg + 1u) * nx) xb_add(&bar[XB_TOPGEN], 1u);
            else XB_SPIN(xb_ld(&bar[XB_TOPGEN]) == tg, bar);
            __builtin_amdgcn_fence(__ATOMIC_ACQUIRE, "agent");
            xb_add(&bar[XB_XGEN(bx)], 1u);
            asm volatile("s_waitcnt vmcnt(0)" ::: "memory");
        } else {
            XB_SPIN(xb_ld(&bar[XB_XGEN(bx)]) == gen, bar);
            __builtin_amdgcn_fence(__ATOMIC_ACQUIRE, "agent");
            asm volatile("s_waitcnt vmcnt(0)" ::: "memory");
        }
    }
    __syncthreads();
}

namespace g8 {
constexpr int BM = 256, BK = 64, HALF = 128, HTB = HALF * BK * 2, STAGE_BYTES = 8 * HTB, NXCD = 8, WGM = 8;
__host__ __device__ __forceinline__ int lds_byte(int r, int c) { const int st = (r >> 4) * 2 + (c >> 5), rr = r & 15, cc = c & 31, ob = rr * 64 + cc * 2; return st * 1024 + (ob ^ (((ob >> 9) & 1) << 5)); }
__host__ __device__ __forceinline__ void stage_rc(int b, int& R, int& C) { const int st = b / 1024, sb = b % 1024, swz = sb ^ (((sb >> 9) & 1) << 5); R = (st >> 1) * 16 + swz / 64; C = (st & 1) * 32 + (swz % 64) / 2; }
__host__ __device__ __forceinline__ int perm32(int rho) { const int n = rho >> 4, i = rho & 15; return 8 * (i >> 2) + 4 * n + (i & 3); }

struct Unit { unsigned ao[2][2]; const char* B; int row0; int pn; int aux; int full; };

__device__ __forceinline__ bool dense_order(int L, int nM, int nN, int& pm, int& pn) {
    const int nwg = nM * nN; if (L >= nwg) return false;
    int wgid = L; { const int q = nwg / NXCD, r = nwg % NXCD, xcd = wgid % NXCD, off = wgid / NXCD; wgid = (xcd < r ? xcd * (q + 1) : r * (q + 1) + (xcd - r) * q) + off; }
    const int nig = WGM * nN, gid = wgid / nig, fm = gid * WGM, gsz = (nM - fm) < WGM ? (nM - fm) : WGM;
    pm = fm + ((wgid % nig) % gsz); pn = (wgid % nig) / gsz; return true;
}

template <class Epi, class Sched, bool ALIGN_EPI>
__device__ __forceinline__ void gemm_phase(LAS unsigned char* lds, const char* A, const int K, const Sched& S, const Epi& E) {
    int tid = threadIdx.x; asm volatile("" : "+v"(tid));
    const int wid = __builtin_amdgcn_readfirstlane(tid >> 6), lane = tid & 63, wr = wid >> 2, wc = wid & 3, fr = lane & 15, fq = lane >> 4;
    const int nt = K / BK;
    int R[2], C[2]; unsigned voffB[2];
#pragma unroll
    for (int i = 0; i < 2; ++i) { stage_rc(tid * 16 + i * 8192, R[i], C[i]); const int Rb = Epi::PERM ? ((R[i] & ~31) + perm32(R[i] & 31)) : R[i]; voffB[i] = (unsigned)(Rb * K + C[i]) * 2u; }
    const size_t kstep = (size_t)(BK * 2);
    const size_t hstep = (size_t)HALF * K * 2;
    const unsigned ldsw = (unsigned)wid * 1024u;
    const int aoff = lds_byte(wr * 64 + fr, fq * 8), boff = lds_byte(wc * 32 + fr, fq * 8);
#define G8_SA(b, h) (((b) * 2 + (h)) * HTB)
#define G8_SB(b, h) ((4 + (b) * 2 + (h)) * HTB)
#define G8_STAGE_B(bufoff, gbase) do { _Pragma("unroll") for (int _i = 0; _i < 2; ++_i) \
        __builtin_amdgcn_global_load_lds((const unsigned*)((const char*)(gbase) + voffB[_i]), (LAS unsigned*)(lds + (bufoff) + ldsw + _i * 8192), 16, 0, 0); } while (0)
#define G8_STAGE_A(bufoff, kb, o0, o1) do { \
        __builtin_amdgcn_global_load_lds((const unsigned*)(A + (size_t)(kb) + (o0)), (LAS unsigned*)(lds + (bufoff) + ldsw), 16, 0, 0); \
        __builtin_amdgcn_global_load_lds((const unsigned*)(A + (size_t)(kb) + (o1)), (LAS unsigned*)(lds + (bufoff) + ldsw + 8192), 16, 0, 0); } while (0)
#define G8_LDA(dst, b, h) do { _Pragma("unroll") for (int m = 0; m < 4; ++m) _Pragma("unroll") for (int k = 0; k < 2; ++k) dst[m][k] = *(const LAS f16x8*)(lds + G8_SA(b, h) + aoff + m * 2048 + k * 1024); } while (0)
#define G8_LDB(dst, b, h) do { _Pragma("unroll") for (int n = 0; n < 2; ++n) _Pragma("unroll") for (int k = 0; k < 2; ++k) dst[n][k] = *(const LAS f16x8*)(lds + G8_SB(b, h) + boff + n * 2048 + k * 1024); } while (0)
#define G8_MMA(ai, bj, At, Bt) do { __builtin_amdgcn_s_setprio(1); _Pragma("unroll") for (int m = 0; m < 4; ++m) _Pragma("unroll") for (int n = 0; n < 2; ++n) _Pragma("unroll") for (int k = 0; k < 2; ++k) \
        acc[ai][bj][m][n] = __builtin_amdgcn_mfma_f32_16x16x32_f16(Bt[n][k], At[m][k], acc[ai][bj][m][n], 0, 0, 0); __builtin_amdgcn_s_setprio(0); } while (0)
#define G8_WAIT_V(n) asm volatile("s_waitcnt vmcnt(" #n ")" ::: "memory")
#define G8_WAIT_L(n) asm volatile("s_waitcnt lgkmcnt(" #n ")" ::: "memory")
#define G8_BAR __builtin_amdgcn_s_barrier()
#define G8_SCHED __builtin_amdgcn_sched_barrier(0)
    Unit cur, nxt; int ui = 0;
    if (!S.next(0, cur, R, C)) return;
    f32x4 acc[2][2][4][2];
#pragma unroll
    for (int a = 0; a < 2; ++a)
#pragma unroll
        for (int b = 0; b < 2; ++b)
#pragma unroll
            for (int m = 0; m < 4; ++m)
#pragma unroll
                for (int n = 0; n < 2; ++n) acc[a][b][m][n] = (f32x4){0.f, 0.f, 0.f, 0.f};
    f16x8 At[4][2], B0[2][2], B1[2][2];
    {
        const char* cB = cur.B;
        G8_STAGE_B(G8_SB(0, 0), cB); G8_STAGE_B(G8_SB(0, 1), cB + hstep); G8_STAGE_A(G8_SA(0, 0), 0, cur.ao[0][0], cur.ao[0][1]); G8_STAGE_A(G8_SA(0, 1), 0, cur.ao[1][0], cur.ao[1][1]);
        if (wr == 1) G8_BAR;
        G8_WAIT_V(2); G8_BAR;
        G8_STAGE_B(G8_SB(1, 0), cB + kstep); G8_STAGE_A(G8_SA(1, 0), kstep, cur.ao[0][0], cur.ao[0][1]); G8_STAGE_B(G8_SB(1, 1), cB + hstep + kstep);
        G8_WAIT_V(6); G8_BAR;
    }
    for (;;) {
        const bool has_next = S.next(ui + 1, nxt, R, C);
        if (!has_next) nxt = cur;
        const char* cB = cur.B; const char* nB = nxt.B;
        for (int t = 0; t < nt; t += 2) {
            const bool last = (t == nt - 2);
            const size_t ka1 = (size_t)(t + 1) * kstep;
            const size_t ka2 = last ? 0 : (size_t)(t + 2) * kstep, ka3 = ka2 + kstep;
            const unsigned o00 = last ? nxt.ao[0][0] : cur.ao[0][0], o01 = last ? nxt.ao[0][1] : cur.ao[0][1], o10 = last ? nxt.ao[1][0] : cur.ao[1][0], o11 = last ? nxt.ao[1][1] : cur.ao[1][1];
            const char* b2 = last ? nB : cB + (size_t)(t + 2) * kstep; const char* b3 = b2 + kstep;
            G8_LDB(B0, 0, 0); G8_LDB(B1, 0, 1); G8_SCHED; G8_LDA(At, 0, 0); G8_STAGE_A(G8_SA(1, 1), ka1, cur.ao[1][0], cur.ao[1][1]);
            G8_WAIT_V(8); G8_WAIT_L(0); G8_BAR; G8_MMA(0, 0, At, B0); G8_MMA(0, 1, At, B1); G8_BAR; G8_SCHED;
            G8_LDA(At, 0, 1); G8_STAGE_B(G8_SB(0, 0), b2); G8_STAGE_B(G8_SB(0, 1), b2 + hstep); G8_STAGE_A(G8_SA(0, 0), ka2, o00, o01);
            G8_WAIT_V(8); G8_WAIT_L(0); G8_BAR; if (cur.full) { G8_MMA(1, 0, At, B0); G8_MMA(1, 1, At, B1); } G8_BAR; G8_SCHED;
            G8_LDB(B0, 1, 0); G8_LDB(B1, 1, 1); G8_SCHED; G8_LDA(At, 1, 0); G8_STAGE_A(G8_SA(0, 1), ka2, o10, o11);
            G8_WAIT_V(8); G8_WAIT_L(0); G8_BAR; G8_MMA(0, 0, At, B0); G8_MMA(0, 1, At, B1); G8_BAR; G8_SCHED;
            G8_LDA(At, 1, 1); G8_STAGE_B(G8_SB(1, 0), b3); G8_STAGE_B(G8_SB(1, 1), b3 + hstep); G8_STAGE_A(G8_SA(1, 0), ka3, o00, o01);
            G8_WAIT_V(8); G8_WAIT_L(0); G8_BAR; if (cur.full) { G8_MMA(1, 0, At, B0); G8_MMA(1, 1, At, B1); } G8_BAR; G8_SCHED;
        }
        if constexpr (ALIGN_EPI) { if (wr == 0) G8_BAR; }
        E(acc, cur, wr, wc, fr, fq);
        if (!has_next) break;
#pragma unroll
        for (int a = 0; a < 2; ++a)
#pragma unroll
            for (int b = 0; b < 2; ++b)
#pragma unroll
                for (int m = 0; m < 4; ++m)
#pragma unroll
                    for (int n = 0; n < 2; ++n) acc[a][b][m][n] = (f32x4){0.f, 0.f, 0.f, 0.f};
        cur = nxt; ++ui;
        if constexpr (ALIGN_EPI) { if (wr == 1) G8_BAR; }
    }
    G8_WAIT_V(0);
    if constexpr (!ALIGN_EPI) { if (wr == 0) G8_BAR; }
    G8_BAR;
#undef G8_SA
#undef G8_SB
#undef G8_STAGE_A
#undef G8_STAGE_B
#undef G8_LDA
#undef G8_LDB
#undef G8_MMA
#undef G8_WAIT_V
#undef G8_WAIT_L
#undef G8_BAR
#undef G8_SCHED
}

struct EpiF32 {
    static constexpr bool PERM = false;
    float* Cc; int ldc;
    __device__ __forceinline__ void operator()(const f32x4 (&acc)[2][2][4][2], const Unit& u, int wr, int wc, int fr, int fq) const {
        const int row0 = u.row0 + wr * 64 + fr, col0 = u.pn * BM + wc * 32 + 4 * fq;
#pragma unroll
        for (int ai = 0; ai < 2; ++ai)
#pragma unroll
            for (int m = 0; m < 4; ++m) { float* rowp = Cc + (size_t)(row0 + ai * HALF + m * 16) * ldc + col0;
#pragma unroll
                for (int bj = 0; bj < 2; ++bj)
#pragma unroll
                    for (int n = 0; n < 2; ++n) *(f32x4*)(rowp + bj * HALF + n * 16) = acc[ai][bj][m][n]; }
    }
};
}

struct ArgTable { LAS const unsigned* base;
    __device__ __forceinline__ const float* operator[](int i) const { const unsigned lo = base[2 * i], hi = base[2 * i + 1];
        const GAS float* g = (const GAS float*)(((unsigned long long)(unsigned)__builtin_amdgcn_readfirstlane(hi) << 32) | (unsigned)__builtin_amdgcn_readfirstlane(lo)); return (const float*)g; } };
struct Frame {
    LAS unsigned char* lds;
    int tid, lane, wave, vcu, G;
    ArgTable in;
    __device__ __forceinline__ float* out() const { return (float*)in[26]; }
    __device__ __forceinline__ unsigned char* ws() const { return (unsigned char*)in[27]; }
};
__device__ __forceinline__ float wave_sum(float v) {
#pragma unroll
    for (int o = 1; o < 64; o <<= 1) v += __shfl_xor(v, o);
    return v;
}
__device__ __forceinline__ float fast_sigmoid(float x) { return 1.0f / (1.0f + __expf(-x)); }
__device__ __forceinline__ float silu_f(float x) { return x * fast_sigmoid(x); }
__device__ __forceinline__ float gelu_f(float x) { const float y = 0.7978845608028654f * (x + 0.044715f * x * x * x); return x * fast_sigmoid(2.0f * y); }
__device__ __forceinline__ unsigned pkh(float a, float b) { f16x2 v; v.x = (f16)a; v.y = (f16)b; return __builtin_bit_cast(unsigned, v); }

struct TItem { const float* W; int ldw, k0, srccol0; f16* WT; int ldt, dstrow0; float scale; };
__device__ __forceinline__ void titem_load(const TItem& t, f32x4 (&tv)[8], int lane) {
    const float* base = t.W + (size_t)t.k0 * t.ldw + t.srccol0;
    const unsigned o0 = (unsigned)(2 * (lane >> 3)) * (unsigned)t.ldw + 4u * (unsigned)(lane & 7), st = 16u * (unsigned)t.ldw;
#pragma unroll
    for (int i = 0; i < 4; ++i) { tv[2 * i] = __builtin_nontemporal_load((const f32x4*)(base + (o0 + (unsigned)i * st))); tv[2 * i + 1] = __builtin_nontemporal_load((const f32x4*)(base + (o0 + (unsigned)i * st + (unsigned)t.ldw))); }
}
__device__ __forceinline__ void titem_store(const TItem& t, const f32x4 (&tv)[8], LAS float* scr, int lane) {
    LAS unsigned* T = (LAS unsigned*)scr; const int r = lane >> 3, n4 = 4 * (lane & 7); const float sc = t.scale;
#pragma unroll
    for (int i = 0; i < 4; ++i) { const f32x4 a = tv[2 * i] * sc, b = tv[2 * i + 1] * sc; LAS unsigned* p = T + n4 * 36 + r + 8 * i;
        p[0] = pkh(a.x, b.x); p[36] = pkh(a.y, b.y); p[72] = pkh(a.z, b.z); p[108] = pkh(a.w, b.w); }
    LDS_WAIT(); asm volatile("" ::: "memory");
    const int c = lane & 7; f16* ob = t.WT + (size_t)t.dstrow0 * t.ldt + t.k0;
    const unsigned oo = (unsigned)(lane >> 3) * (unsigned)t.ldt + 8u * (unsigned)c, ost = 8u * (unsigned)t.ldt;
#pragma unroll
    for (int j = 0; j < 4; ++j) { const u32x4 o = *(const LAS u32x4*)(T + ((lane >> 3) + 8 * j) * 36 + 4 * c);
        __builtin_nontemporal_store(o, (GAS u32x4*)(ob + (oo + (unsigned)j * ost))); }
    LDS_WAIT(); asm volatile("" ::: "memory");
}
__device__ __forceinline__ void transpose_item(const float* W, int ldw, int k0, int srccol0, f16* WT, int ldt, int dstrow0, float scale, LAS float* scr, int lane) {
    TItem t{W, ldw, k0, srccol0, WT, ldt, dstrow0, scale}; f32x4 tv[8]; titem_load(t, tv, lane); titem_store(t, tv, scr, lane);
}
__device__ __forceinline__ int win_srccol(int n0, float& scale) {
    const int t = n0 >> 8, c = n0 & 255; scale = 1.0f;
    if (t >= 8 && t < 16) {
        const int hl = 2 * (t & 3) + ((c & 127) >> 6), dim = (c & 63) + 64 * (c >> 7);
        if (t >= 12) scale = 0.08838834764831845f;
        return (t >= 12 ? 3072 : 2048) + hl * 128 + dim;
    }
    return n0;
}
__device__ __forceinline__ void p0_prologue(Frame& F) {
    LAS float* scr = (LAS float*)(F.lds + RING_OFF + F.wave * 16384);
    const int gw = F.vcu * NWAVES + F.wave, NGW = F.G * NWAVES;
    {
        LAS float* sc = (LAS float*)(F.lds + RING_OFF);
        LAS float* red = sc + 3 * 2048;
        const float* c = F.in[1]; const float* cc = F.in[3]; const float* wm = F.in[4]; const float* bm = F.in[5];
        for (int i = F.tid; i < 3 * 2048; i += 512) { const float v = i < 4096 ? c[i] : cc[i - 4096]; sc[i] = silu_f(v); }
        __syncthreads();
        for (int cb = F.vcu; cb < 256; cb += F.G) {
            const int col0 = cb * 48;
            const int r = F.lane / 12, c4 = F.lane % 12;
            f32x4 a0 = {0, 0, 0, 0}, a1 = {0, 0, 0, 0}, a2 = {0, 0, 0, 0};
            if (F.lane < 60) {
                for (int kb = F.wave * 5 + r; kb < 2048; kb += 320) {
                    f32x4 wv[8];
#pragma unroll
                    for (int j = 0; j < 8; ++j) { const int k = kb + 40 * j; wv[j] = (k < 2048) ? *(const f32x4*)(wm + (size_t)k * 12288 + col0 + 4 * c4) : (f32x4){0.f, 0.f, 0.f, 0.f}; }
#pragma unroll
                    for (int j = 0; j < 8; ++j) { const int k = (kb + 40 * j) & 2047; a0 += wv[j] * sc[k]; a1 += wv[j] * sc[2048 + k]; a2 += wv[j] * sc[4096 + k]; }
                }
                LAS float* rp = red + ((F.wave * 5 + r) * 3) * 48 + 4 * c4;
                *(LAS f32x4*)(rp) = a0; *(LAS f32x4*)(rp + 48) = a1; *(LAS f32x4*)(rp + 96) = a2;
            }
            __syncthreads();
            if (F.tid < 144) { float s = 0.f; for (int j = 0; j < 40; ++j) s += red[j * 144 + F.tid];
                const int v = F.tid / 48, cl = F.tid % 48; ((float*)(F.ws() + WS_MOD))[v * 12288 + col0 + cl] = s + bm[col0 + cl]; }
            __syncthreads();
        }
    }
    if (F.vcu == 0) { float* rope = (float*)(F.ws() + WS_ROPE);
        for (int i = F.tid; i < 2048; i += 512) { const int pos = i >> 5, j = i & 31; const float inv = powf(10000.0f, -(float)j / 32.0f); const float ang = (float)pos * inv;
            rope[i] = cosf(ang); rope[2048 + i] = sinf(ang); } }
    { const float* rw = F.in[17]; f16* rh = (f16*)(F.ws() + WS_RWT); f16* rl = rh + NE * DM;
      for (int idx = F.vcu * 512 + F.tid; idx < NE * DM; idx += F.G * 512) { const int k = idx >> 6, e = idx & 63; const float v = rw[idx]; const f16 hi = (f16)v; rh[e * DM + k] = hi; rl[e * DM + k] = (f16)((v - (float)hi) * 2048.0f); } }
    constexpr int I_IN = 32 * 192, I_OUT = 32 * 64;
    for (int it = gw; it < I_IN + I_OUT; it += NGW) {
        int r = it;
        if (r < I_IN) { const int kb = r / 192, nb = r % 192; float scale; const int src = win_srccol(nb * 32, scale);
            transpose_item(F.in[8], INC, kb * 64, src, (f16*)(F.ws() + WS_WINT), DM, nb * 32, scale, scr, F.lane); continue; }
        r -= I_IN;
        { const int kb = r / 64, nb = r % 64; transpose_item(F.in[16], DM, kb * 64, nb * 32, (f16*)(F.ws() + WS_WOUTT), DM, nb * 32, 1.0f, scr, F.lane); }
    }
}
__device__ __forceinline__ TItem expert_item(Frame& F, int it) {
    constexpr int I_E = 1536; const int e = it / I_E; int r = it % I_E; TItem t;
    if (r < 1024) {
        const int kb = r / 32, nb = r % 32, pn = nb >> 3, wi = nb & 7;
        t.W = (e < NE) ? ((wi < 4 ? F.in[19] : F.in[20]) + (size_t)e * DM * EH) : (wi < 4 ? F.in[22] : F.in[23]);
        t.ldw = EH; t.k0 = kb * 64; t.srccol0 = pn * 128 + (wi & 3) * 32; t.WT = (f16*)(F.ws() + WS_W13T) + (size_t)e * 1024 * DM; t.ldt = DM; t.dstrow0 = nb * 32; t.scale = 1.0f;
    } else {
        r -= 1024; const int kb = r / 64, nb = r % 64;
        t.W = (e < NE) ? (F.in[21] + (size_t)e * EH * DM) : F.in[24];
        t.ldw = DM; t.k0 = kb * 64; t.srccol0 = nb * 32; t.WT = (f16*)(F.ws() + WS_W2T) + (size_t)e * DM * EH; t.ldt = EH; t.dstrow0 = nb * 32; t.scale = 1.0f;
    }
    return t;
}
__device__ __forceinline__ void p2_expert_copies(Frame& F) {
    LAS float* scr = (LAS float*)(F.lds + RING_OFF + F.wave * 16384);
    constexpr int NIT = NE1 * 1536, N_CTXWG = 64, SH_CTX = 292, SH_REG = (NIT - N_CTXWG * SH_CTX) / 192, REM = (NIT - N_CTXWG * SH_CTX) % 192;
    int lo, n;
    if (F.vcu < N_CTXWG) { lo = F.vcu * SH_CTX; n = SH_CTX; }
    else { const int v = F.vcu - N_CTXWG; lo = N_CTXWG * SH_CTX + v * SH_REG + (v < REM ? v : REM); n = SH_REG + (v < REM ? 1 : 0); }
    const int hi = lo + n;
    TItem t0, t1, t2; f32x4 v0[8], v1[8], v2[8];
    int it = lo + F.wave;
    if (it < hi) { t0 = expert_item(F, it); titem_load(t0, v0, F.lane); }
    if (it + NWAVES < hi) { t1 = expert_item(F, it + NWAVES); titem_load(t1, v1, F.lane); }
    for (; it < hi; it += 3 * NWAVES) {
        if (it + 2 * NWAVES < hi) { t2 = expert_item(F, it + 2 * NWAVES); titem_load(t2, v2, F.lane); }
        titem_store(t0, v0, scr, F.lane);
        if (it + 3 * NWAVES < hi) { t0 = expert_item(F, it + 3 * NWAVES); titem_load(t0, v0, F.lane); }
        if (it + NWAVES < hi) titem_store(t1, v1, scr, F.lane);
        if (it + 4 * NWAVES < hi) { t1 = expert_item(F, it + 4 * NWAVES); titem_load(t1, v1, F.lane); }
        if (it + 2 * NWAVES < hi) titem_store(t2, v2, scr, F.lane);
    }
}

constexpr int IMG_LD = 136;
constexpr int IMG_BYTES = 128 * IMG_LD * 2;
__device__ __forceinline__ void wave_mma(f32x4 (&acc)[8], const f16x8 (&a)[4], const LAS f16* img, int fr, int fq) {
#pragma unroll
    for (int ks = 0; ks < 4; ++ks) { __builtin_amdgcn_sched_barrier(0);
#pragma unroll
        for (int t = 0; t < 8; ++t) { const f16x8 b = *(const LAS f16x8*)(img + (16 * t + fr) * IMG_LD + 32 * ks + 8 * fq); acc[t] = __builtin_amdgcn_mfma_f32_16x16x32_f16(b, a[ks], acc[t], 0, 0, 0); } }
    __builtin_amdgcn_sched_barrier(0);
}
__device__ __forceinline__ void zero8(f32x4 (&acc)[8]) {
#pragma unroll
    for (int t = 0; t < 8; ++t) acc[t] = (f32x4){0.f, 0.f, 0.f, 0.f};
}
__device__ __forceinline__ void stage_rows(LAS f16* img, const f16* src, int ld, int tid) {
#pragma unroll
    for (int it = 0; it < 4; ++it) { const int r = (tid >> 4) + 32 * it, cc = (tid & 15) * 8; *(LAS u32x4*)(img + r * IMG_LD + cc) = *(const u32x4*)(src + (size_t)r * ld + cc); }
}
__device__ __forceinline__ void stage_rows_f32(LAS f16* img, const float* src, int tid) {
#pragma unroll
    for (int it = 0; it < 8; ++it) { const int r = (tid >> 5) + 16 * it, cc = (tid & 31) * 4; const f32x4 v = *(const f32x4*)(src + (size_t)r * 128 + cc);
        u32x2 o; o.x = pkh(v.x, v.y); o.y = pkh(v.z, v.w); *(LAS u32x2*)(img + r * IMG_LD + cc) = o; }
}


__device__ __forceinline__ void p2_ctx_unit(Frame& F, int u) {
    const int rb = u >> 4, cb = u & 15, h = cb & 7; const bool isv = cb >= 8;
    const f16* HXc = (const f16*)(F.ws() + WS_HX) + (size_t)(NTOK + rb * 128) * DM; const f16* WT = (const f16*)(F.ws() + WS_WINT);
    LAS f16* imA = (LAS f16*)(F.lds); LAS f16* imB = (LAS f16*)(F.lds + IMG_BYTES);
    const int fr = F.lane & 15, fq = F.lane >> 4, w = F.wave;
    const int r0 = F.tid >> 4, cc = (F.tid & 15) * 8;
    const f16* ap[4]; const f16* bp[4];
#pragma unroll
    for (int it = 0; it < 4; ++it) { const int r = r0 + 32 * it; ap[it] = HXc + (size_t)r * DM + cc;
        const int brow = isv ? (4096 + h * 128 + r) : ((12 + (h >> 1)) * 256 + (r >> 6) * 128 + (h & 1) * 64 + (r & 63)); bp[it] = WT + (size_t)brow * DM + cc; }
    u32x4 aw[4], bw[4];
#pragma unroll
    for (int it = 0; it < 4; ++it) { aw[it] = *(const u32x4*)(ap[it]); bw[it] = *(const u32x4*)(bp[it]); }
    f32x4 acc[8]; zero8(acc);
    for (int kc = 0; kc < 16; ++kc) {
#pragma unroll
        for (int it = 0; it < 4; ++it) { const int r = r0 + 32 * it; *(LAS u32x4*)(imA + r * IMG_LD + cc) = aw[it]; *(LAS u32x4*)(imB + r * IMG_LD + cc) = bw[it]; }
        if (kc < 15) {
#pragma unroll
            for (int it = 0; it < 4; ++it) { aw[it] = *(const u32x4*)(ap[it] + (kc + 1) * 128); bw[it] = *(const u32x4*)(bp[it] + (kc + 1) * 128); } }
        __syncthreads();
        f16x8 a[4];
#pragma unroll
        for (int ks = 0; ks < 4; ++ks) a[ks] = *(const LAS f16x8*)(imA + (16 * w + fr) * IMG_LD + 32 * ks + 8 * fq);
        wave_mma(acc, a, imB, fr, fq);
        __syncthreads();
    }
    f16* dst = (f16*)(F.ws() + (isv ? WS_CV : WS_CK)) + (size_t)(rb * 128 + 16 * w + fr) * AW + h * 128;
#pragma unroll
    for (int t = 0; t < 8; ++t) { u32x2 o; o.x = pkh(acc[t].x, acc[t].y); o.y = pkh(acc[t].z, acc[t].w); *(u32x2*)(dst + 16 * t + 4 * fq) = o; }
}
__device__ __forceinline__ void p1_norm(Frame& F) {
    const int gw = F.vcu * NWAVES + F.wave, NGW = F.G * NWAVES;
    const float* g1 = F.in[6]; const float* xin = F.in[0]; const float* cin = F.in[2]; const float* modb = (const float*)(F.ws() + WS_MOD); f16* HX = (f16*)(F.ws() + WS_HX);
    f32x4 nx[8];
    { const int row = gw; const float* xr = row < NTOK ? xin + (size_t)row * DM : cin + (size_t)(row - NTOK) * DM;
#pragma unroll
      for (int j = 0; j < 8; ++j) nx[j] = *(const f32x4*)(xr + 4 * F.lane + 256 * j); }
    for (int row = gw; row < NROWS_IN; row += NGW) {
        f32x4 v[8]; float ss = 0.f;
#pragma unroll
        for (int j = 0; j < 8; ++j) { v[j] = nx[j]; ss += (v[j].x * v[j].x + v[j].y * v[j].y) + (v[j].z * v[j].z + v[j].w * v[j].w); }
        { const int r2 = row + NGW; if (r2 < NROWS_IN) { const float* xr = r2 < NTOK ? xin + (size_t)r2 * DM : cin + (size_t)(r2 - NTOK) * DM;
#pragma unroll
            for (int j = 0; j < 8; ++j) nx[j] = *(const f32x4*)(xr + 4 * F.lane + 256 * j); } }
        const float* mod = modb + (row < NTOK ? (row >> 12) : 2) * 12288;
        const float rstd = 1.0f / sqrtf(wave_sum(ss) * (1.0f / DM) + EPS);
        f16* orow = HX + (size_t)row * DM;
#pragma unroll
        for (int j = 0; j < 8; ++j) { const int col = 4 * F.lane + 256 * j;
            const f32x4 g = *(const f32x4*)(g1 + col), sh = *(const f32x4*)(mod + col), sc = *(const f32x4*)(mod + 2048 + col);
            const f32x4 h = (v[j] * rstd * g) * (sc + 1.0f) + sh;
            u32x2 o; o.x = pkh(h.x, h.y); o.y = pkh(h.z, h.w); *(u32x2*)(orow + col) = o; }
    }
}

struct InSched { int G, c; const char* Bt; int ulo, uhi;
    __device__ __forceinline__ bool next(int i, g8::Unit& u, const int (&R)[2], const int (&C)[2]) const {
        if (i + ulo >= uhi) return false; const int L = (i + ulo) * G + c; int pm, pn;
        if (!g8::dense_order(L, 32, 24, pm, pn)) return false;
#pragma unroll
        for (int h = 0; h < 2; ++h)
#pragma unroll
            for (int k = 0; k < 2; ++k) u.ao[h][k] = (unsigned)((pm * 256 + h * 128 + R[k]) * DM + C[k]) * 2u;
        u.B = Bt + (size_t)pn * 256 * DM * 2; u.row0 = pm * 256; u.pn = pn; u.aux = 0; u.full = 1;
        return true;
    }
};

struct EpiIn {
    static constexpr bool PERM = true;
    f16* PB; f16* CK; f16* CV; float* vstp; const float* rope;
    __device__ __forceinline__ void operator()(const f32x4 (&acc)[2][2][4][2], const g8::Unit& u, int wr, int wc, int fr, int fq) const {
        const int pn = u.pn, ty = pn >> 2; const bool ctx = u.row0 >= NTOK;
        const int c1 = wc * 32 + 8 * fq;
        if (ty == 2 || ty == 3) {
            const int head = 2 * (pn & 3) + (wc >> 1), i0 = c1 & 63, isq = (ty == 2);
            f16* dstb = ctx ? CK : (PB + (size_t)(isq ? 2 : 3) * NTOK * AW);
#pragma unroll
            for (int ai = 0; ai < 2; ++ai)
#pragma unroll
                for (int m = 0; m < 4; ++m) { const int row = u.row0 + ai * 128 + wr * 64 + m * 16 + fr;
                    const f32x4 a0 = acc[ai][0][m][0], a1 = acc[ai][0][m][1], b0 = acc[ai][1][m][0], b1 = acc[ai][1][m][1];
                    f32x4 c0 = {1.f, 1.f, 1.f, 1.f}, c1v = c0, s0 = {0.f, 0.f, 0.f, 0.f}, s1 = s0;
                    if (!ctx) { const int tpos = row & (SEQ - 1); const int pos = (wc & 1) ? (tpos & 63) : (tpos >> 6); const float* rp = rope + pos * 32 + (i0 & 31);
                        c0 = *(const f32x4*)(rp); c1v = *(const f32x4*)(rp + 4); s0 = *(const f32x4*)(rp + 2048); s1 = *(const f32x4*)(rp + 2052); }
                    const f32x4 o1a = a0 * c0 - b0 * s0, o1b = a1 * c1v - b1 * s1, o2a = a0 * s0 + b0 * c0, o2b = a1 * s1 + b1 * c1v;
                    const int drow = ctx ? row - NTOK : row;
                    f16* d = dstb + (size_t)drow * AW + head * 128 + i0;
                    u32x4 w1; w1.x = pkh(o1a[0], o1a[1]); w1.y = pkh(o1a[2], o1a[3]); w1.z = pkh(o1b[0], o1b[1]); w1.w = pkh(o1b[2], o1b[3]);
                    u32x4 w2; w2.x = pkh(o2a[0], o2a[1]); w2.y = pkh(o2a[2], o2a[3]); w2.z = pkh(o2b[0], o2b[1]); w2.w = pkh(o2b[2], o2b[3]);
                    *(u32x4*)d = w1; *(u32x4*)(d + 64) = w2; }
            return;
        }
        const int sel = (ty == 0) ? 0 : (ty == 1) ? 1 : (ty == 4) ? 4 : 5;
        f16* dstb = (ctx ? CV : PB + (size_t)sel * NTOK * AW) + (pn & 3) * 256 + c1;
#pragma unroll
        for (int ai = 0; ai < 2; ++ai)
#pragma unroll
            for (int m = 0; m < 4; ++m) { const int row = u.row0 + ai * 128 + wr * 64 + m * 16 + fr; const int drow = ctx ? row - NTOK : row;
                float s = 0.f, q = 0.f;
#pragma unroll
                for (int bj = 0; bj < 2; ++bj) { f32x4 v0 = acc[ai][bj][m][0], v1 = acc[ai][bj][m][1];
                    if (ty <= 1) {
#pragma unroll
                        for (int j = 0; j < 4; ++j) { v0[j] = gelu_f(v0[j]); v1[j] = gelu_f(v1[j]); } }
                    else if (ty == 5) {
#pragma unroll
                        for (int j = 0; j < 4; ++j) { v0[j] = silu_f(v0[j]); v1[j] = silu_f(v1[j]); } }
                    if (ty == 1) { s += (v0[0] + v0[1]) + (v0[2] + v0[3]) + (v1[0] + v1[1]) + (v1[2] + v1[3]);
                        q += (v0[0] * v0[0] + v0[1] * v0[1]) + (v0[2] * v0[2] + v0[3] * v0[3]) + (v1[0] * v1[0] + v1[1] * v1[1]) + (v1[2] * v1[2] + v1[3] * v1[3]); }
                    u32x4 o; o.x = pkh(v0[0], v0[1]); o.y = pkh(v0[2], v0[3]); o.z = pkh(v1[0], v1[1]); o.w = pkh(v1[2], v1[3]);
                    *(u32x4*)(dstb + (size_t)drow * AW + bj * 128) = o; }
                if (ty == 1) { s += __shfl_xor(s, 16); s += __shfl_xor(s, 32); q += __shfl_xor(q, 16); q += __shfl_xor(q, 32);
                    if (fq == 0) { f32x2 st; st.x = s; st.y = q; *(f32x2*)(vstp + ((size_t)row * 16 + (pn & 3) * 4 + wc) * 2) = st; } } }
    }
};
struct EpiX1 {
    static constexpr bool PERM = false;
    const float* x; const float* mod; float* X1;
    __device__ __forceinline__ void operator()(const f32x4 (&acc)[2][2][4][2], const g8::Unit& u, int wr, int wc, int fr, int fq) const {
        const int row0 = u.row0 + wr * 64 + fr, col0 = u.pn * 256 + wc * 32 + 4 * fq;
        const float* g1 = mod + (u.row0 >> 12) * 12288 + 2 * 2048;
        f32x4 gv[2][2];
#pragma unroll
        for (int bj = 0; bj < 2; ++bj)
#pragma unroll
            for (int n = 0; n < 2; ++n) gv[bj][n] = *(const f32x4*)(g1 + col0 + bj * 128 + n * 16);
#pragma unroll
        for (int ai = 0; ai < 2; ++ai)
#pragma unroll
            for (int m = 0; m < 4; ++m) { const size_t off = (size_t)(row0 + ai * 128 + m * 16) * DM + col0;
#pragma unroll
                for (int bj = 0; bj < 2; ++bj)
#pragma unroll
                    for (int n = 0; n < 2; ++n) { const f32x4 xv = *(const f32x4*)(x + off + bj * 128 + n * 16); *(f32x4*)(X1 + off + bj * 128 + n * 16) = xv + gv[bj][n] * acc[ai][bj][m][n]; }
                if (m & 1) asm volatile("" ::: "memory"); }
    }
};
__device__ __forceinline__ void p3_post(Frame& F) {
    const int gw = F.vcu * NWAVES + F.wave, NGW = F.G * NWAVES;
    const float* CB = (const float*)(F.ws() + WS_CBUF);
    f16* UG = (f16*)(F.ws() + WS_PBUF); f16* VG = UG + (size_t)NTOK * AW; f16* Qb = VG + (size_t)NTOK * AW; f16* Kb = Qb + (size_t)NTOK * AW; f16* VR = Kb + (size_t)NTOK * AW; f16* GS = VR + (size_t)NTOK * AW;
    f16* CK = (f16*)(F.ws() + WS_CK); f16* CV = (f16*)(F.ws() + WS_CV);
    const float* rope = (const float*)(F.ws() + WS_ROPE);
    float* vstat = (float*)(F.ws() + WS_VSTAT);
    for (int row = gw; row < NROWS_IN; row += NGW) {
        const float* cr = CB + (size_t)row * INC;
        if (row < NTOK) {
            float gv[16]; float s = 0.f;
#pragma unroll
            for (int j = 0; j < 4; ++j) { const int col = 256 * j + 4 * F.lane;
                const f32x4 u = *(const f32x4*)(cr + col); u32x2 o; o.x = pkh(gelu_f(u.x), gelu_f(u.y)); o.y = pkh(gelu_f(u.z), gelu_f(u.w)); *(u32x2*)(UG + (size_t)row * AW + col) = o;
                const f32x4 v = *(const f32x4*)(cr + 1024 + col); gv[4 * j] = gelu_f(v.x); gv[4 * j + 1] = gelu_f(v.y); gv[4 * j + 2] = gelu_f(v.z); gv[4 * j + 3] = gelu_f(v.w);
                s += (gv[4 * j] + gv[4 * j + 1]) + (gv[4 * j + 2] + gv[4 * j + 3]);
                u32x2 o2; o2.x = pkh(gv[4 * j], gv[4 * j + 1]); o2.y = pkh(gv[4 * j + 2], gv[4 * j + 3]); *(u32x2*)(VG + (size_t)row * AW + col) = o2;
                const f32x4 w = *(const f32x4*)(cr + 4096 + col); u32x2 o3; o3.x = pkh(w.x, w.y); o3.y = pkh(w.z, w.w); *(u32x2*)(VR + (size_t)row * AW + col) = o3;
                const f32x4 g = *(const f32x4*)(cr + 5120 + col); u32x2 o4; o4.x = pkh(silu_f(g.x), silu_f(g.y)); o4.y = pkh(silu_f(g.z), silu_f(g.w)); *(u32x2*)(GS + (size_t)row * AW + col) = o4; }
            const float mean = wave_sum(s) * (1.0f / AW); float q = 0.f;
#pragma unroll
            for (int j = 0; j < 16; ++j) { const float d = gv[j] - mean; q += d * d; }
            const float rstd = 1.0f / sqrtf(wave_sum(q) * (1.0f / AW) + EPS);
            if (F.lane == 0) { vstat[2 * row] = mean; vstat[2 * row + 1] = rstd; }
            const int tpos = row & (SEQ - 1), rpos = tpos >> 6, cpos = tpos & 63;
            for (int t = 8; t < 16; ++t) {
#pragma unroll
                for (int cc = 0; cc < 2; ++cc) { const int c = F.lane + 64 * cc;
                    const float x1 = cr[256 * t + c], x2 = cr[256 * t + 128 + c];
                    const int head = 2 * (t & 3) + (c >> 6), i = c & 63;
                    const int ri = (i < 32) ? (rpos * 32 + i) : (cpos * 32 + (i - 32));
                    const float cs = rope[ri], sn = rope[2048 + ri];
                    f16* dst = (t < 12 ? Qb : Kb) + (size_t)row * AW + head * 128 + i;
                    dst[0] = (f16)(x1 * cs - x2 * sn); dst[64] = (f16)(x1 * sn + x2 * cs); }
            }
        } else {
            const int rc = row - NTOK;
            for (int t = 12; t < 16; ++t) {
#pragma unroll
                for (int cc = 0; cc < 2; ++cc) { const int c = F.lane + 64 * cc; const float x1 = cr[256 * t + c], x2 = cr[256 * t + 128 + c];
                    const int head = 2 * (t & 3) + (c >> 6), i = c & 63; f16* dst = CK + (size_t)rc * AW + head * 128 + i; dst[0] = (f16)x1; dst[64] = (f16)x2; }
            }
#pragma unroll
            for (int j = 0; j < 4; ++j) { const int col = 256 * j + 4 * F.lane; const f32x4 w = *(const f32x4*)(cr + 4096 + col); u32x2 o3; o3.x = pkh(w.x, w.y); o3.y = pkh(w.z, w.w); *(u32x2*)(CV + (size_t)rc * AW + col) = o3; }
        }
    }
}

__device__ __forceinline__ size_t st_index(int dir, int bh, int slot) { return ((size_t)(dir * 16 + bh) * 33 + slot) * 16384; }
__device__ __forceinline__ void p4_naive(Frame& F) {
    const int gt = F.vcu * 512 + F.tid, NGT = F.G * 512;
    const f16* UG = (const f16*)(F.ws() + WS_PBUF); const f16* VG = UG + (size_t)NTOK * AW; const f16* Kb = VG + (size_t)2 * NTOK * AW; const f16* VR = Kb + (size_t)NTOK * AW;
    const f16* CK = (const f16*)(F.ws() + WS_CK); const f16* CV = (const f16*)(F.ws() + WS_CV);
    const float* vstat = (const float*)(F.ws() + WS_VSTAT);
    const float* alng = F.in[9]; const float* aws = F.in[10]; const float* abs_ = F.in[11];
    const float* lgf = F.in[13]; const float* lgb = F.in[14];
    float* ARAW = (float*)(F.ws() + WS_ARAW);
    float* ST = (float*)(F.ws() + WS_ST);
    for (int idx = gt; idx < NTOK * AW; idx += NGT) {
        const int t = idx >> 10, j = idx & 1023, h = j >> 7, p = t & 127, t0 = t - p;
        float s = abs_[h * 128 + p]; const float g = alng[j]; const float* wrow = aws + (size_t)(h * 128 + p) * 128;
        for (int q = 0; q < 128; ++q) { const float vn = ((float)VG[(size_t)(t0 + q) * AW + j] - vstat[2 * (t0 + q)]) * vstat[2 * (t0 + q) + 1] * g; s += wrow[q] * vn; }
        ARAW[idx] = (float)UG[idx] * s;
    }
    for (int idx = gt; idx < 2 * 16 * 16384; idx += NGT) {
        const int d = idx & 127, v = (idx >> 7) & 127, bh = (idx >> 14) & 15, dir = idx >> 18, b = bh >> 3, h = bh & 7;
        const float lg = dir ? lgb[h] : lgf[h]; float s = 0.f;
        for (int l = 0; l < CTXL; ++l) { const float w = __expf(lg * (dir ? (float)l : (float)(CTXL - 1 - l)));
            s += w * (float)CV[(size_t)(b * CTXL + l) * AW + h * 128 + v] * (float)CK[(size_t)(b * CTXL + l) * AW + h * 128 + d]; }
        ST[st_index(dir, bh, 0) + v * 128 + d] = s;
    }
    for (int idx = gt; idx < 2 * 16 * 32 * 16384; idx += NGT) {
        const int d = idx & 127, v = (idx >> 7) & 127, i = (idx >> 14) & 31, bh = (idx >> 19) & 15, dir = idx >> 23, b = bh >> 3, h = bh & 7;
        const float lg = dir ? lgb[h] : lgf[h]; float s = 0.f; const size_t t0 = (size_t)b * SEQ + i * CHK;
        for (int m = 0; m < CHK; ++m) { const float w = __expf(lg * (dir ? (float)m : (float)(CHK - 1 - m)));
            s += w * (float)VR[(t0 + m) * AW + h * 128 + v] * (float)Kb[(t0 + m) * AW + h * 128 + d]; }
        ST[st_index(dir, bh, dir ? 32 - i : i + 1) + v * 128 + d] = s;
    }
}

__device__ __forceinline__ void p4_fast(Frame& F) {
    const f16* UG = (const f16*)(F.ws() + WS_PBUF); const f16* VG = UG + (size_t)NTOK * AW; const f16* Kb = VG + (size_t)2 * NTOK * AW; const f16* VR = Kb + (size_t)NTOK * AW;
    const f16* CK = (const f16*)(F.ws() + WS_CK); const f16* CV = (const f16*)(F.ws() + WS_CV);
    const float* vstat = (const float*)(F.ws() + WS_VSTAT);
    const float* alng = F.in[9]; const float* aws = F.in[10]; const float* abs_ = F.in[11];
    const float* lgf = F.in[13]; const float* lgb = F.in[14];
    float* ARAW = (float*)(F.ws() + WS_ARAW); float* ST = (float*)(F.ws() + WS_ST);
    LAS f16* im0 = (LAS f16*)(F.lds); LAS f16* im1 = (LAS f16*)(F.lds + IMG_BYTES); LAS f16* im2 = (LAS f16*)(F.lds + 2 * IMG_BYTES);
    const int fr = F.lane & 15, fq = F.lane >> 4, w = F.wave;
    constexpr int NU_MLP = 512, NU_LOC = 512, NU_CTX = 16, NU = NU_MLP + NU_LOC + NU_CTX;
    for (int u = F.vcu; u < NU; u += F.G) {
        if (u < NU_MLP) {
            const int h = u & 7, ci = u >> 3, t0 = ci * CHK, hc = h * 128;
            float mean, rstd; { const float* pp = vstat + (size_t)(t0 + (F.tid & 127)) * 32; float ssum = 0.f, qsum = 0.f;
#pragma unroll
                for (int k = 0; k < 16; ++k) { const f32x2 st = *(const f32x2*)(pp + 2 * k); ssum += st.x; qsum += st.y; }
                mean = ssum * (1.0f / AW); rstd = 1.0f / sqrtf(fmaxf(qsum * (1.0f / AW) - mean * mean, 0.f) + EPS); }
#pragma unroll
            for (int it = 0; it < 4; ++it) { const int q = F.tid & 127, cc = ((F.tid >> 7) + 4 * it) * 8;
                const f16x8 v = *(const f16x8*)(VG + (size_t)(t0 + q) * AW + hc + cc);
#pragma unroll
                for (int j = 0; j < 8; ++j) im0[(cc + j) * IMG_LD + q] = (f16)(((float)v[j] - mean) * rstd * alng[hc + cc + j]); }
            f16x8 a[4]; const float* wrow = aws + (size_t)(hc + 16 * w + fr) * 128;
#pragma unroll
            for (int ks = 0; ks < 4; ++ks) { const f32x4 x0 = *(const f32x4*)(wrow + 32 * ks + 8 * fq), x1 = *(const f32x4*)(wrow + 32 * ks + 8 * fq + 4);
                a[ks][0] = (f16)x0.x; a[ks][1] = (f16)x0.y; a[ks][2] = (f16)x0.z; a[ks][3] = (f16)x0.w; a[ks][4] = (f16)x1.x; a[ks][5] = (f16)x1.y; a[ks][6] = (f16)x1.z; a[ks][7] = (f16)x1.w; }
            __syncthreads();
            f32x4 acc[8]; zero8(acc); wave_mma(acc, a, im0, fr, fq);
            const int p = 16 * w + fr; const float bias = abs_[hc + p];
#pragma unroll
            for (int t = 0; t < 8; ++t) { const int d = 16 * t + 4 * fq; const f16x4 ug = *(const f16x4*)(UG + (size_t)(t0 + p) * AW + hc + d);
                f32x4 o; o.x = (float)ug.x * (acc[t].x + bias); o.y = (float)ug.y * (acc[t].y + bias); o.z = (float)ug.z * (acc[t].z + bias); o.w = (float)ug.w * (acc[t].w + bias);
                *(f32x4*)(ARAW + (size_t)(t0 + p) * AW + hc + d) = o; }
            __syncthreads();
        } else {
            const bool isctx = (u >= NU_MLP + NU_LOC); const int uu = isctx ? (u - NU_MLP - NU_LOC) : (u - NU_MLP);
            const int bh = isctx ? uu : (uu >> 5), i = isctx ? 0 : (uu & 31), b = bh >> 3, h = bh & 7, hc = h * 128;
            const float lf = lgf[h], lb = lgb[h];
            f32x4 af[8], ab[8]; zero8(af); zero8(ab);
            const int nhalf = isctx ? 2 : 1;
            for (int hf = 0; hf < nhalf; ++hf) {
                const f16* ksrc = isctx ? (CK + (size_t)(b * CTXL + hf * 128) * AW + hc) : (Kb + (size_t)(b * SEQ + i * CHK) * AW + hc);
                const f16* vsrc = isctx ? (CV + (size_t)(b * CTXL + hf * 128) * AW + hc) : (VR + (size_t)(b * SEQ + i * CHK) * AW + hc);
                const int L = isctx ? CTXL : CHK;
#pragma unroll
                for (int it = 0; it < 4; ++it) { const int m = F.tid & 127, cc = ((F.tid >> 7) + 4 * it) * 8; const int l = hf * 128 + m;
                    const f16x8 kv = *(const f16x8*)(ksrc + (size_t)m * AW + cc); const f16x8 vv = *(const f16x8*)(vsrc + (size_t)m * AW + cc);
                    const float wf = __expf(lf * (float)(L - 1 - l)), wb = __expf(lb * (float)l);
#pragma unroll
                    for (int j = 0; j < 8; ++j) { im0[(cc + j) * IMG_LD + m] = vv[j]; im1[(cc + j) * IMG_LD + m] = (f16)((float)kv[j] * wf); im2[(cc + j) * IMG_LD + m] = (f16)((float)kv[j] * wb); } }
                __syncthreads();
                f16x8 a[4];
#pragma unroll
                for (int ks = 0; ks < 4; ++ks) a[ks] = *(const LAS f16x8*)(im0 + (16 * w + fr) * IMG_LD + 32 * ks + 8 * fq);
                wave_mma(af, a, im1, fr, fq); wave_mma(ab, a, im2, fr, fq);
                __syncthreads();
            }
            float* df = ST + st_index(0, bh, isctx ? 0 : i + 1) + (16 * w + fr) * 128; float* db = ST + st_index(1, bh, isctx ? 0 : 32 - i) + (16 * w + fr) * 128;
#pragma unroll
            for (int t = 0; t < 8; ++t) { *(f32x4*)(df + 16 * t + 4 * fq) = af[t]; *(f32x4*)(db + 16 * t + 4 * fq) = ab[t]; }
        }
    }
}
__device__ __forceinline__ void p6_fast(Frame& F) {
    const f16* Qb = (const f16*)(F.ws() + WS_PBUF) + (size_t)2 * NTOK * AW; const f16* Kb = Qb + (size_t)NTOK * AW; const f16* VR = Kb + (size_t)NTOK * AW; const f16* GS = VR + (size_t)NTOK * AW;
    const float* ST = (const float*)(F.ws() + WS_ST);
    const float* lgf = F.in[13]; const float* lgb = F.in[14]; const float* gng = F.in[15]; f16* AR = (f16*)(F.ws() + WS_AR);
    LAS f16* imK = (LAS f16*)(F.lds); LAS f16* imV = (LAS f16*)(F.lds + IMG_BYTES); LAS f16* imS = (LAS f16*)(F.lds + 2 * IMG_BYTES); LAS f16* imP = (LAS f16*)(F.lds + 3 * IMG_BYTES);
    const int fr = F.lane & 15, fq = F.lane >> 4, w = F.wave;
    constexpr float L2E = 1.4426950408889634f;
    for (int u = F.vcu; u < 512; u += F.G) {
        const int bh = u >> 5, i = u & 31, b = bh >> 3, h = bh & 7, hc = h * 128; const size_t t0 = (size_t)b * SEQ + i * CHK;
        const float lf = lgf[h] * L2E, lb = lgb[h] * L2E;
        stage_rows(imK, Kb + t0 * AW + hc, AW, F.tid);
#pragma unroll
        for (int it = 0; it < 4; ++it) { const int m = F.tid & 127, cc = ((F.tid >> 7) + 4 * it) * 8; const f16x8 vv = *(const f16x8*)(VR + (t0 + m) * AW + hc + cc);
#pragma unroll
            for (int j = 0; j < 8; ++j) imV[(cc + j) * IMG_LD + m] = vv[j]; }
        stage_rows_f32(imS, ST + st_index(0, bh, i), F.tid);
        const int n = 16 * w + fr; const size_t trow = t0 + n;
        f16x8 qa[4];
#pragma unroll
        for (int ks = 0; ks < 4; ++ks) qa[ks] = *(const f16x8*)(Qb + trow * AW + hc + 32 * ks + 8 * fq);
        __syncthreads();
        f32x4 acc[8], o[8]; zero8(acc); wave_mma(acc, qa, imS, fr, fq);
        const float qf = exp2f(lf * (float)(n + 1)), qb = exp2f(lb * (float)(CHK - n));
#pragma unroll
        for (int t = 0; t < 8; ++t) o[t] = acc[t] * qf;
        __syncthreads();
        stage_rows_f32(imS, ST + st_index(1, bh, 31 - i), F.tid);
        __syncthreads();
        zero8(acc); wave_mma(acc, qa, imS, fr, fq);
#pragma unroll
        for (int t = 0; t < 8; ++t) o[t] += acc[t] * qb;
        zero8(acc); wave_mma(acc, qa, imK, fr, fq);
        int nn = n; asm volatile("" : "+v"(nn));
        LAS f16* pw = imP + (16 * w) * IMG_LD;
#pragma unroll
        for (int t = 0; t < 8; ++t) { float pv[4];
#pragma unroll
            for (int r = 0; r < 4; ++r) { const float dm = (float)(nn - (16 * t + 4 * fq + r)); const float dec = exp2f(lf * fmaxf(dm, 0.f) + lb * fmaxf(-dm, 0.f)) + (1.0f - fminf(fabsf(dm), 1.0f)); pv[r] = acc[t][r] * dec; }
            u32x2 pk; pk.x = pkh(pv[0], pv[1]); pk.y = pkh(pv[2], pv[3]); *(LAS u32x2*)(pw + fr * IMG_LD + 16 * t + 4 * fq) = pk; }
        f16x8 pa[4];
#pragma unroll
        for (int ks = 0; ks < 4; ++ks) pa[ks] = *(const LAS f16x8*)(pw + fr * IMG_LD + 32 * ks + 8 * fq);
        wave_mma(o, pa, imV, fr, fq);
        float s = 0.f;
#pragma unroll
        for (int t = 0; t < 8; ++t) s += (o[t].x + o[t].y) + (o[t].z + o[t].w);
        s += __shfl_xor(s, 16); s += __shfl_xor(s, 32);
        const float mean = s * (1.0f / 128.0f); float q = 0.f;
#pragma unroll
        for (int t = 0; t < 8; ++t) { o[t] = o[t] - mean; q += (o[t].x * o[t].x + o[t].y * o[t].y) + (o[t].z * o[t].z + o[t].w * o[t].w); }
        q += __shfl_xor(q, 16); q += __shfl_xor(q, 32);
        const float rstd = 1.0f / sqrtf(q * (1.0f / 128.0f) + EPS);
#pragma unroll
        for (int t = 0; t < 8; ++t) { const int col = hc + 16 * t + 4 * fq; const f32x4 g = *(const f32x4*)(gng + col); const f16x4 gs = *(const f16x4*)(GS + trow * AW + col);
            u32x2 pk; pk.x = pkh(o[t].x * rstd * g.x * (float)gs.x, o[t].y * rstd * g.y * (float)gs.y); pk.y = pkh(o[t].z * rstd * g.z * (float)gs.z, o[t].w * rstd * g.w * (float)gs.w);
            *(u32x2*)(AR + trow * DM + AW + col) = pk; }
        __syncthreads();
    }
}
__device__ __forceinline__ void p5_naive(Frame& F) {
    const int gw = F.vcu * NWAVES + F.wave, NGW = F.G * NWAVES; const int gt = F.vcu * 512 + F.tid, NGT = F.G * 512;
    const float* ARAW = (const float*)(F.ws() + WS_ARAW); f16* AR = (f16*)(F.ws() + WS_AR); const float* aog = F.in[12];
    for (int row = gw; row < NTOK; row += NGW) {
        f32x4 v[4]; float ss = 0.f;
#pragma unroll
        for (int j = 0; j < 4; ++j) { v[j] = *(const f32x4*)(ARAW + (size_t)row * AW + 4 * F.lane + 256 * j); ss += (v[j].x * v[j].x + v[j].y * v[j].y) + (v[j].z * v[j].z + v[j].w * v[j].w); }
        const float rstd = 1.0f / sqrtf(wave_sum(ss) * (1.0f / AW) + EPS);
#pragma unroll
        for (int j = 0; j < 4; ++j) { const int col = 4 * F.lane + 256 * j; const f32x4 g = *(const f32x4*)(aog + col); const f32x4 h = v[j] * rstd * g;
            u32x2 o; o.x = pkh(h.x, h.y); o.y = pkh(h.z, h.w); *(u32x2*)(AR + (size_t)row * DM + col) = o; }
    }
    float* ST = (float*)(F.ws() + WS_ST); const float* lgf = F.in[13]; const float* lgb = F.in[14];
    for (int idx = gt; idx < 2 * 16 * 16384; idx += NGT) {
        const int e = idx & 16383, bh = (idx >> 14) & 15, dir = idx >> 18, h = bh & 7;
        const float cd = __expf((dir ? lgb[h] : lgf[h]) * (float)CHK);
        float* p0 = ST + st_index(dir, bh, 0) + e; float uv[32];
#pragma unroll
        for (int s = 0; s < 32; ++s) uv[s] = p0[(size_t)s * 16384];
#pragma unroll
        for (int s = 1; s < 32; ++s) { uv[s] = cd * uv[s - 1] + uv[s]; p0[(size_t)s * 16384] = uv[s]; }
    }
}
__device__ __forceinline__ void p6_naive(Frame& F) {
    const int gt = F.vcu * 512 + F.tid, NGT = F.G * 512;
    const f16* Qb = (const f16*)(F.ws() + WS_PBUF) + (size_t)2 * NTOK * AW; const f16* Kb = Qb + (size_t)NTOK * AW;
    const float* lgf = F.in[13]; const float* lgb = F.in[14]; float* PB = (float*)(F.ws() + WS_PB);
    for (int idx = gt; idx < 16 * 32 * 16384; idx += NGT) {
        const int m = idx & 127, n = (idx >> 7) & 127, i = (idx >> 14) & 31, bh = idx >> 19, b = bh >> 3, h = bh & 7;
        const size_t t0 = (size_t)b * SEQ + i * CHK; const f16* q = Qb + (t0 + n) * AW + h * 128; const f16* k = Kb + (t0 + m) * AW + h * 128;
        float s = 0.f; for (int d = 0; d < 128; ++d) s += (float)q[d] * (float)k[d];
        const float dec = (n > m) ? __expf(lgf[h] * (float)(n - m)) : (n < m) ? __expf(lgb[h] * (float)(m - n)) : 2.0f;
        PB[idx] = s * dec;
    }
}
__device__ __forceinline__ void p7_naive(Frame& F) {
    const int gw = F.vcu * NWAVES + F.wave, NGW = F.G * NWAVES;
    const f16* Qb = (const f16*)(F.ws() + WS_PBUF) + (size_t)2 * NTOK * AW; const f16* VR = Qb + (size_t)2 * NTOK * AW; const f16* GS = VR + (size_t)NTOK * AW;
    const float* PB = (const float*)(F.ws() + WS_PB); const float* ST = (const float*)(F.ws() + WS_ST);
    const float* lgf = F.in[13]; const float* lgb = F.in[14]; const float* gng = F.in[15]; f16* AR = (f16*)(F.ws() + WS_AR);
    for (int it = gw; it < NTOK * NH; it += NGW) {
        const int t = it >> 3, h = it & 7, b = t >> 12, tp = t & (SEQ - 1), i = tp >> 7, n = tp & 127, bh = b * 8 + h;
        const size_t t0 = (size_t)b * SEQ + i * CHK;
        const float* prow = PB + (((size_t)bh * 32 + i) * 128 + n) * 128;
        float o0 = 0.f, o1 = 0.f;
        for (int m = 0; m < 128; ++m) { const float p = prow[m]; const f16* vr = VR + (t0 + m) * AW + h * 128; o0 += p * (float)vr[F.lane]; o1 += p * (float)vr[F.lane + 64]; }
        const f16* q = Qb + (size_t)t * AW + h * 128;
        const float* sf = ST + st_index(0, bh, i); const float* sb = ST + st_index(1, bh, 31 - i);
        float f0 = 0.f, f1 = 0.f, b0 = 0.f, b1 = 0.f;
        for (int d = 0; d < 128; ++d) { const float qd = (float)q[d]; f0 += qd * sf[F.lane * 128 + d]; f1 += qd * sf[(F.lane + 64) * 128 + d]; b0 += qd * sb[F.lane * 128 + d]; b1 += qd * sb[(F.lane + 64) * 128 + d]; }
        const float qf = __expf(lgf[h] * (float)(n + 1)), qb = __expf(lgb[h] * (float)(CHK - n));
        o0 += qf * f0 + qb * b0; o1 += qf * f1 + qb * b1;
        const float mean = wave_sum(o0 + o1) * (1.0f / 128.0f); const float d0 = o0 - mean, d1 = o1 - mean;
        const float rstd = 1.0f / sqrtf(wave_sum(d0 * d0 + d1 * d1) * (1.0f / 128.0f) + EPS);
        const int j0 = h * 128 + F.lane;
        AR[(size_t)t * DM + AW + j0] = (f16)(d0 * rstd * gng[j0] * (float)GS[(size_t)t * AW + j0]);
        AR[(size_t)t * DM + AW + j0 + 64] = (f16)(d1 * rstd * gng[j0 + 64] * (float)GS[(size_t)t * AW + j0 + 64]);
    }
}
struct DenseSched { int G, c, nM, nN, K; const char* Bt;
    __device__ __forceinline__ bool next(int i, g8::Unit& u, const int (&R)[2], const int (&C)[2]) const {
        int pm, pn; if (!g8::dense_order(i * G + c, nM, nN, pm, pn)) return false;
#pragma unroll
        for (int h = 0; h < 2; ++h)
#pragma unroll
            for (int k = 0; k < 2; ++k) u.ao[h][k] = (unsigned)((pm * 256 + h * 128 + R[k]) * K + C[k]) * 2u;
        u.B = Bt + (size_t)pn * 256 * K * 2; u.row0 = pm * 256; u.pn = pn; u.aux = 0; u.full = 1; return true; } };
__device__ __forceinline__ void p9_router(Frame& F) {
    const float* X1 = (const float*)(F.ws() + WS_X1); f16* HX2 = (f16*)(F.ws() + WS_HX2);
    const float* g2 = F.in[7]; const float* rbias = F.in[18];
    const f16* RWH = (const f16*)(F.ws() + WS_RWT); const f16* RWL = RWH + NE * DM;
    int* EIDX = (int*)(F.ws() + WS_EIDX); float* EW = (float*)(F.ws() + WS_EW); int* CNT = (int*)(F.ws() + WS_CNT);
    LAS float* RED = (LAS float*)F.lds; LAS float* LOG = (LAS float*)(F.lds + 32768); LAS float* PART = (LAS float*)(F.lds + 36864); LAS int* lcnt = (LAS int*)(F.lds + 37888);
    const int r = F.lane & 15, q = F.lane >> 4, w = F.wave;
    for (int u = F.vcu; u < 512; u += F.G) {
        if (F.tid < 64) lcnt[F.tid] = 0;
        const int row = u * 16 + r; const int kb = 256 * w + 8 * q;
        const float* mod = (const float*)(F.ws() + WS_MOD) + ((u * 16) >> 12) * 12288;
        float ss = 0.f; const float* xrow = X1 + (size_t)row * DM + kb;
        {   f32x4 xa[8], xb[8];
#pragma unroll
            for (int ks = 0; ks < 8; ++ks) { xa[ks] = *(const f32x4*)(xrow + 32 * ks); xb[ks] = *(const f32x4*)(xrow + 32 * ks + 4); }
#pragma unroll
            for (int ks = 0; ks < 8; ++ks) ss += (xa[ks].x * xa[ks].x + xa[ks].y * xa[ks].y) + (xa[ks].z * xa[ks].z + xa[ks].w * xa[ks].w) + (xb[ks].x * xb[ks].x + xb[ks].y * xb[ks].y) + (xb[ks].z * xb[ks].z + xb[ks].w * xb[ks].w); }
        ss += __shfl_xor(ss, 16); ss += __shfl_xor(ss, 32);
        if (q == 0) PART[w * 16 + r] = ss;
        __syncthreads();
        float tot = 0.f;
#pragma unroll
        for (int ww = 0; ww < 8; ++ww) tot += PART[ww * 16 + r];
        const float rstd = 1.0f / sqrtf(tot * (1.0f / DM) + EPS);
        f32x4 am[4], al[4];
#pragma unroll
        for (int nt = 0; nt < 4; ++nt) { am[nt] = (f32x4){0.f, 0.f, 0.f, 0.f}; al[nt] = am[nt]; }
        const f16* rwh = RWH + (size_t)r * DM + kb; const f16* rwl = RWL + (size_t)r * DM + kb;
#pragma unroll 1
        for (int ks = 0; ks < 8; ++ks) { const int col = kb + 32 * ks;
            const f32x4 xa = *(const f32x4*)(xrow + 32 * ks), xb = *(const f32x4*)(xrow + 32 * ks + 4);
            const f32x4 ga = *(const f32x4*)(g2 + col), gb = *(const f32x4*)(g2 + col + 4), sha = *(const f32x4*)(mod + 3 * 2048 + col), shb = *(const f32x4*)(mod + 3 * 2048 + col + 4), sca = *(const f32x4*)(mod + 4 * 2048 + col), scb = *(const f32x4*)(mod + 4 * 2048 + col + 4);
            f16x8 bh[4], bl[4];
#pragma unroll
            for (int nt = 0; nt < 4; ++nt) { bh[nt] = *(const f16x8*)(rwh + (size_t)(16 * nt) * DM + 32 * ks); bl[nt] = *(const f16x8*)(rwl + (size_t)(16 * nt) * DM + 32 * ks); }
            const f32x4 ha = (xa * rstd * ga) * (sca + 1.0f) + sha, hb = (xb * rstd * gb) * (scb + 1.0f) + shb;
            f16x8 hi, lo;
            hi[0] = (f16)ha.x; hi[1] = (f16)ha.y; hi[2] = (f16)ha.z; hi[3] = (f16)ha.w; hi[4] = (f16)hb.x; hi[5] = (f16)hb.y; hi[6] = (f16)hb.z; hi[7] = (f16)hb.w;
            lo[0] = (f16)((ha.x - (float)hi[0]) * 2048.0f); lo[1] = (f16)((ha.y - (float)hi[1]) * 2048.0f); lo[2] = (f16)((ha.z - (float)hi[2]) * 2048.0f); lo[3] = (f16)((ha.w - (float)hi[3]) * 2048.0f);
            lo[4] = (f16)((hb.x - (float)hi[4]) * 2048.0f); lo[5] = (f16)((hb.y - (float)hi[5]) * 2048.0f); lo[6] = (f16)((hb.z - (float)hi[6]) * 2048.0f); lo[7] = (f16)((hb.w - (float)hi[7]) * 2048.0f);
            *(f16x8*)(HX2 + (size_t)row * DM + col) = hi;
#pragma unroll
            for (int nt = 0; nt < 4; ++nt) {
                am[nt] = __builtin_amdgcn_mfma_f32_16x16x32_f16(hi, bh[nt], am[nt], 0, 0, 0);
                al[nt] = __builtin_amdgcn_mfma_f32_16x16x32_f16(lo, bh[nt], al[nt], 0, 0, 0);
                al[nt] = __builtin_amdgcn_mfma_f32_16x16x32_f16(hi, bl[nt], al[nt], 0, 0, 0); } }
#pragma unroll
        for (int nt = 0; nt < 4; ++nt)
#pragma unroll
            for (int rg = 0; rg < 4; ++rg) RED[(w * 16 + 4 * q + rg) * 64 + 16 * nt + r] = am[nt][rg] + al[nt][rg] * (1.0f / 2048.0f);
        __syncthreads();
#pragma unroll
        for (int o2 = 0; o2 < 2; ++o2) { const int o = F.tid + 512 * o2; float sacc = 0.f;
#pragma unroll
            for (int ww = 0; ww < 8; ++ww) sacc += RED[ww * 1024 + o];
            LOG[o] = sacc; }
        __syncthreads();
        for (int rr = 0; rr < 2; ++rr) { const int rl = 2 * w + rr, trow = u * 16 + rl;
            const float logit = LOG[rl * 64 + F.lane];
            const float s = 1.0f / (1.0f + expf(-logit)); const float sel = s + rbias[F.lane];
            float m1 = sel; m1 = fmaxf(m1, __shfl_xor(m1, 1)); m1 = fmaxf(m1, __shfl_xor(m1, 2)); m1 = fmaxf(m1, __shfl_xor(m1, 4));
            const unsigned long long bm = __ballot(sel == m1); const int gbase = F.lane & ~7; const unsigned gb = (unsigned)(bm >> gbase) & 0xffu; const int first = gbase + __builtin_ctz(gb);
            float m2 = (F.lane == first) ? -INFINITY : sel; m2 = fmaxf(m2, __shfl_xor(m2, 1)); m2 = fmaxf(m2, __shfl_xor(m2, 2)); m2 = fmaxf(m2, __shfl_xor(m2, 4));
            const float gs = m1 + m2; const int myg = F.lane >> 3; int beat = 0;
#pragma unroll
            for (int g = 0; g < 8; ++g) { const float og = __shfl(gs, g * 8); beat += (og > gs || (og == gs && g < myg)) ? 1 : 0; }
            const float cand = (beat < 4) ? sel : -INFINITY; int rank = 0;
            for (int e = 0; e < NE; ++e) { const float oc = __shfl(cand, e); rank += (oc > cand || (oc == cand && e < F.lane)) ? 1 : 0; }
            const bool chosen = (rank < TOPK) && (beat < 4);
            const float wsum = wave_sum(chosen ? s : 0.f);
            if (chosen) { EIDX[trow * 8 + rank] = F.lane; EW[trow * 8 + rank] = s / wsum * 2.5f; __hip_atomic_fetch_add(&lcnt[F.lane], 1, __ATOMIC_RELAXED, __HIP_MEMORY_SCOPE_WORKGROUP); }
        }
        __syncthreads();
        if (F.tid < 64) CNT[u * 64 + F.tid] = lcnt[F.tid];
        __syncthreads();
    }
}
__device__ __forceinline__ void p10_lists(Frame& F) {
    LAS int* pre = (LAS int*)(F.lds);
    LAS int* tot = pre + 128; LAS int* rb = pre + 256; LAS int* lfill = pre + 384;
    const int* CNT = (const int*)(F.ws() + WS_CNT);
    const int* EIDX = (const int*)(F.ws() + WS_EIDX); const float* EW = (const float*)(F.ws() + WS_EW);
    int* TILEE = (int*)(F.ws() + WS_TILEE); int* ROWTOK = (int*)(F.ws() + WS_ROWTOK); int* ROWDST = (int*)(F.ws() + WS_ROWDST); float* ROWW = (float*)(F.ws() + WS_ROWW);
    const int u1 = F.vcu, u2 = F.vcu + F.G;
    {
        LAS int* segs = pre + 512;
        const int e = F.tid & 63, seg = F.tid >> 6; int run = 0, q1 = 0, q2 = 0;
        for (int j0 = 0; j0 < 64; j0 += 16) { int cv[16];
#pragma unroll
            for (int j = 0; j < 16; ++j) cv[j] = CNT[(seg * 64 + j0 + j) * 64 + e];
#pragma unroll
            for (int j = 0; j < 16; ++j) { const int uu = seg * 64 + j0 + j; if (uu == u1) q1 = run; if (uu == u2) q2 = run; run += cv[j]; } }
        segs[seg * 64 + e] = run; if ((u1 >> 6) == seg) segs[512 + e] = q1; if ((u2 >> 6) == seg) segs[576 + e] = q2;
        __syncthreads();
        if (F.tid < 64) { int r2 = 0, p1 = 0, p2 = 0;
#pragma unroll
            for (int sg = 0; sg < 8; ++sg) { if (sg == (u1 >> 6)) p1 = r2 + segs[512 + e]; if (sg == (u2 >> 6)) p2 = r2 + segs[576 + e]; r2 += segs[sg * 64 + e]; }
            pre[e] = p1; pre[64 + e] = p2; tot[e] = r2; }
    }
    __syncthreads();
    if (F.tid == 0) { tot[NE] = NTOK; int tiles = 0; for (int e = 0; e < NE1; ++e) { rb[e] = tiles * 256; const int nt = (tot[e] + 255) >> 8; if (F.vcu == 0) for (int j = 0; j < nt; ++j) { TILEE[tiles + j] = e; TILEE[512 + tiles + j] = (j + 1 < nt) ? 256 : (tot[e] - 256 * j); } tiles += nt; } rb[NE1] = tiles * 256; if (F.vcu == 0) TILEE[511] = tiles; }
    __syncthreads();
    for (int k = 0; k < 2; ++k) { const int u = k ? u2 : u1; if (u >= 512) break;
        if (F.tid < 64) lfill[F.tid] = 0;
        __syncthreads();
        if (F.tid < 128) { const int i = u * 128 + F.tid; const int e = EIDX[i]; const int pos = pre[k * 64 + e] + __hip_atomic_fetch_add(&lfill[e], 1, __ATOMIC_RELAXED, __HIP_MEMORY_SCOPE_WORKGROUP);
            const int row = rb[e] + pos; ROWTOK[row] = i >> 3; ROWDST[row] = (i >> 3) * NSLOT + (i & 7); ROWW[row] = EW[i]; }
        else if (F.tid < 144) { const int t = u * 16 + (F.tid - 128); const int row = rb[NE] + t; ROWTOK[row] = t; ROWDST[row] = t * NSLOT + 8; ROWW[row] = 1.0f; }
        __syncthreads();
    }
    if (F.vcu < NE1) { const int e = F.vcu; const int lo = rb[e] + tot[e], hi = rb[e + 1]; for (int r = lo + F.tid; r < hi; r += 512) { ROWTOK[r] = 0; ROWDST[r] = -1; ROWW[r] = 0.f; } }
}
struct MoeSched { int G, c, nN, K, gather; const int* TILEE; const int* ROWTOK; const char* Bt; size_t bstride_e;
    __device__ __forceinline__ bool next(int i, g8::Unit& u, const int (&R)[2], const int (&C)[2]) const {
        const int ntile = __builtin_amdgcn_readfirstlane(TILEE[511]), total = ntile * nN, per = (total + 7) >> 3, x = c & 7, lc = c >> 3, li = i * (G >> 3) + lc;
        if (li >= per) return false; const int idx = x * per + li; if (idx >= total) return false;
        const int j = idx / nN, pn = idx % nN, e = __builtin_amdgcn_readfirstlane(TILEE[j]);
#pragma unroll
        for (int h = 0; h < 2; ++h)
#pragma unroll
            for (int k = 0; k < 2; ++k) { const int r = j * 256 + h * 128 + R[k]; const int src = gather ? ROWTOK[r] : r; u.ao[h][k] = (unsigned)(src * K + C[k]) * 2u; }
        u.B = Bt + (size_t)e * bstride_e + (size_t)pn * 256 * K * 2; u.row0 = j * 256; u.pn = pn; u.aux = e; u.full = __builtin_amdgcn_readfirstlane(TILEE[512 + j]) > 128; return true; } };
struct EpiHid {
    static constexpr bool PERM = true;
    f16* HID;
    __device__ __forceinline__ void operator()(const f32x4 (&acc)[2][2][4][2], const g8::Unit& u, int wr, int wc, int fr, int fq) const {
        const int row0 = u.row0 + wr * 64 + fr, col0 = u.pn * 128 + wc * 32 + 8 * fq;
#pragma unroll
        for (int ai = 0; ai < 2; ++ai)
#pragma unroll
            for (int m = 0; m < 4; ++m) { const f32x4 a0 = acc[ai][0][m][0], a1 = acc[ai][0][m][1], b0 = acc[ai][1][m][0], b1 = acc[ai][1][m][1];
                u32x4 w; w.x = pkh(silu_f(a0[0]) * b0[0], silu_f(a0[1]) * b0[1]); w.y = pkh(silu_f(a0[2]) * b0[2], silu_f(a0[3]) * b0[3]);
                w.z = pkh(silu_f(a1[0]) * b1[0], silu_f(a1[1]) * b1[1]); w.w = pkh(silu_f(a1[2]) * b1[2], silu_f(a1[3]) * b1[3]);
                *(u32x4*)(HID + (size_t)(row0 + ai * 128 + m * 16) * EH + col0) = w; }
    }
};
struct EpiYs {
    static constexpr bool PERM = true;
    f16* YS; const int* ROWDST; const float* ROWW;
    __device__ __forceinline__ void operator()(const f32x4 (&acc)[2][2][4][2], const g8::Unit& u, int wr, int wc, int fr, int fq) const {
        const int row0 = u.row0 + wr * 64 + fr, col0 = u.pn * 256 + wc * 32 + 8 * fq;
#pragma unroll
        for (int ai = 0; ai < 2; ++ai)
#pragma unroll
            for (int m = 0; m < 4; ++m) { const int row = row0 + ai * 128 + m * 16; const int dst = ROWDST[row]; const float w = ROWW[row];
                if (dst >= 0) {
#pragma unroll
                    for (int bj = 0; bj < 2; ++bj) { const f32x4 a0 = acc[ai][bj][m][0] * w, a1 = acc[ai][bj][m][1] * w;
                        u32x4 o; o.x = pkh(a0[0], a0[1]); o.y = pkh(a0[2], a0[3]); o.z = pkh(a1[0], a1[1]); o.w = pkh(a1[2], a1[3]);
                        *(u32x4*)(YS + (size_t)dst * DM + col0 + bj * 128) = o; } } }
    }
};
__device__ __forceinline__ void p13_combine(Frame& F) {
    const int gw = F.vcu * NWAVES + F.wave, NGW = F.G * NWAVES;
    const float* X1 = (const float*)(F.ws() + WS_X1); const f16* YS = (const f16*)(F.ws() + WS_YS); const float* fg = F.in[25]; float* outp = F.out();
    for (int row = gw; row < NTOK; row += NGW) {
        const float* g2 = (const float*)(F.ws() + WS_MOD) + (row >> 12) * 12288 + 5 * 2048;
        const f16* yrow = YS + (size_t)row * NSLOT * DM + 8 * F.lane; const float* xrow = X1 + (size_t)row * DM + 8 * F.lane;
        f32x4 v[4][2]; float ss = 0.f;
        f16x8 y[NSLOT], yn[NSLOT]; f32x4 xa, xb, xna, xnb;
#pragma unroll
        for (int sl = 0; sl < NSLOT; ++sl) y[sl] = __builtin_nontemporal_load((const f16x8*)(yrow + (size_t)sl * DM));
        xa = *(const f32x4*)(xrow); xb = *(const f32x4*)(xrow + 4);
#pragma unroll
        for (int j = 0; j < 4; ++j) { const int col = 8 * F.lane + 512 * j;
            if (j < 3) {
#pragma unroll
                for (int sl = 0; sl < NSLOT; ++sl) yn[sl] = __builtin_nontemporal_load((const f16x8*)(yrow + (size_t)sl * DM + 512 * (j + 1)));
                xna = *(const f32x4*)(xrow + 512 * (j + 1)); xnb = *(const f32x4*)(xrow + 512 * (j + 1) + 4); }
            const f32x4 ga = *(const f32x4*)(g2 + col), gb = *(const f32x4*)(g2 + col + 4);
            f32x4 a = {0.f, 0.f, 0.f, 0.f}, b = a;
#pragma unroll
            for (int sl = 0; sl < NSLOT; ++sl) { a.x += (float)y[sl][0]; a.y += (float)y[sl][1]; a.z += (float)y[sl][2]; a.w += (float)y[sl][3]; b.x += (float)y[sl][4]; b.y += (float)y[sl][5]; b.z += (float)y[sl][6]; b.w += (float)y[sl][7]; }
            v[j][0] = xa + ga * a; v[j][1] = xb + gb * b;
            ss += (v[j][0].x * v[j][0].x + v[j][0].y * v[j][0].y) + (v[j][0].z * v[j][0].z + v[j][0].w * v[j][0].w) + (v[j][1].x * v[j][1].x + v[j][1].y * v[j][1].y) + (v[j][1].z * v[j][1].z + v[j][1].w * v[j][1].w);
            FENCE();
            if (j < 3) {
#pragma unroll
                for (int sl = 0; sl < NSLOT; ++sl) y[sl] = yn[sl];
                xa = xna; xb = xnb; } }
        const float rstd = 1.0f / sqrtf(wave_sum(ss) * (1.0f / DM) + EPS);
#pragma unroll
        for (int j = 0; j < 4; ++j) { const int col = 8 * F.lane + 512 * j; const f32x4 ga = *(const f32x4*)(fg + col), gb = *(const f32x4*)(fg + col + 4);
            __builtin_nontemporal_store(v[j][0] * rstd * ga, (f32x4*)(outp + (size_t)row * DM + col)); __builtin_nontemporal_store(v[j][1] * rstd * gb, (f32x4*)(outp + (size_t)row * DM + col + 4)); }
    }
}

struct Args { const float* in[26]; float* out; unsigned char* ws; int ph_lo, ph_hi, li, pad; };
__global__ void __launch_bounds__(NWAVES * 64, 2) fwd(Args args) {
    extern __shared__ __attribute__((aligned(16))) unsigned char lds[];
    Frame F;
    F.lds = (LAS unsigned char*)lds;
    F.tid = threadIdx.x; F.lane = F.tid & 63; F.wave = __builtin_amdgcn_readfirstlane(F.tid >> 6);
    F.G = gridDim.x; { const int bx = blockIdx.x; F.vcu = (bx & 7) * (F.G >> 3) + (bx >> 3); }
    F.in.base = (LAS const unsigned*)(F.lds + LDSCTL_OFF + 512);
    {
        const unsigned* ka = (const unsigned*)__builtin_amdgcn_kernarg_segment_ptr();
        if (F.tid < 128) ((LAS unsigned*)(F.lds + LDSCTL_OFF))[F.tid] = 0u;
        if (F.tid >= 128 && F.tid < 128 + 60) ((LAS unsigned*)(F.lds + LDSCTL_OFF + 512))[F.tid - 128] = ka[F.tid - 128];
    }
    __syncthreads();
    const int ph_lo = (int)__builtin_amdgcn_readfirstlane(((LAS const unsigned*)(F.lds + LDSCTL_OFF + 512))[56]), ph_hi = (int)__builtin_amdgcn_readfirstlane(((LAS const unsigned*)(F.lds + LDSCTL_OFF + 512))[57]);
    if (MK_N_LAUNCHES == 1) xcd_barrier_post((unsigned*)(F.ws() + WS_CTL) + CW_BAR);
    const int lo = ph_lo, hi = ph_hi;
#define REFRESH() do { int t_ = threadIdx.x; asm volatile("" : "+v"(t_)); F.tid = t_; F.lane = t_ & 63; F.wave = __builtin_amdgcn_readfirstlane(t_ >> 6); } while (0)
#define IN(k) (lo <= (k) && (k) < hi)
#define SEAM(k) do { if (IN(k) && IN((k) + 1)) { XcdBarrier bar_; bar_.bar = (unsigned*)(F.ws() + WS_CTL) + CW_BAR; bar_.st = (volatile LAS unsigned*)((LAS unsigned char*)lds + MISC_OFF) + 8; xcd_barrier(bar_); } } while (0)
    const int cblk = (int)blockIdx.x;
    if (IN(0)) for (int rep_ = 0; rep_ <= ((PROBE_DUP >> 0) & 1); ++rep_) { if (rep_) __syncthreads(); REFRESH(); p0_prologue(F); } SEAM(0);
    if (IN(1)) for (int rep_ = 0; rep_ <= ((PROBE_DUP >> 1) & 1); ++rep_) { if (rep_) __syncthreads(); REFRESH(); p1_norm(F); } SEAM(1);
    if (IN(2)) for (int rep_ = 0; rep_ <= ((PROBE_DUP >> 2) & 1); ++rep_) { if (rep_) __syncthreads(); REFRESH(); InSched S{F.G, cblk, (const char*)(F.ws() + WS_WINT), 0, 1000};
        EpiIn E{(f16*)(F.ws() + WS_PBUF), (f16*)(F.ws() + WS_CK), (f16*)(F.ws() + WS_CV), (float*)(F.ws() + WS_VSTAT), (const float*)(F.ws() + WS_ROPE)};
        const int grp = (cblk >> 3) & 3;
        for (int part = 0; part < 2; ++part) {
            S.ulo = part ? grp : 0; S.uhi = part ? 1000 : grp;
            if (S.uhi > S.ulo) g8::gemm_phase<EpiIn, InSched, true>(F.lds + RING_OFF, (const char*)(F.ws() + WS_HX), DM, S, E);
            if (part == 0) { __syncthreads(); REFRESH(); if (F.vcu < 64) { p2_ctx_unit(F, F.vcu); __syncthreads(); } p2_expert_copies(F); __syncthreads(); } } } SEAM(2);
    if (IN(4)) for (int rep_ = 0; rep_ <= ((PROBE_DUP >> 4) & 1); ++rep_) { if (rep_) __syncthreads(); REFRESH(); p4_fast(F); } SEAM(4);
    if (IN(5)) for (int rep_ = 0; rep_ <= ((PROBE_DUP >> 5) & 1); ++rep_) { if (rep_) __syncthreads(); REFRESH(); p5_naive(F); } SEAM(5);
    if (IN(6)) for (int rep_ = 0; rep_ <= ((PROBE_DUP >> 6) & 1); ++rep_) { if (rep_) __syncthreads(); REFRESH(); p6_fast(F); } SEAM(6);
    if (IN(8)) for (int rep_ = 0; rep_ <= ((PROBE_DUP >> 8) & 1); ++rep_) { if (rep_) __syncthreads(); REFRESH(); DenseSched S{F.G, cblk, 32, 8, DM, (const char*)(F.ws() + WS_WOUTT)}; EpiX1 E{F.in[0], (const float*)(F.ws() + WS_MOD), (float*)(F.ws() + WS_X1)};
        g8::gemm_phase<EpiX1, DenseSched, true>(F.lds + RING_OFF, (const char*)(F.ws() + WS_AR), DM, S, E); } SEAM(8);
    if (IN(9)) for (int rep_ = 0; rep_ <= ((PROBE_DUP >> 9) & 1); ++rep_) { if (rep_) __syncthreads(); REFRESH(); p9_router(F); } SEAM(9);
    if (IN(10)) for (int rep_ = 0; rep_ <= ((PROBE_DUP >> 10) & 1); ++rep_) { if (rep_) __syncthreads(); REFRESH(); p10_lists(F); } SEAM(10);
    if (IN(11)) for (int rep_ = 0; rep_ <= ((PROBE_DUP >> 11) & 1); ++rep_) { if (rep_) __syncthreads(); REFRESH(); MoeSched S{F.G, cblk, 4, DM, 1, (const int*)(F.ws() + WS_TILEE), (const int*)(F.ws() + WS_ROWTOK), (const char*)(F.ws() + WS_W13T), (size_t)1024 * DM * 2};
        EpiHid E{(f16*)(F.ws() + WS_HID)};
        g8::gemm_phase<EpiHid, MoeSched, true>(F.lds + RING_OFF, (const char*)(F.ws() + WS_HX2), DM, S, E); } SEAM(11);
    if (IN(12)) for (int rep_ = 0; rep_ <= ((PROBE_DUP >> 12) & 1); ++rep_) { if (rep_) __syncthreads(); REFRESH(); MoeSched S{F.G, cblk, 8, EH, 0, (const int*)(F.ws() + WS_TILEE), (const int*)(F.ws() + WS_ROWTOK), (const char*)(F.ws() + WS_W2T), (size_t)DM * EH * 2};
        EpiYs E{(f16*)(F.ws() + WS_YS), (const int*)(F.ws() + WS_ROWDST), (const float*)(F.ws() + WS_ROWW)};
        g8::gemm_phase<EpiYs, MoeSched, true>(F.lds + RING_OFF, (const char*)(F.ws() + WS_HID), EH, S, E); } SEAM(12);
    if (IN(13)) for (int rep_ = 0; rep_ <= ((PROBE_DUP >> 13) & 1); ++rep_) { if (rep_) __syncthreads(); REFRESH(); p13_combine(F); }
#undef IN
#undef SEAM
}

extern "C" void kernel_launch(void* const* d_in, const int* in_sizes, int n_in, void* d_out, int out_size, void* d_ws, size_t ws_size, hipStream_t stream) {
    static int grid = 0;
    if (grid == 0) {
        if (n_in != 26 || in_sizes[0] != NTOK * DM || out_size != NTOK * DM || ws_size < WS_END) {
            fprintf(stderr, "kernel_launch: unexpected problem (n_in %d, in0 %d, out %d, ws %zu); nothing launched\n", n_in, n_in > 0 ? in_sizes[0] : -1, out_size, ws_size); grid = -1; return; }
        int dev = 0, cus = 0, per_cu = 0;
        if (hipGetDevice(&dev) != hipSuccess || hipDeviceGetAttribute(&cus, hipDeviceAttributeMultiprocessorCount, dev) != hipSuccess) { grid = -1; return; }
        if (hipFuncSetAttribute((const void*)fwd, hipFuncAttributeMaxDynamicSharedMemorySize, LDS_BYTES) != hipSuccess) { fprintf(stderr, "kernel_launch: hipFuncSetAttribute failed\n"); grid = -1; return; }
        if (hipOccupancyMaxActiveBlocksPerMultiprocessor(&per_cu, (const void*)fwd, NWAVES * 64, LDS_BYTES) != hipSuccess || per_cu < 1)
            fprintf(stderr, "kernel_launch: occupancy query reports %d workgroups per CU\n", per_cu);
        (void)hipGetLastError();
        grid = cus & ~7;
    }
    if (grid < 0) return;
    if (hipMemsetAsync((char*)d_ws + WS_CTL, 0, CTL_ZERO_BYTES, stream) != hipSuccess) return;
    Args a{};
    for (int i = 0; i < 26; ++i) a.in[i] = (const float*)d_in[i];
    a.out = (float*)d_out; a.ws = (unsigned char*)d_ws;
    if (MK_N_LAUNCHES == 1) { a.ph_lo = 0; a.ph_hi = NPHASE; a.li = 0; hipLaunchKernelGGL(fwd, dim3(grid), dim3(NWAVES * 64), LDS_BYTES, stream, a); }
    else { for (int li = 0; li < NPHASE; ++li) { a.ph_lo = li; a.ph_hi = li + 1; a.li = li; hipLaunchKernelGGL(fwd, dim3(grid), dim3(NWAVES * 64), LDS_BYTES, stream, a); } }
}
```

```cpp
#include <hip/hip_runtime.h>
#include <cstdio>
#include <cstdint>

#ifndef PROBE_DUP
#define PROBE_DUP 0
#endif
#ifndef MK_N_LAUNCHES
#define MK_N_LAUNCHES 1
#endif

#define LAS __attribute__((address_space(3)))
#define GAS __attribute__((address_space(1)))
typedef _Float16 f16;
typedef _Float16 f16x8 __attribute__((ext_vector_type(8)));
typedef _Float16 f16x4 __attribute__((ext_vector_type(4)));
typedef _Float16 f16x2 __attribute__((ext_vector_type(2)));
typedef float f32x4 __attribute__((ext_vector_type(4)));
typedef float f32x2 __attribute__((ext_vector_type(2)));
typedef unsigned u32x4 __attribute__((ext_vector_type(4)));
typedef unsigned u32x2 __attribute__((ext_vector_type(2)));
typedef GAS unsigned gu32;

constexpr int DM = 2048, NB = 2, SEQ = 4096, NTOK = NB * SEQ, CTXL = 256, NCTX = NB * CTXL, CHK = 128, NCH = SEQ / CHK;
constexpr int AW = 1024, INC = 6144, NH = 8, HD = 128;
constexpr int NE = 64, NE1 = 65, TOPK = 8, EH = 512, NSLOT = 9;
constexpr int NROWS_IN = NTOK + NCTX;
constexpr int MAXTILES = 360;
constexpr int MAXROWS = MAXTILES * 256;
constexpr float EPS = 1e-6f;
constexpr int NPHASE = 14;
constexpr int NWAVES = 8;

constexpr size_t MiB = 1u << 20;
constexpr size_t WS_CTL = 0, CTL_ZERO_BYTES = 1 * MiB;
constexpr size_t WS_MOD = 1 * MiB;
constexpr size_t WS_ROPE = WS_MOD + 256 * 1024;
constexpr size_t WS_VSTAT = 4 * MiB;
constexpr size_t WS_EIDX = WS_ROPE + 64 * 1024;
constexpr size_t WS_EW = WS_EIDX + 256 * 1024;
constexpr size_t WS_TILEE = WS_EW + 256 * 1024;
constexpr size_t WS_ROWTOK = 2 * MiB;
constexpr size_t WS_ROWDST = WS_ROWTOK + 512 * 1024;
constexpr size_t WS_ROWW = WS_ROWDST + 512 * 1024;
constexpr size_t WS_RWT = 5 * MiB;
constexpr size_t WS_CNT = 5 * MiB + 512 * 1024;
constexpr size_t WS_W13T = 8 * MiB;
constexpr size_t WS_W2T = WS_W13T + 260 * MiB;
constexpr size_t WS_WINT = WS_W2T + 130 * MiB;
constexpr size_t WS_WOUTT = WS_WINT + 24 * MiB;
constexpr size_t WS_X1 = WS_WOUTT + 8 * MiB;
constexpr size_t WS_HX2 = WS_X1 + 64 * MiB;
constexpr size_t WS_HID = WS_HX2 + 32 * MiB;
constexpr size_t WS_OVL = WS_HID + 90 * MiB;
static_assert(WS_OVL == 616 * MiB, "map");
constexpr size_t WS_HX = WS_OVL;
constexpr size_t WS_CBUF = WS_OVL + 34 * MiB;
constexpr size_t WS_ARAW = WS_CBUF;
constexpr size_t WS_PB = WS_CBUF + 32 * MiB;
constexpr size_t WS_AR = WS_CBUF + 64 * MiB;
constexpr size_t WS_OUTX = WS_CBUF + 96 * MiB;
constexpr size_t WS_PBUF = WS_OVL + 238 * MiB;
constexpr size_t WS_CK = WS_PBUF + 96 * MiB;
constexpr size_t WS_CV = WS_CK + 1 * MiB;
constexpr size_t WS_ST = WS_CV + 1 * MiB;
constexpr size_t WS_YS = WS_OVL;
constexpr size_t WS_END = 1024 * MiB;
static_assert(WS_ST + 70 * MiB <= WS_END && WS_YS + 288 * MiB <= WS_END && WS_OUTX + 64 * MiB <= WS_PBUF, "map");
constexpr int CW_BAR = 4096;

constexpr int RING_OFF = 0, RING_BYTES = 131072;
constexpr int LDS_BYTES = 147456;
constexpr int LDSCTL_OFF = LDS_BYTES - 1024, MISC_OFF = LDSCTL_OFF + 320;

#define RLX_AGENT __ATOMIC_RELAXED, __HIP_MEMORY_SCOPE_AGENT
#define LDS_WAIT() asm volatile("s_waitcnt lgkmcnt(0)" ::: "memory")
#define FENCE() do { asm volatile("" ::: "memory"); __builtin_amdgcn_sched_barrier(0); } while (0)
#define VM_WAIT() asm volatile("s_waitcnt vmcnt(0)" ::: "memory")

#define XB_TMO      128
#define XB_XCNT(j)  (256  + 64 * (j))
#define XB_XSUB(j)  (1280 + 64 * (j))
#define XB_XGEN(j)  (2304 + 64 * (j))
#define XB_TOP      3328
#define XB_TOPGEN   3392
#define XCD_BAR_WORDS 3456
#define XB_SPIN_CAP (1u << 18)
__device__ __forceinline__ unsigned xb_ld(unsigned* p)              { return __hip_atomic_load(p, __ATOMIC_RELAXED, __HIP_MEMORY_SCOPE_AGENT); }
__device__ __forceinline__ unsigned xb_add(unsigned* p, unsigned v) { return __hip_atomic_fetch_add(p, v, __ATOMIC_RELAXED, __HIP_MEMORY_SCOPE_AGENT); }
__device__ __forceinline__ unsigned xb_xcc_id() { return (unsigned)__builtin_amdgcn_s_getreg((3 << 11) | 20) & 0xFu; }
#define XB_SPIN(cond, bar) do { unsigned _sp = 0; while (cond) { __builtin_amdgcn_s_sleep(1); \
    if ((++_sp & 255u) == 0u) { if (xb_ld(&(bar)[XB_TMO])) break; if (_sp > XB_SPIN_CAP) { atomicAdd(&(bar)[XB_TMO], 1u); break; } } } } while (0)
struct XcdBarrier { unsigned* bar; volatile LAS unsigned* st; };
__device__ __forceinline__ void xcd_barrier_post(unsigned* bar) {
    if (threadIdx.x == 0) (void)xb_add(&bar[XB_XCNT(xb_xcc_id())], 1u);
}
__device__ __forceinline__ void xcd_barrier_complete(unsigned* bar, unsigned x, unsigned& nloc, unsigned& nx) {
    const unsigned G = gridDim.x * gridDim.y * gridDim.z;
    unsigned sum, cnt, mine, sp = 0u;
    for (;;) {
        sum = 0u; cnt = 0u; mine = 0u;
#pragma unroll
        for (unsigned j = 0; j < 16; ++j) { const unsigned c = xb_ld(&bar[XB_XCNT(j)]); sum += c; cnt += (c > 0u) ? 1u : 0u; mine = (j == x) ? c : mine; }
        if (sum == G) break;
        __builtin_amdgcn_s_sleep(1);
        if ((++sp & 255u) == 0u) { if (xb_ld(&bar[XB_TMO])) break; if (sp > XB_SPIN_CAP) { atomicAdd(&bar[XB_TMO], 1u); break; } }
    }
    nloc = mine > 0u ? mine : 1u; nx = cnt > 0u ? cnt : 1u;
}
__device__ __forceinline__ void xcd_barrier(const XcdBarrier& b) {
    asm volatile("s_waitcnt vmcnt(0)" ::: "memory");
    __syncthreads();
    if (threadIdx.x == 0) {
        unsigned* bar = b.bar; const unsigned bx = xb_xcc_id();
        __builtin_amdgcn_s_waitcnt(0);
        unsigned nloc = b.st[0], nx = b.st[1];
        if (nloc == 0u) { xcd_barrier_complete(bar, bx, nloc, nx); b.st[0] = nloc; b.st[1] = nx; }
        const unsigned old = xb_add(&bar[XB_XSUB(bx)], 1u);
        const unsigned gen = old / nloc;
        if (old + 1u == (gen + 1u) * nloc) {
            __builtin_amdgcn_fence(__ATOMIC_RELEASE, "agent");
            asm volatile("s_waitcnt vmcnt(0)" ::: "memory");
            const unsigned og = xb_add(&bar[XB_TOP], 1u);
            const unsigned tg = og / nx;
            if (og + 1u == (tg + 1u) * nx) xb_add(&bar[XB_TOPGEN], 1u);
            else XB_SPIN(xb_ld(&bar[XB_TOPGEN]) == tg, bar);
            __builtin_amdgcn_fence(__ATOMIC_ACQUIRE, "agent");
            xb_add(&bar[XB_XGEN(bx)], 1u);
            asm volatile("s_waitcnt vmcnt(0)" ::: "memory");
        } else {
            XB_SPIN(xb_ld(&bar[XB_XGEN(bx)]) == gen, bar);
            __builtin_amdgcn_fence(__ATOMIC_ACQUIRE, "agent");
            asm volatile("s_waitcnt vmcnt(0)" ::: "memory");
        }
    }
    __syncthreads();
}

namespace g8 {
constexpr int BM = 256, BK = 64, HALF = 128, HTB = HALF * BK * 2, STAGE_BYTES = 8 * HTB, NXCD = 8, WGM = 8;
__host__ __device__ __forceinline__ int lds_byte(int r, int c) { const int st = (r >> 4) * 2 + (c >> 5), rr = r & 15, cc = c & 31, ob = rr * 64 + cc * 2; return st * 1024 + (ob ^ (((ob >> 9) & 1) << 5)); }
__host__ __device__ __forceinline__ void stage_rc(int b, int& R, int& C) { const int st = b / 1024, sb = b % 1024, swz = sb ^ (((sb >> 9) & 1) << 5); R = (st >> 1) * 16 + swz / 64; C = (st & 1) * 32 + (swz % 64) / 2; }
__host__ __device__ __forceinline__ int perm32(int rho) { const int n = rho >> 4, i = rho & 15; return 8 * (i >> 2) + 4 * n + (i & 3); }

struct Unit { unsigned ao[2][2]; const char* B; int row0; int pn; int aux; int full; };

__device__ __forceinline__ bool dense_order(int L, int nM, int nN, int& pm, int& pn) {
    const int nwg = nM * nN; if (L >= nwg) return false;
    int wgid = L; { const int q = nwg / NXCD, r = nwg % NXCD, xcd = wgid % NXCD, off = wgid / NXCD; wgid = (xcd < r ? xcd * (q + 1) : r * (q + 1) + (xcd - r) * q) + off; }
    const int nig = WGM * nN, gid = wgid / nig, fm = gid * WGM, gsz = (nM - fm) < WGM ? (nM - fm) : WGM;
    pm = fm + ((wgid % nig) % gsz); pn = (wgid % nig) / gsz; return true;
}

template <class Epi, class Sched, bool ALIGN_EPI>
__device__ __forceinline__ void gemm_phase(LAS unsigned char* lds, const char* A, const int K, const Sched& S, const Epi& E) {
    int tid = threadIdx.x; asm volatile("" : "+v"(tid));
    const int wid = __builtin_amdgcn_readfirstlane(tid >> 6), lane = tid & 63, wr = wid >> 2, wc = wid & 3, fr = lane & 15, fq = lane >> 4;
    const int nt = K / BK;
    int R[2], C[2]; unsigned voffB[2];
#pragma unroll
    for (int i = 0; i < 2; ++i) { stage_rc(tid * 16 + i * 8192, R[i], C[i]); const int Rb = Epi::PERM ? ((R[i] & ~31) + perm32(R[i] & 31)) : R[i]; voffB[i] = (unsigned)(Rb * K + C[i]) * 2u; }
    const size_t kstep = (size_t)(BK * 2);
    const size_t hstep = (size_t)HALF * K * 2;
    const unsigned ldsw = (unsigned)wid * 1024u;
    const int aoff = lds_byte(wr * 64 + fr, fq * 8), boff = lds_byte(wc * 32 + fr, fq * 8);
#define G8_SA(b, h) (((b) * 2 + (h)) * HTB)
#define G8_SB(b, h) ((4 + (b) * 2 + (h)) * HTB)
#define G8_STAGE_B(bufoff, gbase) do { _Pragma("unroll") for (int _i = 0; _i < 2; ++_i) \
        __builtin_amdgcn_global_load_lds((const unsigned*)((const char*)(gbase) + voffB[_i]), (LAS unsigned*)(lds + (bufoff) + ldsw + _i * 8192), 16, 0, 0); } while (0)
#define G8_STAGE_A(bufoff, kb, o0, o1) do { \
        __builtin_amdgcn_global_load_lds((const unsigned*)(A + (size_t)(kb) + (o0)), (LAS unsigned*)(lds + (bufoff) + ldsw), 16, 0, 0); \
        __builtin_amdgcn_global_load_lds((const unsigned*)(A + (size_t)(kb) + (o1)), (LAS unsigned*)(lds + (bufoff) + ldsw + 8192), 16, 0, 0); } while (0)
#define G8_LDA(dst, b, h) do { _Pragma("unroll") for (int m = 0; m < 4; ++m) _Pragma("unroll") for (int k = 0; k < 2; ++k) dst[m][k] = *(const LAS f16x8*)(lds + G8_SA(b, h) + aoff + m * 2048 + k * 1024); } while (0)
#define G8_LDB(dst, b, h) do { _Pragma("unroll") for (int n = 0; n < 2; ++n) _Pragma("unroll") for (int k = 0; k < 2; ++k) dst[n][k] = *(const LAS f16x8*)(lds + G8_SB(b, h) + boff + n * 2048 + k * 1024); } while (0)
#define G8_MMA(ai, bj, At, Bt) do { __builtin_amdgcn_s_setprio(1); _Pragma("unroll") for (int m = 0; m < 4; ++m) _Pragma("unroll") for (int n = 0; n < 2; ++n) _Pragma("unroll") for (int k = 0; k < 2; ++k) \
        acc[ai][bj][m][n] = __builtin_amdgcn_mfma_f32_16x16x32_f16(Bt[n][k], At[m][k], acc[ai][bj][m][n], 0, 0, 0); __builtin_amdgcn_s_setprio(0); } while (0)
#define G8_WAIT_V(n) asm volatile("s_waitcnt vmcnt(" #n ")" ::: "memory")
#define G8_WAIT_L(n) asm volatile("s_waitcnt lgkmcnt(" #n ")" ::: "memory")
#define G8_BAR __builtin_amdgcn_s_barrier()
#define G8_SCHED __builtin_amdgcn_sched_barrier(0)
    Unit cur, nxt; int ui = 0;
    if (!S.next(0, cur, R, C)) return;
    f32x4 acc[2][2][4][2];
#pragma unroll
    for (int a = 0; a < 2; ++a)
#pragma unroll
        for (int b = 0; b < 2; ++b)
#pragma unroll
            for (int m = 0; m < 4; ++m)
#pragma unroll
                for (int n = 0; n < 2; ++n) acc[a][b][m][n] = (f32x4){0.f, 0.f, 0.f, 0.f};
    f16x8 At[4][2], B0[2][2], B1[2][2];
    {
        const char* cB = cur.B;
        G8_STAGE_B(G8_SB(0, 0), cB); G8_STAGE_B(G8_SB(0, 1), cB + hstep); G8_STAGE_A(G8_SA(0, 0), 0, cur.ao[0][0], cur.ao[0][1]); G8_STAGE_A(G8_SA(0, 1), 0, cur.ao[1][0], cur.ao[1][1]);
        if (wr == 1) G8_BAR;
        G8_WAIT_V(2); G8_BAR;
        G8_STAGE_B(G8_SB(1, 0), cB + kstep); G8_STAGE_A(G8_SA(1, 0), kstep, cur.ao[0][0], cur.ao[0][1]); G8_STAGE_B(G8_SB(1, 1), cB + hstep + kstep);
        G8_WAIT_V(6); G8_BAR;
    }
    for (;;) {
        const bool has_next = S.next(ui + 1, nxt, R, C);
        if (!has_next) nxt = cur;
        const char* cB = cur.B; const char* nB = nxt.B;
        for (int t = 0; t < nt; t += 2) {
            const bool last = (t == nt - 2);
            const size_t ka1 = (size_t)(t + 1) * kstep;
            const size_t ka2 = last ? 0 : (size_t)(t + 2) * kstep, ka3 = ka2 + kstep;
            const unsigned o00 = last ? nxt.ao[0][0] : cur.ao[0][0], o01 = last ? nxt.ao[0][1] : cur.ao[0][1], o10 = last ? nxt.ao[1][0] : cur.ao[1][0], o11 = last ? nxt.ao[1][1] : cur.ao[1][1];
            const char* b2 = last ? nB : cB + (size_t)(t + 2) * kstep; const char* b3 = b2 + kstep;
            G8_LDB(B0, 0, 0); G8_LDB(B1, 0, 1); G8_SCHED; G8_LDA(At, 0, 0); G8_STAGE_A(G8_SA(1, 1), ka1, cur.ao[1][0], cur.ao[1][1]);
            G8_WAIT_V(8); G8_WAIT_L(0); G8_BAR; G8_MMA(0, 0, At, B0); G8_MMA(0, 1, At, B1); G8_BAR; G8_SCHED;
            G8_LDA(At, 0, 1); G8_STAGE_B(G8_SB(0, 0), b2); G8_STAGE_B(G8_SB(0, 1), b2 + hstep); G8_STAGE_A(G8_SA(0, 0), ka2, o00, o01);
            G8_WAIT_V(8); G8_WAIT_L(0); G8_BAR; if (cur.full) { G8_MMA(1, 0, At, B0); G8_MMA(1, 1, At, B1); } G8_BAR; G8_SCHED;
            G8_LDB(B0, 1, 0); G8_LDB(B1, 1, 1); G8_SCHED; G8_LDA(At, 1, 0); G8_STAGE_A(G8_SA(0, 1), ka2, o10, o11);
            G8_WAIT_V(8); G8_WAIT_L(0); G8_BAR; G8_MMA(0, 0, At, B0); G8_MMA(0, 1, At, B1); G8_BAR; G8_SCHED;
            G8_LDA(At, 1, 1); G8_STAGE_B(G8_SB(1, 0), b3); G8_STAGE_B(G8_SB(1, 1), b3 + hstep); G8_STAGE_A(G8_SA(1, 0), ka3, o00, o01);
            G8_WAIT_V(8); G8_WAIT_L(0); G8_BAR; if (cur.full) { G8_MMA(1, 0, At, B0); G8_MMA(1, 1, At, B1); } G8_BAR; G8_SCHED;
        }
        if constexpr (ALIGN_EPI) { if (wr == 0) G8_BAR; }
        E(acc, cur, wr, wc, fr, fq);
        if (!has_next) break;
#pragma unroll
        for (int a = 0; a < 2; ++a)
#pragma unroll
            for (int b = 0; b < 2; ++b)
#pragma unroll
                for (int m = 0; m < 4; ++m)
#pragma unroll
                    for (int n = 0; n < 2; ++n) acc[a][b][m][n] = (f32x4){0.f, 0.f, 0.f, 0.f};
        cur = nxt; ++ui;
        if constexpr (ALIGN_EPI) { if (wr == 1) G8_BAR; }
    }
    G8_WAIT_V(0);
    if constexpr (!ALIGN_EPI) { if (wr == 0) G8_BAR; }
    G8_BAR;
#undef G8_SA
#undef G8_SB
#undef G8_STAGE_A
#undef G8_STAGE_B
#undef G8_LDA
#undef G8_LDB
#undef G8_MMA
#undef G8_WAIT_V
#undef G8_WAIT_L
#undef G8_BAR
#undef G8_SCHED
}

struct EpiF32 {
    static constexpr bool PERM = false;
    float* Cc; int ldc;
    __device__ __forceinline__ void operator()(const f32x4 (&acc)[2][2][4][2], const Unit& u, int wr, int wc, int fr, int fq) const {
        const int row0 = u.row0 + wr * 64 + fr, col0 = u.pn * BM + wc * 32 + 4 * fq;
#pragma unroll
        for (int ai = 0; ai < 2; ++ai)
#pragma unroll
            for (int m = 0; m < 4; ++m) { float* rowp = Cc + (size_t)(row0 + ai * HALF + m * 16) * ldc + col0;
#pragma unroll
                for (int bj = 0; bj < 2; ++bj)
#pragma unroll
                    for (int n = 0; n < 2; ++n) *(f32x4*)(rowp + bj * HALF + n * 16) = acc[ai][bj][m][n]; }
    }
};
}

struct ArgTable { LAS const unsigned* base;
    __device__ __forceinline__ const float* operator[](int i) const { const unsigned lo = base[2 * i], hi = base[2 * i + 1];
        const GAS float* g = (const GAS float*)(((unsigned long long)(unsigned)__builtin_amdgcn_readfirstlane(hi) << 32) | (unsigned)__builtin_amdgcn_readfirstlane(lo)); return (const float*)g; } };
struct Frame {
    LAS unsigned char* lds;
    int tid, lane, wave, vcu, G;
    ArgTable in;
    __device__ __forceinline__ float* out() const { return (float*)in[26]; }
    __device__ __forceinline__ unsigned char* ws() const { return (unsigned char*)in[27]; }
};
__device__ __forceinline__ float wave_sum(float v) {
#pragma unroll
    for (int o = 1; o < 64; o <<= 1) v += __shfl_xor(v, o);
    return v;
}
__device__ __forceinline__ float fast_sigmoid(float x) { return 1.0f / (1.0f + __expf(-x)); }
__device__ __forceinline__ float silu_f(float x) { return x * fast_sigmoid(x); }
__device__ __forceinline__ float gelu_f(float x) { const float y = 0.7978845608028654f * (x + 0.044715f * x * x * x); return x * fast_sigmoid(2.0f * y); }
__device__ __forceinline__ unsigned pkh(float a, float b) { f16x2 v; v.x = (f16)a; v.y = (f16)b; return __builtin_bit_cast(unsigned, v); }

struct TItem { const float* W; int ldw, k0, srccol0; f16* WT; int ldt, dstrow0; float scale; };
__device__ __forceinline__ void titem_load(const TItem& t, f32x4 (&tv)[8], int lane) {
    const float* base = t.W + (size_t)t.k0 * t.ldw + t.srccol0;
    const unsigned o0 = (unsigned)(2 * (lane >> 3)) * (unsigned)t.ldw + 4u * (unsigned)(lane & 7), st = 16u * (unsigned)t.ldw;
#pragma unroll
    for (int i = 0; i < 4; ++i) { tv[2 * i] = __builtin_nontemporal_load((const f32x4*)(base + (o0 + (unsigned)i * st))); tv[2 * i + 1] = __builtin_nontemporal_load((const f32x4*)(base + (o0 + (unsigned)i * st + (unsigned)t.ldw))); }
}
__device__ __forceinline__ void titem_store(const TItem& t, const f32x4 (&tv)[8], LAS float* scr, int lane) {
    LAS unsigned* T = (LAS unsigned*)scr; const int r = lane >> 3, n4 = 4 * (lane & 7); const float sc = t.scale;
#pragma unroll
    for (int i = 0; i < 4; ++i) { const f32x4 a = tv[2 * i] * sc, b = tv[2 * i + 1] * sc; LAS unsigned* p = T + n4 * 36 + r + 8 * i;
        p[0] = pkh(a.x, b.x); p[36] = pkh(a.y, b.y); p[72] = pkh(a.z, b.z); p[108] = pkh(a.w, b.w); }
    LDS_WAIT(); asm volatile("" ::: "memory");
    const int c = lane & 7; f16* ob = t.WT + (size_t)t.dstrow0 * t.ldt + t.k0;
    const unsigned oo = (unsigned)(lane >> 3) * (unsigned)t.ldt + 8u * (unsigned)c, ost = 8u * (unsigned)t.ldt;
#pragma unroll
    for (int j = 0; j < 4; ++j) { const u32x4 o = *(const LAS u32x4*)(T + ((lane >> 3) + 8 * j) * 36 + 4 * c);
        __builtin_nontemporal_store(o, (GAS u32x4*)(ob + (oo + (unsigned)j * ost))); }
    LDS_WAIT(); asm volatile("" ::: "memory");
}
__device__ __forceinline__ void transpose_item(const float* W, int ldw, int k0, int srccol0, f16* WT, int ldt, int dstrow0, float scale, LAS float* scr, int lane) {
    TItem t{W, ldw, k0, srccol0, WT, ldt, dstrow0, scale}; f32x4 tv[8]; titem_load(t, tv, lane); titem_store(t, tv, scr, lane);
}
__device__ __forceinline__ int win_srccol(int n0, float& scale) {
    const int t = n0 >> 8, c = n0 & 255; scale = 1.0f;
    if (t >= 8 && t < 16) {
        const int hl = 2 * (t & 3) + ((c & 127) >> 6), dim = (c & 63) + 64 * (c >> 7);
        if (t >= 12) scale = 0.08838834764831845f;
        return (t >= 12 ? 3072 : 2048) + hl * 128 + dim;
    }
    return n0;
}
__device__ __forceinline__ void p0_prologue(Frame& F) {
    LAS float* scr = (LAS float*)(F.lds + RING_OFF + F.wave * 16384);
    const int gw = F.vcu * NWAVES + F.wave, NGW = F.G * NWAVES;
    {
        LAS float* sc = (LAS float*)(F.lds + RING_OFF);
        LAS float* red = sc + 3 * 2048;
        const float* c = F.in[1]; const float* cc = F.in[3]; const float* wm = F.in[4]; const float* bm = F.in[5];
        for (int i = F.tid; i < 3 * 2048; i += 512) { const float v = i < 4096 ? c[i] : cc[i - 4096]; sc[i] = silu_f(v); }
        __syncthreads();
        for (int cb = F.vcu; cb < 256; cb += F.G) {
            const int col0 = cb * 48;
            const int r = F.lane / 12, c4 = F.lane % 12;
            f32x4 a0 = {0, 0, 0, 0}, a1 = {0, 0, 0, 0}, a2 = {0, 0, 0, 0};
            if (F.lane < 60) {
                for (int kb = F.wave * 5 + r; kb < 2048; kb += 320) {
                    f32x4 wv[8];
#pragma unroll
                    for (int j = 0; j < 8; ++j) { const int k = kb + 40 * j; wv[j] = (k < 2048) ? *(const f32x4*)(wm + (size_t)k * 12288 + col0 + 4 * c4) : (f32x4){0.f, 0.f, 0.f, 0.f}; }
#pragma unroll
                    for (int j = 0; j < 8; ++j) { const int k = (kb + 40 * j) & 2047; a0 += wv[j] * sc[k]; a1 += wv[j] * sc[2048 + k]; a2 += wv[j] * sc[4096 + k]; }
                }
                LAS float* rp = red + ((F.wave * 5 + r) * 3) * 48 + 4 * c4;
                *(LAS f32x4*)(rp) = a0; *(LAS f32x4*)(rp + 48) = a1; *(LAS f32x4*)(rp + 96) = a2;
            }
            __syncthreads();
            if (F.tid < 144) { float s = 0.f; for (int j = 0; j < 40; ++j) s += red[j * 144 + F.tid];
                const int v = F.tid / 48, cl = F.tid % 48; ((float*)(F.ws() + WS_MOD))[v * 12288 + col0 + cl] = s + bm[col0 + cl]; }
            __syncthreads();
        }
    }
    if (F.vcu == 0) { float* rope = (float*)(F.ws() + WS_ROPE);
        for (int i = F.tid; i < 2048; i += 512) { const int pos = i >> 5, j = i & 31; const float inv = powf(10000.0f, -(float)j / 32.0f); const float ang = (float)pos * inv;
            rope[i] = cosf(ang); rope[2048 + i] = sinf(ang); } }
    { const float* rw = F.in[17]; f16* rh = (f16*)(F.ws() + WS_RWT); f16* rl = rh + NE * DM;
      for (int idx = F.vcu * 512 + F.tid; idx < NE * DM; idx += F.G * 512) { const int k = idx >> 6, e = idx & 63; const float v = rw[idx]; const f16 hi = (f16)v; rh[e * DM + k] = hi; rl[e * DM + k] = (f16)((v - (float)hi) * 2048.0f); } }
    constexpr int I_IN = 32 * 192, I_OUT = 32 * 64;
    for (int it = gw; it < I_IN + I_OUT; it += NGW) {
        int r = it;
        if (r < I_IN) { const int kb = r / 192, nb = r % 192; float scale; const int src = win_srccol(nb * 32, scale);
            transpose_item(F.in[8], INC, kb * 64, src, (f16*)(F.ws() + WS_WINT), DM, nb * 32, scale, scr, F.lane); continue; }
        r -= I_IN;
        { const int kb = r / 64, nb = r % 64; transpose_item(F.in[16], DM, kb * 64, nb * 32, (f16*)(F.ws() + WS_WOUTT), DM, nb * 32, 1.0f, scr, F.lane); }
    }
}
__device__ __forceinline__ TItem expert_item(Frame& F, int it) {
    constexpr int I_E = 1536; const int e = it / I_E; int r = it % I_E; TItem t;
    if (r < 1024) {
        const int kb = r / 32, nb = r % 32, pn = nb >> 3, wi = nb & 7;
        t.W = (e < NE) ? ((wi < 4 ? F.in[19] : F.in[20]) + (size_t)e * DM * EH) : (wi < 4 ? F.in[22] : F.in[23]);
        t.ldw = EH; t.k0 = kb * 64; t.srccol0 = pn * 128 + (wi & 3) * 32; t.WT = (f16*)(F.ws() + WS_W13T) + (size_t)e * 1024 * DM; t.ldt = DM; t.dstrow0 = nb * 32; t.scale = 1.0f;
    } else {
        r -= 1024; const int kb = r / 64, nb = r % 64;
        t.W = (e < NE) ? (F.in[21] + (size_t)e * EH * DM) : F.in[24];
        t.ldw = DM; t.k0 = kb * 64; t.srccol0 = nb * 32; t.WT = (f16*)(F.ws() + WS_W2T) + (size_t)e * DM * EH; t.ldt = EH; t.dstrow0 = nb * 32; t.scale = 1.0f;
    }
    return t;
}
__device__ __forceinline__ void p2_expert_copies(Frame& F) {
    LAS float* scr = (LAS float*)(F.lds + RING_OFF + F.wave * 16384);
    constexpr int NIT = NE1 * 1536, N_CTXWG = 64, SH_CTX = 292, SH_REG = (NIT - N_CTXWG * SH_CTX) / 192, REM = (NIT - N_CTXWG * SH_CTX) % 192;
    int lo, n;
    if (F.vcu < N_CTXWG) { lo = F.vcu * SH_CTX; n = SH_CTX; }
    else { const int v = F.vcu - N_CTXWG; lo = N_CTXWG * SH_CTX + v * SH_REG + (v < REM ? v : REM); n = SH_REG + (v < REM ? 1 : 0); }
    const int hi = lo + n;
    TItem t0, t1, t2; f32x4 v0[8], v1[8], v2[8];
    int it = lo + F.wave;
    if (it < hi) { t0 = expert_item(F, it); titem_load(t0, v0, F.lane); }
    if (it + NWAVES < hi) { t1 = expert_item(F, it + NWAVES); titem_load(t1, v1, F.lane); }
    for (; it < hi; it += 3 * NWAVES) {
        if (it + 2 * NWAVES < hi) { t2 = expert_item(F, it + 2 * NWAVES); titem_load(t2, v2, F.lane); }
        titem_store(t0, v0, scr, F.lane);
        if (it + 3 * NWAVES < hi) { t0 = expert_item(F, it + 3 * NWAVES); titem_load(t0, v0, F.lane); }
        if (it + NWAVES < hi) titem_store(t1, v1, scr, F.lane);
        if (it + 4 * NWAVES < hi) { t1 = expert_item(F, it + 4 * NWAVES); titem_load(t1, v1, F.lane); }
        if (it + 2 * NWAVES < hi) titem_store(t2, v2, scr, F.lane);
    }
}

constexpr int IMG_LD = 136;
constexpr int IMG_BYTES = 128 * IMG_LD * 2;
__device__ __forceinline__ void wave_mma(f32x4 (&acc)[8], const f16x8 (&a)[4], const LAS f16* img, int fr, int fq) {
#pragma unroll
    for (int ks = 0; ks < 4; ++ks) { __builtin_amdgcn_sched_barrier(0);
#pragma unroll
        for (int t = 0; t < 8; ++t) { const f16x8 b = *(const LAS f16x8*)(img + (16 * t + fr) * IMG_LD + 32 * ks + 8 * fq); acc[t] = __builtin_amdgcn_mfma_f32_16x16x32_f16(b, a[ks], acc[t], 0, 0, 0); } }
    __builtin_amdgcn_sched_barrier(0);
}
__device__ __forceinline__ void zero8(f32x4 (&acc)[8]) {
#pragma unroll
    for (int t = 0; t < 8; ++t) acc[t] = (f32x4){0.f, 0.f, 0.f, 0.f};
}
__device__ __forceinline__ void stage_rows(LAS f16* img, const f16* src, int ld, int tid) {
#pragma unroll
    for (int it = 0; it < 4; ++it) { const int r = (tid >> 4) + 32 * it, cc = (tid & 15) * 8; *(LAS u32x4*)(img + r * IMG_LD + cc) = *(const u32x4*)(src + (size_t)r * ld + cc); }
}
__device__ __forceinline__ void stage_rows_f32(LAS f16* img, const float* src, int tid) {
#pragma unroll
    for (int it = 0; it < 8; ++it) { const int r = (tid >> 5) + 16 * it, cc = (tid & 31) * 4; const f32x4 v = *(const f32x4*)(src + (size_t)r * 128 + cc);
        u32x2 o; o.x = pkh(v.x, v.y); o.y = pkh(v.z, v.w); *(LAS u32x2*)(img + r * IMG_LD + cc) = o; }
}


__device__ __forceinline__ void p2_ctx_unit(Frame& F, int u) {
    const int rb = u >> 4, cb = u & 15, h = cb & 7; const bool isv = cb >= 8;
    const f16* HXc = (const f16*)(F.ws() + WS_HX) + (size_t)(NTOK + rb * 128) * DM; const f16* WT = (const f16*)(F.ws() + WS_WINT);
    LAS f16* imA = (LAS f16*)(F.lds); LAS f16* imB = (LAS f16*)(F.lds + IMG_BYTES);
    const int fr = F.lane & 15, fq = F.lane >> 4, w = F.wave;
    const int r0 = F.tid >> 4, cc = (F.tid & 15) * 8;
    const f16* ap[4]; const f16* bp[4];
#pragma unroll
    for (int it = 0; it < 4; ++it) { const int r = r0 + 32 * it; ap[it] = HXc + (size_t)r * DM + cc;
        const int brow = isv ? (4096 + h * 128 + r) : ((12 + (h >> 1)) * 256 + (r >> 6) * 128 + (h & 1) * 64 + (r & 63)); bp[it] = WT + (size_t)brow * DM + cc; }
    u32x4 aw[4], bw[4];
#pragma unroll
    for (int it = 0; it < 4; ++it) { aw[it] = *(const u32x4*)(ap[it]); bw[it] = *(const u32x4*)(bp[it]); }
    f32x4 acc[8]; zero8(acc);
    for (int kc = 0; kc < 16; ++kc) {
#pragma unroll
        for (int it = 0; it < 4; ++it) { const int r = r0 + 32 * it; *(LAS u32x4*)(imA + r * IMG_LD + cc) = aw[it]; *(LAS u32x4*)(imB + r * IMG_LD + cc) = bw[it]; }
        if (kc < 15) {
#pragma unroll
            for (int it = 0; it < 4; ++it) { aw[it] = *(const u32x4*)(ap[it] + (kc + 1) * 128); bw[it] = *(const u32x4*)(bp[it] + (kc + 1) * 128); } }
        __syncthreads();
        f16x8 a[4];
#pragma unroll
        for (int ks = 0; ks < 4; ++ks) a[ks] = *(const LAS f16x8*)(imA + (16 * w + fr) * IMG_LD + 32 * ks + 8 * fq);
        wave_mma(acc, a, imB, fr, fq);
        __syncthreads();
    }
    f16* dst = (f16*)(F.ws() + (isv ? WS_CV : WS_CK)) + (size_t)(rb * 128 + 16 * w + fr) * AW + h * 128;
#pragma unroll
    for (int t = 0; t < 8; ++t) { u32x2 o; o.x = pkh(acc[t].x, acc[t].y); o.y = pkh(acc[t].z, acc[t].w); *(u32x2*)(dst + 16 * t + 4 * fq) = o; }
}
__device__ __forceinline__ void p1_norm(Frame& F) {
    const int gw = F.vcu * NWAVES + F.wave, NGW = F.G * NWAVES;
    const float* g1 = F.in[6]; const float* xin = F.in[0]; const float* cin = F.in[2]; const float* modb = (const float*)(F.ws() + WS_MOD); f16* HX = (f16*)(F.ws() + WS_HX);
    f32x4 nx[8];
    { const int row = gw; const float* xr = row < NTOK ? xin + (size_t)row * DM : cin + (size_t)(row - NTOK) * DM;
#pragma unroll
      for (int j = 0; j < 8; ++j) nx[j] = *(const f32x4*)(xr + 4 * F.lane + 256 * j); }
    for (int row = gw; row < NROWS_IN; row += NGW) {
        f32x4 v[8]; float ss = 0.f;
#pragma unroll
        for (int j = 0; j < 8; ++j) { v[j] = nx[j]; ss += (v[j].x * v[j].x + v[j].y * v[j].y) + (v[j].z * v[j].z + v[j].w * v[j].w); }
        { const int r2 = row + NGW; if (r2 < NROWS_IN) { const float* xr = r2 < NTOK ? xin + (size_t)r2 * DM : cin + (size_t)(r2 - NTOK) * DM;
#pragma unroll
            for (int j = 0; j < 8; ++j) nx[j] = *(const f32x4*)(xr + 4 * F.lane + 256 * j); } }
        const float* mod = modb + (row < NTOK ? (row >> 12) : 2) * 12288;
        const float rstd = 1.0f / sqrtf(wave_sum(ss) * (1.0f / DM) + EPS);
        f16* orow = HX + (size_t)row * DM;
#pragma unroll
        for (int j = 0; j < 8; ++j) { const int col = 4 * F.lane + 256 * j;
            const f32x4 g = *(const f32x4*)(g1 + col), sh = *(const f32x4*)(mod + col), sc = *(const f32x4*)(mod + 2048 + col);
            const f32x4 h = (v[j] * rstd * g) * (sc + 1.0f) + sh;
            u32x2 o; o.x = pkh(h.x, h.y); o.y = pkh(h.z, h.w); *(u32x2*)(orow + col) = o; }
    }
}

struct InSched { int G, c; const char* Bt; int ulo, uhi;
    __device__ __forceinline__ bool next(int i, g8::Unit& u, const int (&R)[2], const int (&C)[2]) const {
        if (i + ulo >= uhi) return false; const int L = (i + ulo) * G + c; int pm, pn;
        if (!g8::dense_order(L, 32, 24, pm, pn)) return false;
#pragma unroll
        for (int h = 0; h < 2; ++h)
#pragma unroll
            for (int k = 0; k < 2; ++k) u.ao[h][k] = (unsigned)((pm * 256 + h * 128 + R[k]) * DM + C[k]) * 2u;
        u.B = Bt + (size_t)pn * 256 * DM * 2; u.row0 = pm * 256; u.pn = pn; u.aux = 0; u.full = 1;
        return true;
    }
};

struct EpiIn {
    static constexpr bool PERM = true;
    f16* PB; f16* CK; f16* CV; float* vstp; const float* rope;
    __device__ __forceinline__ void operator()(const f32x4 (&acc)[2][2][4][2], const g8::Unit& u, int wr, int wc, int fr, int fq) const {
        const int pn = u.pn, ty = pn >> 2; const bool ctx = u.row0 >= NTOK;
        const int c1 = wc * 32 + 8 * fq;
        if (ty == 2 || ty == 3) {
            const int head = 2 * (pn & 3) + (wc >> 1), i0 = c1 & 63, isq = (ty == 2);
            f16* dstb = ctx ? CK : (PB + (size_t)(isq ? 2 : 3) * NTOK * AW);
#pragma unroll
            for (int ai = 0; ai < 2; ++ai)
#pragma unroll
                for (int m = 0; m < 4; ++m) { const int row = u.row0 + ai * 128 + wr * 64 + m * 16 + fr;
                    const f32x4 a0 = acc[ai][0][m][0], a1 = acc[ai][0][m][1], b0 = acc[ai][1][m][0], b1 = acc[ai][1][m][1];
                    f32x4 c0 = {1.f, 1.f, 1.f, 1.f}, c1v = c0, s0 = {0.f, 0.f, 0.f, 0.f}, s1 = s0;
                    if (!ctx) { const int tpos = row & (SEQ - 1); const int pos = (wc & 1) ? (tpos & 63) : (tpos >> 6); const float* rp = rope + pos * 32 + (i0 & 31);
                        c0 = *(const f32x4*)(rp); c1v = *(const f32x4*)(rp + 4); s0 = *(const f32x4*)(rp + 2048); s1 = *(const f32x4*)(rp + 2052); }
                    const f32x4 o1a = a0 * c0 - b0 * s0, o1b = a1 * c1v - b1 * s1, o2a = a0 * s0 + b0 * c0, o2b = a1 * s1 + b1 * c1v;
                    const int drow = ctx ? row - NTOK : row;
                    f16* d = dstb + (size_t)drow * AW + head * 128 + i0;
                    u32x4 w1; w1.x = pkh(o1a[0], o1a[1]); w1.y = pkh(o1a[2], o1a[3]); w1.z = pkh(o1b[0], o1b[1]); w1.w = pkh(o1b[2], o1b[3]);
                    u32x4 w2; w2.x = pkh(o2a[0], o2a[1]); w2.y = pkh(o2a[2], o2a[3]); w2.z = pkh(o2b[0], o2b[1]); w2.w = pkh(o2b[2], o2b[3]);
                    *(u32x4*)d = w1; *(u32x4*)(d + 64) = w2; }
            return;
        }
        const int sel = (ty == 0) ? 0 : (ty == 1) ? 1 : (ty == 4) ? 4 : 5;
        f16* dstb = (ctx ? CV : PB + (size_t)sel * NTOK * AW) + (pn & 3) * 256 + c1;
#pragma unroll
        for (int ai = 0; ai < 2; ++ai)
#pragma unroll
            for (int m = 0; m < 4; ++m) { const int row = u.row0 + ai * 128 + wr * 64 + m * 16 + fr; const int drow = ctx ? row - NTOK : row;
                float s = 0.f, q = 0.f;
#pragma unroll
                for (int bj = 0; bj < 2; ++bj) { f32x4 v0 = acc[ai][bj][m][0], v1 = acc[ai][bj][m][1];
                    if (ty <= 1) {
#pragma unroll
                        for (int j = 0; j < 4; ++j) { v0[j] = gelu_f(v0[j]); v1[j] = gelu_f(v1[j]); } }
                    else if (ty == 5) {
#pragma unroll
                        for (int j = 0; j < 4; ++j) { v0[j] = silu_f(v0[j]); v1[j] = silu_f(v1[j]); } }
                    if (ty == 1) { s += (v0[0] + v0[1]) + (v0[2] + v0[3]) + (v1[0] + v1[1]) + (v1[2] + v1[3]);
                        q += (v0[0] * v0[0] + v0[1] * v0[1]) + (v0[2] * v0[2] + v0[3] * v0[3]) + (v1[0] * v1[0] + v1[1] * v1[1]) + (v1[2] * v1[2] + v1[3] * v1[3]); }
                    u32x4 o; o.x = pkh(v0[0], v0[1]); o.y = pkh(v0[2], v0[3]); o.z = pkh(v1[0], v1[1]); o.w = pkh(v1[2], v1[3]);
                    *(u32x4*)(dstb + (size_t)drow * AW + bj * 128) = o; }
                if (ty == 1) { s += __shfl_xor(s, 16); s += __shfl_xor(s, 32); q += __shfl_xor(q, 16); q += __shfl_xor(q, 32);
                    if (fq == 0) { f32x2 st; st.x = s; st.y = q; *(f32x2*)(vstp + ((size_t)row * 16 + (pn & 3) * 4 + wc) * 2) = st; } } }
    }
};
struct EpiX1 {
    static constexpr bool PERM = false;
    const float* x; const float* mod; float* X1;
    __device__ __forceinline__ void operator()(const f32x4 (&acc)[2][2][4][2], const g8::Unit& u, int wr, int wc, int fr, int fq) const {
        const int row0 = u.row0 + wr * 64 + fr, col0 = u.pn * 256 + wc * 32 + 4 * fq;
        const float* g1 = mod + (u.row0 >> 12) * 12288 + 2 * 2048;
        f32x4 gv[2][2];
#pragma unroll
        for (int bj = 0; bj < 2; ++bj)
#pragma unroll
            for (int n = 0; n < 2; ++n) gv[bj][n] = *(const f32x4*)(g1 + col0 + bj * 128 + n * 16);
#pragma unroll
        for (int ai = 0; ai < 2; ++ai)
#pragma unroll
            for (int m = 0; m < 4; ++m) { const size_t off = (size_t)(row0 + ai * 128 + m * 16) * DM + col0;
#pragma unroll
                for (int bj = 0; bj < 2; ++bj)
#pragma unroll
                    for (int n = 0; n < 2; ++n) { const f32x4 xv = *(const f32x4*)(x + off + bj * 128 + n * 16); *(f32x4*)(X1 + off + bj * 128 + n * 16) = xv + gv[bj][n] * acc[ai][bj][m][n]; }
                if (m & 1) asm volatile("" ::: "memory"); }
    }
};
__device__ __forceinline__ void p3_post(Frame& F) {
    const int gw = F.vcu * NWAVES + F.wave, NGW = F.G * NWAVES;
    const float* CB = (const float*)(F.ws() + WS_CBUF);
    f16* UG = (f16*)(F.ws() + WS_PBUF); f16* VG = UG + (size_t)NTOK * AW; f16* Qb = VG + (size_t)NTOK * AW; f16* Kb = Qb + (size_t)NTOK * AW; f16* VR = Kb + (size_t)NTOK * AW; f16* GS = VR + (size_t)NTOK * AW;
    f16* CK = (f16*)(F.ws() + WS_CK); f16* CV = (f16*)(F.ws() + WS_CV);
    const float* rope = (const float*)(F.ws() + WS_ROPE);
    float* vstat = (float*)(F.ws() + WS_VSTAT);
    for (int row = gw; row < NROWS_IN; row += NGW) {
        const float* cr = CB + (size_t)row * INC;
        if (row < NTOK) {
            float gv[16]; float s = 0.f;
#pragma unroll
            for (int j = 0; j < 4; ++j) { const int col = 256 * j + 4 * F.lane;
                const f32x4 u = *(const f32x4*)(cr + col); u32x2 o; o.x = pkh(gelu_f(u.x), gelu_f(u.y)); o.y = pkh(gelu_f(u.z), gelu_f(u.w)); *(u32x2*)(UG + (size_t)row * AW + col) = o;
                const f32x4 v = *(const f32x4*)(cr + 1024 + col); gv[4 * j] = gelu_f(v.x); gv[4 * j + 1] = gelu_f(v.y); gv[4 * j + 2] = gelu_f(v.z); gv[4 * j + 3] = gelu_f(v.w);
                s += (gv[4 * j] + gv[4 * j + 1]) + (gv[4 * j + 2] + gv[4 * j + 3]);
                u32x2 o2; o2.x = pkh(gv[4 * j], gv[4 * j + 1]); o2.y = pkh(gv[4 * j + 2], gv[4 * j + 3]); *(u32x2*)(VG + (size_t)row * AW + col) = o2;
                const f32x4 w = *(const f32x4*)(cr + 4096 + col); u32x2 o3; o3.x = pkh(w.x, w.y); o3.y = pkh(w.z, w.w); *(u32x2*)(VR + (size_t)row * AW + col) = o3;
                const f32x4 g = *(const f32x4*)(cr + 5120 + col); u32x2 o4; o4.x = pkh(silu_f(g.x), silu_f(g.y)); o4.y = pkh(silu_f(g.z), silu_f(g.w)); *(u32x2*)(GS + (size_t)row * AW + col) = o4; }
            const float mean = wave_sum(s) * (1.0f / AW); float q = 0.f;
#pragma unroll
            for (int j = 0; j < 16; ++j) { const float d = gv[j] - mean; q += d * d; }
            const float rstd = 1.0f / sqrtf(wave_sum(q) * (1.0f / AW) + EPS);
            if (F.lane == 0) { vstat[2 * row] = mean; vstat[2 * row + 1] = rstd; }
            const int tpos = row & (SEQ - 1), rpos = tpos >> 6, cpos = tpos & 63;
            for (int t = 8; t < 16; ++t) {
#pragma unroll
                for (int cc = 0; cc < 2; ++cc) { const int c = F.lane + 64 * cc;
                    const float x1 = cr[256 * t + c], x2 = cr[256 * t + 128 + c];
                    const int head = 2 * (t & 3) + (c >> 6), i = c & 63;
                    const int ri = (i < 32) ? (rpos * 32 + i) : (cpos * 32 + (i - 32));
                    const float cs = rope[ri], sn = rope[2048 + ri];
                    f16* dst = (t < 12 ? Qb : Kb) + (size_t)row * AW + head * 128 + i;
                    dst[0] = (f16)(x1 * cs - x2 * sn); dst[64] = (f16)(x1 * sn + x2 * cs); }
            }
        } else {
            const int rc = row - NTOK;
            for (int t = 12; t < 16; ++t) {
#pragma unroll
                for (int cc = 0; cc < 2; ++cc) { const int c = F.lane + 64 * cc; const float x1 = cr[256 * t + c], x2 = cr[256 * t + 128 + c];
                    const int head = 2 * (t & 3) + (c >> 6), i = c & 63; f16* dst = CK + (size_t)rc * AW + head * 128 + i; dst[0] = (f16)x1; dst[64] = (f16)x2; }
            }
#pragma unroll
            for (int j = 0; j < 4; ++j) { const int col = 256 * j + 4 * F.lane; const f32x4 w = *(const f32x4*)(cr + 4096 + col); u32x2 o3; o3.x = pkh(w.x, w.y); o3.y = pkh(w.z, w.w); *(u32x2*)(CV + (size_t)rc * AW + col) = o3; }
        }
    }
}

__device__ __forceinline__ size_t st_index(int dir, int bh, int slot) { return ((size_t)(dir * 16 + bh) * 33 + slot) * 16384; }
__device__ __forceinline__ void p4_naive(Frame& F) {
    const int gt = F.vcu * 512 + F.tid, NGT = F.G * 512;
    const f16* UG = (const f16*)(F.ws() + WS_PBUF); const f16* VG = UG + (size_t)NTOK * AW; const f16* Kb = VG + (size_t)2 * NTOK * AW; const f16* VR = Kb + (size_t)NTOK * AW;
    const f16* CK = (const f16*)(F.ws() + WS_CK); const f16* CV = (const f16*)(F.ws() + WS_CV);
    const float* vstat = (const float*)(F.ws() + WS_VSTAT);
    const float* alng = F.in[9]; const float* aws = F.in[10]; const float* abs_ = F.in[11];
    const float* lgf = F.in[13]; const float* lgb = F.in[14];
    float* ARAW = (float*)(F.ws() + WS_ARAW);
    float* ST = (float*)(F.ws() + WS_ST);
    for (int idx = gt; idx < NTOK * AW; idx += NGT) {
        const int t = idx >> 10, j = idx & 1023, h = j >> 7, p = t & 127, t0 = t - p;
        float s = abs_[h * 128 + p]; const float g = alng[j]; const float* wrow = aws + (size_t)(h * 128 + p) * 128;
        for (int q = 0; q < 128; ++q) { const float vn = ((float)VG[(size_t)(t0 + q) * AW + j] - vstat[2 * (t0 + q)]) * vstat[2 * (t0 + q) + 1] * g; s += wrow[q] * vn; }
        ARAW[idx] = (float)UG[idx] * s;
    }
    for (int idx = gt; idx < 2 * 16 * 16384; idx += NGT) {
        const int d = idx & 127, v = (idx >> 7) & 127, bh = (idx >> 14) & 15, dir = idx >> 18, b = bh >> 3, h = bh & 7;
        const float lg = dir ? lgb[h] : lgf[h]; float s = 0.f;
        for (int l = 0; l < CTXL; ++l) { const float w = __expf(lg * (dir ? (float)l : (float)(CTXL - 1 - l)));
            s += w * (float)CV[(size_t)(b * CTXL + l) * AW + h * 128 + v] * (float)CK[(size_t)(b * CTXL + l) * AW + h * 128 + d]; }
        ST[st_index(dir, bh, 0) + v * 128 + d] = s;
    }
    for (int idx = gt; idx < 2 * 16 * 32 * 16384; idx += NGT) {
        const int d = idx & 127, v = (idx >> 7) & 127, i = (idx >> 14) & 31, bh = (idx >> 19) & 15, dir = idx >> 23, b = bh >> 3, h = bh & 7;
        const float lg = dir ? lgb[h] : lgf[h]; float s = 0.f; const size_t t0 = (size_t)b * SEQ + i * CHK;
        for (int m = 0; m < CHK; ++m) { const float w = __expf(lg * (dir ? (float)m : (float)(CHK - 1 - m)));
            s += w * (float)VR[(t0 + m) * AW + h * 128 + v] * (float)Kb[(t0 + m) * AW + h * 128 + d]; }
        ST[st_index(dir, bh, dir ? 32 - i : i + 1) + v * 128 + d] = s;
    }
}

__device__ __forceinline__ void p4_fast(Frame& F) {
    const f16* UG = (const f16*)(F.ws() + WS_PBUF); const f16* VG = UG + (size_t)NTOK * AW; const f16* Kb = VG + (size_t)2 * NTOK * AW; const f16* VR = Kb + (size_t)NTOK * AW;
    const f16* CK = (const f16*)(F.ws() + WS_CK); const f16* CV = (const f16*)(F.ws() + WS_CV);
    const float* vstat = (const float*)(F.ws() + WS_VSTAT);
    const float* alng = F.in[9]; const float* aws = F.in[10]; const float* abs_ = F.in[11];
    const float* lgf = F.in[13]; const float* lgb = F.in[14];
    float* ARAW = (float*)(F.ws() + WS_ARAW); float* ST = (float*)(F.ws() + WS_ST);
    LAS f16* im0 = (LAS f16*)(F.lds); LAS f16* im1 = (LAS f16*)(F.lds + IMG_BYTES); LAS f16* im2 = (LAS f16*)(F.lds + 2 * IMG_BYTES);
    const int fr = F.lane & 15, fq = F.lane >> 4, w = F.wave;
    constexpr int NU_MLP = 512, NU_LOC = 512, NU_CTX = 32, NU = NU_MLP + NU_LOC + NU_CTX;
    for (int u = F.vcu; u < NU; u += F.G) {
        if (u < NU_MLP) {
            const int h = u & 7, ci = u >> 3, t0 = ci * CHK, hc = h * 128;
            float mean, rstd; { const float* pp = vstat + (size_t)(t0 + (F.tid & 127)) * 32; float ssum = 0.f, qsum = 0.f;
#pragma unroll
                for (int k = 0; k < 16; ++k) { const f32x2 st = *(const f32x2*)(pp + 2 * k); ssum += st.x; qsum += st.y; }
                mean = ssum * (1.0f / AW); rstd = 1.0f / sqrtf(fmaxf(qsum * (1.0f / AW) - mean * mean, 0.f) + EPS); }
#pragma unroll
            for (int it = 0; it < 4; ++it) { const int q = F.tid & 127, cc = ((F.tid >> 7) + 4 * it) * 8;
                const f16x8 v = *(const f16x8*)(VG + (size_t)(t0 + q) * AW + hc + cc);
#pragma unroll
                for (int j = 0; j < 8; ++j) im0[(cc + j) * IMG_LD + q] = (f16)(((float)v[j] - mean) * rstd * alng[hc + cc + j]); }
            f16x8 a[4]; const float* wrow = aws + (size_t)(hc + 16 * w + fr) * 128;
#pragma unroll
            for (int ks = 0; ks < 4; ++ks) { const f32x4 x0 = *(const f32x4*)(wrow + 32 * ks + 8 * fq), x1 = *(const f32x4*)(wrow + 32 * ks + 8 * fq + 4);
                a[ks][0] = (f16)x0.x; a[ks][1] = (f16)x0.y; a[ks][2] = (f16)x0.z; a[ks][3] = (f16)x0.w; a[ks][4] = (f16)x1.x; a[ks][5] = (f16)x1.y; a[ks][6] = (f16)x1.z; a[ks][7] = (f16)x1.w; }
            __syncthreads();
            f32x4 acc[8]; zero8(acc); wave_mma(acc, a, im0, fr, fq);
            const int p = 16 * w + fr; const float bias = abs_[hc + p];
#pragma unroll
            for (int t = 0; t < 8; ++t) { const int d = 16 * t + 4 * fq; const f16x4 ug = *(const f16x4*)(UG + (size_t)(t0 + p) * AW + hc + d);
                f32x4 o; o.x = (float)ug.x * (acc[t].x + bias); o.y = (float)ug.y * (acc[t].y + bias); o.z = (float)ug.z * (acc[t].z + bias); o.w = (float)ug.w * (acc[t].w + bias);
                *(f32x4*)(ARAW + (size_t)(t0 + p) * AW + hc + d) = o; }
            __syncthreads();
        } else {
            const bool isctx = (u >= NU_MLP + NU_LOC); const int uu = isctx ? (u - NU_MLP - NU_LOC) : (u - NU_MLP);
            const int bh = isctx ? (uu >> 1) : (uu >> 5), i = isctx ? 0 : (uu & 31), b = bh >> 3, h = bh & 7, hc = h * 128, chf = uu & 1;
            const float lf = lgf[h], lb = lgb[h];
            f32x4 af[8], ab[8]; zero8(af); zero8(ab);
            { const int hf = isctx ? chf : 0;
                const f16* ksrc = isctx ? (CK + (size_t)(b * CTXL + hf * 128) * AW + hc) : (Kb + (size_t)(b * SEQ + i * CHK) * AW + hc);
                const f16* vsrc = isctx ? (CV + (size_t)(b * CTXL + hf * 128) * AW + hc) : (VR + (size_t)(b * SEQ + i * CHK) * AW + hc);
                const int L = isctx ? CTXL : CHK;
#pragma unroll
                for (int it = 0; it < 4; ++it) { const int m = F.tid & 127, cc = ((F.tid >> 7) + 4 * it) * 8; const int l = hf * 128 + m;
                    const f16x8 kv = *(const f16x8*)(ksrc + (size_t)m * AW + cc); const f16x8 vv = *(const f16x8*)(vsrc + (size_t)m * AW + cc);
                    const float wf = __expf(lf * (float)(L - 1 - l)), wb = __expf(lb * (float)l);
#pragma unroll
                    for (int j = 0; j < 8; ++j) { im0[(cc + j) * IMG_LD + m] = vv[j]; im1[(cc + j) * IMG_LD + m] = (f16)((float)kv[j] * wf); im2[(cc + j) * IMG_LD + m] = (f16)((float)kv[j] * wb); } }
                __syncthreads();
                f16x8 a[4];
#pragma unroll
                for (int ks = 0; ks < 4; ++ks) a[ks] = *(const LAS f16x8*)(im0 + (16 * w + fr) * IMG_LD + 32 * ks + 8 * fq);
                wave_mma(af, a, im1, fr, fq); wave_mma(ab, a, im2, fr, fq);
                __syncthreads();
            }
            const int sf = isctx ? (chf ? 32 : 0) : i + 1, sb = isctx ? (chf ? 32 : 0) : 32 - i;
            float* df = ST + st_index(0, bh, sf) + (16 * w + fr) * 128; float* db = ST + st_index(1, bh, sb) + (16 * w + fr) * 128;
            if (isctx || sf != 32) {
#pragma unroll
                for (int t = 0; t < 8; ++t) *(f32x4*)(df + 16 * t + 4 * fq) = af[t]; }
            if (isctx || sb != 32) {
#pragma unroll
                for (int t = 0; t < 8; ++t) *(f32x4*)(db + 16 * t + 4 * fq) = ab[t]; }
        }
    }
}
__device__ __forceinline__ void p6_fast(Frame& F) {
    const f16* Qb = (const f16*)(F.ws() + WS_PBUF) + (size_t)2 * NTOK * AW; const f16* Kb = Qb + (size_t)NTOK * AW; const f16* VR = Kb + (size_t)NTOK * AW; const f16* GS = VR + (size_t)NTOK * AW;
    const float* ST = (const float*)(F.ws() + WS_ST);
    const float* lgf = F.in[13]; const float* lgb = F.in[14]; const float* gng = F.in[15]; f16* AR = (f16*)(F.ws() + WS_AR);
    LAS f16* imK = (LAS f16*)(F.lds); LAS f16* imV = (LAS f16*)(F.lds + IMG_BYTES); LAS f16* imS = (LAS f16*)(F.lds + 2 * IMG_BYTES); LAS f16* imP = (LAS f16*)(F.lds + 3 * IMG_BYTES);
    const int fr = F.lane & 15, fq = F.lane >> 4, w = F.wave;
    constexpr float L2E = 1.4426950408889634f;
    for (int u = F.vcu; u < 512; u += F.G) {
        const int bh = u >> 5, i = u & 31, b = bh >> 3, h = bh & 7, hc = h * 128; const size_t t0 = (size_t)b * SEQ + i * CHK;
        const float lf = lgf[h] * L2E, lb = lgb[h] * L2E;
        stage_rows(imK, Kb + t0 * AW + hc, AW, F.tid);
#pragma unroll
        for (int it = 0; it < 4; ++it) { const int m = F.tid & 127, cc = ((F.tid >> 7) + 4 * it) * 8; const f16x8 vv = *(const f16x8*)(VR + (t0 + m) * AW + hc + cc);
#pragma unroll
            for (int j = 0; j < 8; ++j) imV[(cc + j) * IMG_LD + m] = vv[j]; }
        stage_rows_f32(imS, ST + st_index(0, bh, i), F.tid);
        const int n = 16 * w + fr; const size_t trow = t0 + n;
        f16x8 qa[4];
#pragma unroll
        for (int ks = 0; ks < 4; ++ks) qa[ks] = *(const f16x8*)(Qb + trow * AW + hc + 32 * ks + 8 * fq);
        __syncthreads();
        f32x4 acc[8], o[8]; zero8(acc); wave_mma(acc, qa, imS, fr, fq);
        const float qf = exp2f(lf * (float)(n + 1)), qb = exp2f(lb * (float)(CHK - n));
#pragma unroll
        for (int t = 0; t < 8; ++t) o[t] = acc[t] * qf;
        __syncthreads();
        stage_rows_f32(imS, ST + st_index(1, bh, 31 - i), F.tid);
        __syncthreads();
        zero8(acc); wave_mma(acc, qa, imS, fr, fq);
#pragma unroll
        for (int t = 0; t < 8; ++t) o[t] += acc[t] * qb;
        zero8(acc); wave_mma(acc, qa, imK, fr, fq);
        int nn = n; asm volatile("" : "+v"(nn));
        LAS f16* pw = imP + (16 * w) * IMG_LD;
#pragma unroll
        for (int t = 0; t < 8; ++t) { float pv[4];
#pragma unroll
            for (int r = 0; r < 4; ++r) { const float dm = (float)(nn - (16 * t + 4 * fq + r)); const float dec = exp2f(lf * fmaxf(dm, 0.f) + lb * fmaxf(-dm, 0.f)) + (1.0f - fminf(fabsf(dm), 1.0f)); pv[r] = acc[t][r] * dec; }
            u32x2 pk; pk.x = pkh(pv[0], pv[1]); pk.y = pkh(pv[2], pv[3]); *(LAS u32x2*)(pw + fr * IMG_LD + 16 * t + 4 * fq) = pk; }
        f16x8 pa[4];
#pragma unroll
        for (int ks = 0; ks < 4; ++ks) pa[ks] = *(const LAS f16x8*)(pw + fr * IMG_LD + 32 * ks + 8 * fq);
        wave_mma(o, pa, imV, fr, fq);
        float s = 0.f;
#pragma unroll
        for (int t = 0; t < 8; ++t) s += (o[t].x + o[t].y) + (o[t].z + o[t].w);
        s += __shfl_xor(s, 16); s += __shfl_xor(s, 32);
        const float mean = s * (1.0f / 128.0f); float q = 0.f;
#pragma unroll
        for (int t = 0; t < 8; ++t) { o[t] = o[t] - mean; q += (o[t].x * o[t].x + o[t].y * o[t].y) + (o[t].z * o[t].z + o[t].w * o[t].w); }
        q += __shfl_xor(q, 16); q += __shfl_xor(q, 32);
        const float rstd = 1.0f / sqrtf(q * (1.0f / 128.0f) + EPS);
#pragma unroll
        for (int t = 0; t < 8; ++t) { const int col = hc + 16 * t + 4 * fq; const f32x4 g = *(const f32x4*)(gng + col); const f16x4 gs = *(const f16x4*)(GS + trow * AW + col);
            u32x2 pk; pk.x = pkh(o[t].x * rstd * g.x * (float)gs.x, o[t].y * rstd * g.y * (float)gs.y); pk.y = pkh(o[t].z * rstd * g.z * (float)gs.z, o[t].w * rstd * g.w * (float)gs.w);
            *(u32x2*)(AR + trow * DM + AW + col) = pk; }
        __syncthreads();
    }
}
__device__ __forceinline__ void p5_naive(Frame& F) {
    const int gw = F.vcu * NWAVES + F.wave, NGW = F.G * NWAVES; const int gt = F.vcu * 512 + F.tid, NGT = F.G * 512;
    const float* ARAW = (const float*)(F.ws() + WS_ARAW); f16* AR = (f16*)(F.ws() + WS_AR); const float* aog = F.in[12];
    for (int row = gw; row < NTOK; row += NGW) {
        f32x4 v[4]; float ss = 0.f;
#pragma unroll
        for (int j = 0; j < 4; ++j) { v[j] = *(const f32x4*)(ARAW + (size_t)row * AW + 4 * F.lane + 256 * j); ss += (v[j].x * v[j].x + v[j].y * v[j].y) + (v[j].z * v[j].z + v[j].w * v[j].w); }
        const float rstd = 1.0f / sqrtf(wave_sum(ss) * (1.0f / AW) + EPS);
#pragma unroll
        for (int j = 0; j < 4; ++j) { const int col = 4 * F.lane + 256 * j; const f32x4 g = *(const f32x4*)(aog + col); const f32x4 h = v[j] * rstd * g;
            u32x2 o; o.x = pkh(h.x, h.y); o.y = pkh(h.z, h.w); *(u32x2*)(AR + (size_t)row * DM + col) = o; }
    }
    float* ST = (float*)(F.ws() + WS_ST); const float* lgf = F.in[13]; const float* lgb = F.in[14];
    for (int idx = gt; idx < 2 * 16 * 16384; idx += NGT) {
        const int e = idx & 16383, bh = (idx >> 14) & 15, dir = idx >> 18, h = bh & 7;
        const float cd = __expf((dir ? lgb[h] : lgf[h]) * (float)CHK);
        float* p0 = ST + st_index(dir, bh, 0) + e; float uv[32];
#pragma unroll
        for (int s = 0; s < 32; ++s) uv[s] = p0[(size_t)s * 16384];
        uv[0] += p0[(size_t)32 * 16384]; p0[0] = uv[0];
#pragma unroll
        for (int s = 1; s < 32; ++s) { uv[s] = cd * uv[s - 1] + uv[s]; p0[(size_t)s * 16384] = uv[s]; }
    }
}
__device__ __forceinline__ void p6_naive(Frame& F) {
    const int gt = F.vcu * 512 + F.tid, NGT = F.G * 512;
    const f16* Qb = (const f16*)(F.ws() + WS_PBUF) + (size_t)2 * NTOK * AW; const f16* Kb = Qb + (size_t)NTOK * AW;
    const float* lgf = F.in[13]; const float* lgb = F.in[14]; float* PB = (float*)(F.ws() + WS_PB);
    for (int idx = gt; idx < 16 * 32 * 16384; idx += NGT) {
        const int m = idx & 127, n = (idx >> 7) & 127, i = (idx >> 14) & 31, bh = idx >> 19, b = bh >> 3, h = bh & 7;
        const size_t t0 = (size_t)b * SEQ + i * CHK; const f16* q = Qb + (t0 + n) * AW + h * 128; const f16* k = Kb + (t0 + m) * AW + h * 128;
        float s = 0.f; for (int d = 0; d < 128; ++d) s += (float)q[d] * (float)k[d];
        const float dec = (n > m) ? __expf(lgf[h] * (float)(n - m)) : (n < m) ? __expf(lgb[h] * (float)(m - n)) : 2.0f;
        PB[idx] = s * dec;
    }
}
__device__ __forceinline__ void p7_naive(Frame& F) {
    const int gw = F.vcu * NWAVES + F.wave, NGW = F.G * NWAVES;
    const f16* Qb = (const f16*)(F.ws() + WS_PBUF) + (size_t)2 * NTOK * AW; const f16* VR = Qb + (size_t)2 * NTOK * AW; const f16* GS = VR + (size_t)NTOK * AW;
    const float* PB = (const float*)(F.ws() + WS_PB); const float* ST = (const float*)(F.ws() + WS_ST);
    const float* lgf = F.in[13]; const float* lgb = F.in[14]; const float* gng = F.in[15]; f16* AR = (f16*)(F.ws() + WS_AR);
    for (int it = gw; it < NTOK * NH; it += NGW) {
        const int t = it >> 3, h = it & 7, b = t >> 12, tp = t & (SEQ - 1), i = tp >> 7, n = tp & 127, bh = b * 8 + h;
        const size_t t0 = (size_t)b * SEQ + i * CHK;
        const float* prow = PB + (((size_t)bh * 32 + i) * 128 + n) * 128;
        float o0 = 0.f, o1 = 0.f;
        for (int m = 0; m < 128; ++m) { const float p = prow[m]; const f16* vr = VR + (t0 + m) * AW + h * 128; o0 += p * (float)vr[F.lane]; o1 += p * (float)vr[F.lane + 64]; }
        const f16* q = Qb + (size_t)t * AW + h * 128;
        const float* sf = ST + st_index(0, bh, i); const float* sb = ST + st_index(1, bh, 31 - i);
        float f0 = 0.f, f1 = 0.f, b0 = 0.f, b1 = 0.f;
        for (int d = 0; d < 128; ++d) { const float qd = (float)q[d]; f0 += qd * sf[F.lane * 128 + d]; f1 += qd * sf[(F.lane + 64) * 128 + d]; b0 += qd * sb[F.lane * 128 + d]; b1 += qd * sb[(F.lane + 64) * 128 + d]; }
        const float qf = __expf(lgf[h] * (float)(n + 1)), qb = __expf(lgb[h] * (float)(CHK - n));
        o0 += qf * f0 + qb * b0; o1 += qf * f1 + qb * b1;
        const float mean = wave_sum(o0 + o1) * (1.0f / 128.0f); const float d0 = o0 - mean, d1 = o1 - mean;
        const float rstd = 1.0f / sqrtf(wave_sum(d0 * d0 + d1 * d1) * (1.0f / 128.0f) + EPS);
        const int j0 = h * 128 + F.lane;
        AR[(size_t)t * DM + AW + j0] = (f16)(d0 * rstd * gng[j0] * (float)GS[(size_t)t * AW + j0]);
        AR[(size_t)t * DM + AW + j0 + 64] = (f16)(d1 * rstd * gng[j0 + 64] * (float)GS[(size_t)t * AW + j0 + 64]);
    }
}
struct DenseSched { int G, c, nM, nN, K; const char* Bt;
    __device__ __forceinline__ bool next(int i, g8::Unit& u, const int (&R)[2], const int (&C)[2]) const {
        int pm, pn; if (!g8::dense_order(i * G + c, nM, nN, pm, pn)) return false;
#pragma unroll
        for (int h = 0; h < 2; ++h)
#pragma unroll
            for (int k = 0; k < 2; ++k) u.ao[h][k] = (unsigned)((pm * 256 + h * 128 + R[k]) * K + C[k]) * 2u;
        u.B = Bt + (size_t)pn * 256 * K * 2; u.row0 = pm * 256; u.pn = pn; u.aux = 0; u.full = 1; return true; } };
__device__ __forceinline__ void p9_router(Frame& F) {
    const float* X1 = (const float*)(F.ws() + WS_X1); f16* HX2 = (f16*)(F.ws() + WS_HX2);
    const float* g2 = F.in[7]; const float* rbias = F.in[18];
    const f16* RWH = (const f16*)(F.ws() + WS_RWT); const f16* RWL = RWH + NE * DM;
    int* EIDX = (int*)(F.ws() + WS_EIDX); float* EW = (float*)(F.ws() + WS_EW); int* CNT = (int*)(F.ws() + WS_CNT);
    LAS float* RED = (LAS float*)F.lds; LAS float* LOG = (LAS float*)(F.lds + 32768); LAS float* PART = (LAS float*)(F.lds + 36864); LAS int* lcnt = (LAS int*)(F.lds + 37888);
    const int r = F.lane & 15, q = F.lane >> 4, w = F.wave;
    for (int u = F.vcu; u < 512; u += F.G) {
        if (F.tid < 64) lcnt[F.tid] = 0;
        const int row = u * 16 + r; const int kb = 256 * w + 8 * q;
        const float* mod = (const float*)(F.ws() + WS_MOD) + ((u * 16) >> 12) * 12288;
        float ss = 0.f; const float* xrow = X1 + (size_t)row * DM + kb;
        {   f32x4 xa[8], xb[8];
#pragma unroll
            for (int ks = 0; ks < 8; ++ks) { xa[ks] = *(const f32x4*)(xrow + 32 * ks); xb[ks] = *(const f32x4*)(xrow + 32 * ks + 4); }
#pragma unroll
            for (int ks = 0; ks < 8; ++ks) ss += (xa[ks].x * xa[ks].x + xa[ks].y * xa[ks].y) + (xa[ks].z * xa[ks].z + xa[ks].w * xa[ks].w) + (xb[ks].x * xb[ks].x + xb[ks].y * xb[ks].y) + (xb[ks].z * xb[ks].z + xb[ks].w * xb[ks].w); }
        ss += __shfl_xor(ss, 16); ss += __shfl_xor(ss, 32);
        if (q == 0) PART[w * 16 + r] = ss;
        __syncthreads();
        float tot = 0.f;
#pragma unroll
        for (int ww = 0; ww < 8; ++ww) tot += PART[ww * 16 + r];
        const float rstd = 1.0f / sqrtf(tot * (1.0f / DM) + EPS);
        f32x4 am[4], al[4];
#pragma unroll
        for (int nt = 0; nt < 4; ++nt) { am[nt] = (f32x4){0.f, 0.f, 0.f, 0.f}; al[nt] = am[nt]; }
        const f16* rwh = RWH + (size_t)r * DM + kb; const f16* rwl = RWL + (size_t)r * DM + kb;
#pragma unroll 1
        for (int ks = 0; ks < 8; ++ks) { const int col = kb + 32 * ks;
            const f32x4 xa = *(const f32x4*)(xrow + 32 * ks), xb = *(const f32x4*)(xrow + 32 * ks + 4);
            const f32x4 ga = *(const f32x4*)(g2 + col), gb = *(const f32x4*)(g2 + col + 4), sha = *(const f32x4*)(mod + 3 * 2048 + col), shb = *(const f32x4*)(mod + 3 * 2048 + col + 4), sca = *(const f32x4*)(mod + 4 * 2048 + col), scb = *(const f32x4*)(mod + 4 * 2048 + col + 4);
            f16x8 bh[4], bl[4];
#pragma unroll
            for (int nt = 0; nt < 4; ++nt) { bh[nt] = *(const f16x8*)(rwh + (size_t)(16 * nt) * DM + 32 * ks); bl[nt] = *(const f16x8*)(rwl + (size_t)(16 * nt) * DM + 32 * ks); }
            const f32x4 ha = (xa * rstd * ga) * (sca + 1.0f) + sha, hb = (xb * rstd * gb) * (scb + 1.0f) + shb;
            f16x8 hi, lo;
            hi[0] = (f16)ha.x; hi[1] = (f16)ha.y; hi[2] = (f16)ha.z; hi[3] = (f16)ha.w; hi[4] = (f16)hb.x; hi[5] = (f16)hb.y; hi[6] = (f16)hb.z; hi[7] = (f16)hb.w;
            lo[0] = (f16)((ha.x - (float)hi[0]) * 2048.0f); lo[1] = (f16)((ha.y - (float)hi[1]) * 2048.0f); lo[2] = (f16)((ha.z - (float)hi[2]) * 2048.0f); lo[3] = (f16)((ha.w - (float)hi[3]) * 2048.0f);
            lo[4] = (f16)((hb.x - (float)hi[4]) * 2048.0f); lo[5] = (f16)((hb.y - (float)hi[5]) * 2048.0f); lo[6] = (f16)((hb.z - (float)hi[6]) * 2048.0f); lo[7] = (f16)((hb.w - (float)hi[7]) * 2048.0f);
            *(f16x8*)(HX2 + (size_t)row * DM + col) = hi;
#pragma unroll
            for (int nt = 0; nt < 4; ++nt) {
                am[nt] = __builtin_amdgcn_mfma_f32_16x16x32_f16(hi, bh[nt], am[nt], 0, 0, 0);
                al[nt] = __builtin_amdgcn_mfma_f32_16x16x32_f16(lo, bh[nt], al[nt], 0, 0, 0);
                al[nt] = __builtin_amdgcn_mfma_f32_16x16x32_f16(hi, bl[nt], al[nt], 0, 0, 0); } }
#pragma unroll
        for (int nt = 0; nt < 4; ++nt)
#pragma unroll
            for (int rg = 0; rg < 4; ++rg) RED[(w * 16 + 4 * q + rg) * 64 + 16 * nt + r] = am[nt][rg] + al[nt][rg] * (1.0f / 2048.0f);
        __syncthreads();
#pragma unroll
        for (int o2 = 0; o2 < 2; ++o2) { const int o = F.tid + 512 * o2; float sacc = 0.f;
#pragma unroll
            for (int ww = 0; ww < 8; ++ww) sacc += RED[ww * 1024 + o];
            LOG[o] = sacc; }
        __syncthreads();
        for (int rr = 0; rr < 2; ++rr) { const int rl = 2 * w + rr, trow = u * 16 + rl;
            const float logit = LOG[rl * 64 + F.lane];
            const float s = 1.0f / (1.0f + expf(-logit)); const float sel = s + rbias[F.lane];
            float m1 = sel; m1 = fmaxf(m1, __shfl_xor(m1, 1)); m1 = fmaxf(m1, __shfl_xor(m1, 2)); m1 = fmaxf(m1, __shfl_xor(m1, 4));
            const unsigned long long bm = __ballot(sel == m1); const int gbase = F.lane & ~7; const unsigned gb = (unsigned)(bm >> gbase) & 0xffu; const int first = gbase + __builtin_ctz(gb);
            float m2 = (F.lane == first) ? -INFINITY : sel; m2 = fmaxf(m2, __shfl_xor(m2, 1)); m2 = fmaxf(m2, __shfl_xor(m2, 2)); m2 = fmaxf(m2, __shfl_xor(m2, 4));
            const float gs = m1 + m2; const int myg = F.lane >> 3; int beat = 0;
#pragma unroll
            for (int g = 0; g < 8; ++g) { const float og = __shfl(gs, g * 8); beat += (og > gs || (og == gs && g < myg)) ? 1 : 0; }
            const float cand = (beat < 4) ? sel : -INFINITY; int rank = 0;
            for (int e = 0; e < NE; ++e) { const float oc = __shfl(cand, e); rank += (oc > cand || (oc == cand && e < F.lane)) ? 1 : 0; }
            const bool chosen = (rank < TOPK) && (beat < 4);
            const float wsum = wave_sum(chosen ? s : 0.f);
            if (chosen) { EIDX[trow * 8 + rank] = F.lane; EW[trow * 8 + rank] = s / wsum * 2.5f; __hip_atomic_fetch_add(&lcnt[F.lane], 1, __ATOMIC_RELAXED, __HIP_MEMORY_SCOPE_WORKGROUP); }
        }
        __syncthreads();
        if (F.tid < 64) CNT[u * 64 + F.tid] = lcnt[F.tid];
        __syncthreads();
    }
}
__device__ __forceinline__ void p10_lists(Frame& F) {
    LAS int* pre = (LAS int*)(F.lds);
    LAS int* tot = pre + 128; LAS int* rb = pre + 256; LAS int* lfill = pre + 384;
    const int* CNT = (const int*)(F.ws() + WS_CNT);
    const int* EIDX = (const int*)(F.ws() + WS_EIDX); const float* EW = (const float*)(F.ws() + WS_EW);
    int* TILEE = (int*)(F.ws() + WS_TILEE); int* ROWTOK = (int*)(F.ws() + WS_ROWTOK); int* ROWDST = (int*)(F.ws() + WS_ROWDST); float* ROWW = (float*)(F.ws() + WS_ROWW);
    const int u1 = F.vcu, u2 = F.vcu + F.G;
    {
        LAS int* segs = pre + 512;
        const int e = F.tid & 63, seg = F.tid >> 6; int run = 0, q1 = 0, q2 = 0;
        { int cv[64];
#pragma unroll
            for (int j = 0; j < 64; ++j) cv[j] = CNT[(seg * 64 + j) * 64 + e];
#pragma unroll
            for (int j = 0; j < 64; ++j) { const int uu = seg * 64 + j; if (uu == u1) q1 = run; if (uu == u2) q2 = run; run += cv[j]; } }
        segs[seg * 64 + e] = run; if ((u1 >> 6) == seg) segs[512 + e] = q1; if ((u2 >> 6) == seg) segs[576 + e] = q2;
        __syncthreads();
        if (F.tid < 64) { int r2 = 0, p1 = 0, p2 = 0;
#pragma unroll
            for (int sg = 0; sg < 8; ++sg) { if (sg == (u1 >> 6)) p1 = r2 + segs[512 + e]; if (sg == (u2 >> 6)) p2 = r2 + segs[576 + e]; r2 += segs[sg * 64 + e]; }
            pre[e] = p1; pre[64 + e] = p2; tot[e] = r2; }
    }
    __syncthreads();
    if (F.tid == 0) { tot[NE] = NTOK; int tiles = 0; for (int e = 0; e < NE1; ++e) { rb[e] = tiles * 256; const int nt = (tot[e] + 255) >> 8; if (F.vcu == 0) for (int j = 0; j < nt; ++j) { TILEE[tiles + j] = e; TILEE[512 + tiles + j] = (j + 1 < nt) ? 256 : (tot[e] - 256 * j); } tiles += nt; } rb[NE1] = tiles * 256; if (F.vcu == 0) TILEE[511] = tiles; }
    __syncthreads();
    for (int k = 0; k < 2; ++k) { const int u = k ? u2 : u1; if (u >= 512) break;
        if (F.tid < 64) lfill[F.tid] = 0;
        __syncthreads();
        if (F.tid < 128) { const int i = u * 128 + F.tid; const int e = EIDX[i]; const int pos = pre[k * 64 + e] + __hip_atomic_fetch_add(&lfill[e], 1, __ATOMIC_RELAXED, __HIP_MEMORY_SCOPE_WORKGROUP);
            const int row = rb[e] + pos; ROWTOK[row] = i >> 3; ROWDST[row] = (i >> 3) * NSLOT + (i & 7); ROWW[row] = EW[i]; }
        else if (F.tid < 144) { const int t = u * 16 + (F.tid - 128); const int row = rb[NE] + t; ROWTOK[row] = t; ROWDST[row] = t * NSLOT + 8; ROWW[row] = 1.0f; }
        __syncthreads();
    }
    if (F.vcu < NE1) { const int e = F.vcu; const int lo = rb[e] + tot[e], hi = rb[e + 1]; for (int r = lo + F.tid; r < hi; r += 512) { ROWTOK[r] = 0; ROWDST[r] = -1; ROWW[r] = 0.f; } }
}
struct MoeSched { int G, c, nN, K, gather; const int* TILEE; const int* ROWTOK; const char* Bt; size_t bstride_e;
    __device__ __forceinline__ bool next(int i, g8::Unit& u, const int (&R)[2], const int (&C)[2]) const {
        const int ntile = __builtin_amdgcn_readfirstlane(TILEE[511]), total = ntile * nN, per = (total + 7) >> 3, x = c & 7, lc = c >> 3, li = i * (G >> 3) + lc;
        if (li >= per) return false; const int idx = x * per + li; if (idx >= total) return false;
        const int j = idx / nN, pn = idx % nN, e = __builtin_amdgcn_readfirstlane(TILEE[j]);
#pragma unroll
        for (int h = 0; h < 2; ++h)
#pragma unroll
            for (int k = 0; k < 2; ++k) { const int r = j * 256 + h * 128 + R[k]; const int src = gather ? ROWTOK[r] : r; u.ao[h][k] = (unsigned)(src * K + C[k]) * 2u; }
        u.B = Bt + (size_t)e * bstride_e + (size_t)pn * 256 * K * 2; u.row0 = j * 256; u.pn = pn; u.aux = e; u.full = __builtin_amdgcn_readfirstlane(TILEE[512 + j]) > 128; return true; } };
struct EpiHid {
    static constexpr bool PERM = true;
    f16* HID;
    __device__ __forceinline__ void operator()(const f32x4 (&acc)[2][2][4][2], const g8::Unit& u, int wr, int wc, int fr, int fq) const {
        const int row0 = u.row0 + wr * 64 + fr, col0 = u.pn * 128 + wc * 32 + 8 * fq;
#pragma unroll
        for (int ai = 0; ai < 2; ++ai)
#pragma unroll
            for (int m = 0; m < 4; ++m) { const f32x4 a0 = acc[ai][0][m][0], a1 = acc[ai][0][m][1], b0 = acc[ai][1][m][0], b1 = acc[ai][1][m][1];
                u32x4 w; w.x = pkh(silu_f(a0[0]) * b0[0], silu_f(a0[1]) * b0[1]); w.y = pkh(silu_f(a0[2]) * b0[2], silu_f(a0[3]) * b0[3]);
                w.z = pkh(silu_f(a1[0]) * b1[0], silu_f(a1[1]) * b1[1]); w.w = pkh(silu_f(a1[2]) * b1[2], silu_f(a1[3]) * b1[3]);
                *(u32x4*)(HID + (size_t)(row0 + ai * 128 + m * 16) * EH + col0) = w; }
    }
};
struct EpiYs {
    static constexpr bool PERM = true;
    f16* YS; const int* ROWDST; const float* ROWW;
    __device__ __forceinline__ void operator()(const f32x4 (&acc)[2][2][4][2], const g8::Unit& u, int wr, int wc, int fr, int fq) const {
        const int row0 = u.row0 + wr * 64 + fr, col0 = u.pn * 256 + wc * 32 + 8 * fq;
#pragma unroll
        for (int ai = 0; ai < 2; ++ai)
#pragma unroll
            for (int m = 0; m < 4; ++m) { const int row = row0 + ai * 128 + m * 16; const int dst = ROWDST[row]; const float w = ROWW[row];
                if (dst >= 0) {
#pragma unroll
                    for (int bj = 0; bj < 2; ++bj) { const f32x4 a0 = acc[ai][bj][m][0] * w, a1 = acc[ai][bj][m][1] * w;
                        u32x4 o; o.x = pkh(a0[0], a0[1]); o.y = pkh(a0[2], a0[3]); o.z = pkh(a1[0], a1[1]); o.w = pkh(a1[2], a1[3]);
                        *(u32x4*)(YS + (size_t)dst * DM + col0 + bj * 128) = o; } } }
    }
};
__device__ __forceinline__ void p13_combine(Frame& F) {
    const int gw = F.vcu * NWAVES + F.wave, NGW = F.G * NWAVES;
    const float* X1 = (const float*)(F.ws() + WS_X1); const f16* YS = (const f16*)(F.ws() + WS_YS); const float* fg = F.in[25]; float* outp = F.out();
    for (int row = gw; row < NTOK; row += NGW) {
        const float* g2 = (const float*)(F.ws() + WS_MOD) + (row >> 12) * 12288 + 5 * 2048;
        const f16* yrow = YS + (size_t)row * NSLOT * DM + 8 * F.lane; const float* xrow = X1 + (size_t)row * DM + 8 * F.lane;
        f32x4 v[4][2]; float ss = 0.f;
        f16x8 y[NSLOT], yn[NSLOT]; f32x4 xa, xb, xna, xnb;
#pragma unroll
        for (int sl = 0; sl < NSLOT; ++sl) y[sl] = __builtin_nontemporal_load((const f16x8*)(yrow + (size_t)sl * DM));
        xa = *(const f32x4*)(xrow); xb = *(const f32x4*)(xrow + 4);
#pragma unroll
        for (int j = 0; j < 4; ++j) { const int col = 8 * F.lane + 512 * j;
            if (j < 3) {
#pragma unroll
                for (int sl = 0; sl < NSLOT; ++sl) yn[sl] = __builtin_nontemporal_load((const f16x8*)(yrow + (size_t)sl * DM + 512 * (j + 1)));
                xna = *(const f32x4*)(xrow + 512 * (j + 1)); xnb = *(const f32x4*)(xrow + 512 * (j + 1) + 4); }
            const f32x4 ga = *(const f32x4*)(g2 + col), gb = *(const f32x4*)(g2 + col + 4);
            f32x4 a = {0.f, 0.f, 0.f, 0.f}, b = a;
#pragma unroll
            for (int sl = 0; sl < NSLOT; ++sl) { a.x += (float)y[sl][0]; a.y += (float)y[sl][1]; a.z += (float)y[sl][2]; a.w += (float)y[sl][3]; b.x += (float)y[sl][4]; b.y += (float)y[sl][5]; b.z += (float)y[sl][6]; b.w += (float)y[sl][7]; }
            v[j][0] = xa + ga * a; v[j][1] = xb + gb * b;
            ss += (v[j][0].x * v[j][0].x + v[j][0].y * v[j][0].y) + (v[j][0].z * v[j][0].z + v[j][0].w * v[j][0].w) + (v[j][1].x * v[j][1].x + v[j][1].y * v[j][1].y) + (v[j][1].z * v[j][1].z + v[j][1].w * v[j][1].w);
            FENCE();
            if (j < 3) {
#pragma unroll
                for (int sl = 0; sl < NSLOT; ++sl) y[sl] = yn[sl];
                xa = xna; xb = xnb; } }
        const float rstd = 1.0f / sqrtf(wave_sum(ss) * (1.0f / DM) + EPS);
#pragma unroll
        for (int j = 0; j < 4; ++j) { const int col = 8 * F.lane + 512 * j; const f32x4 ga = *(const f32x4*)(fg + col), gb = *(const f32x4*)(fg + col + 4);
            __builtin_nontemporal_store(v[j][0] * rstd * ga, (f32x4*)(outp + (size_t)row * DM + col)); __builtin_nontemporal_store(v[j][1] * rstd * gb, (f32x4*)(outp + (size_t)row * DM + col + 4)); }
    }
}

struct Args { const float* in[26]; float* out; unsigned char* ws; int ph_lo, ph_hi, li, pad; };
__global__ void __launch_bounds__(NWAVES * 64, 2) fwd(Args args) {
    extern __shared__ __attribute__((aligned(16))) unsigned char lds[];
    Frame F;
    F.lds = (LAS unsigned char*)lds;
    F.tid = threadIdx.x; F.lane = F.tid & 63; F.wave = __builtin_amdgcn_readfirstlane(F.tid >> 6);
    F.G = gridDim.x; { const int bx = blockIdx.x; F.vcu = (bx & 7) * (F.G >> 3) + (bx >> 3); }
    F.in.base = (LAS const unsigned*)(F.lds + LDSCTL_OFF + 512);
    {
        const unsigned* ka = (const unsigned*)__builtin_amdgcn_kernarg_segment_ptr();
        if (F.tid < 128) ((LAS unsigned*)(F.lds + LDSCTL_OFF))[F.tid] = 0u;
        if (F.tid >= 128 && F.tid < 128 + 60) ((LAS unsigned*)(F.lds + LDSCTL_OFF + 512))[F.tid - 128] = ka[F.tid - 128];
    }
    __syncthreads();
    const int ph_lo = (int)__builtin_amdgcn_readfirstlane(((LAS const unsigned*)(F.lds + LDSCTL_OFF + 512))[56]), ph_hi = (int)__builtin_amdgcn_readfirstlane(((LAS const unsigned*)(F.lds + LDSCTL_OFF + 512))[57]);
    if (MK_N_LAUNCHES == 1) xcd_barrier_post((unsigned*)(F.ws() + WS_CTL) + CW_BAR);
    const int lo = ph_lo, hi = ph_hi;
#define REFRESH() do { int t_ = threadIdx.x; asm volatile("" : "+v"(t_)); F.tid = t_; F.lane = t_ & 63; F.wave = __builtin_amdgcn_readfirstlane(t_ >> 6); } while (0)
#define IN(k) (lo <= (k) && (k) < hi)
#define SEAM(k) do { if (IN(k) && IN((k) + 1)) { XcdBarrier bar_; bar_.bar = (unsigned*)(F.ws() + WS_CTL) + CW_BAR; bar_.st = (volatile LAS unsigned*)((LAS unsigned char*)lds + MISC_OFF) + 8; xcd_barrier(bar_); } } while (0)
    const int cblk = (int)blockIdx.x;
    if (IN(0)) for (int rep_ = 0; rep_ <= ((PROBE_DUP >> 0) & 1); ++rep_) { if (rep_) __syncthreads(); REFRESH(); p0_prologue(F); } SEAM(0);
    if (IN(1)) for (int rep_ = 0; rep_ <= ((PROBE_DUP >> 1) & 1); ++rep_) { if (rep_) __syncthreads(); REFRESH(); p1_norm(F); } SEAM(1);
    if (IN(2)) for (int rep_ = 0; rep_ <= ((PROBE_DUP >> 2) & 1); ++rep_) { if (rep_) __syncthreads(); REFRESH(); InSched S{F.G, cblk, (const char*)(F.ws() + WS_WINT), 0, 1000};
        EpiIn E{(f16*)(F.ws() + WS_PBUF), (f16*)(F.ws() + WS_CK), (f16*)(F.ws() + WS_CV), (float*)(F.ws() + WS_VSTAT), (const float*)(F.ws() + WS_ROPE)};
        const int grp = (cblk >> 3) & 3;
        for (int part = 0; part < 2; ++part) {
            S.ulo = part ? grp : 0; S.uhi = part ? 1000 : grp;
            if (S.uhi > S.ulo) g8::gemm_phase<EpiIn, InSched, true>(F.lds + RING_OFF, (const char*)(F.ws() + WS_HX), DM, S, E);
            if (part == 0) { __syncthreads(); REFRESH(); if (F.vcu < 64) { p2_ctx_unit(F, F.vcu); __syncthreads(); } p2_expert_copies(F); __syncthreads(); } } } SEAM(2);
    if (IN(4)) for (int rep_ = 0; rep_ <= ((PROBE_DUP >> 4) & 1); ++rep_) { if (rep_) __syncthreads(); REFRESH(); p4_fast(F); } SEAM(4);
    if (IN(5)) for (int rep_ = 0; rep_ <= ((PROBE_DUP >> 5) & 1); ++rep_) { if (rep_) __syncthreads(); REFRESH(); p5_naive(F); } SEAM(5);
    if (IN(6)) for (int rep_ = 0; rep_ <= ((PROBE_DUP >> 6) & 1); ++rep_) { if (rep_) __syncthreads(); REFRESH(); p6_fast(F); } SEAM(6);
    if (IN(8)) for (int rep_ = 0; rep_ <= ((PROBE_DUP >> 8) & 1); ++rep_) { if (rep_) __syncthreads(); REFRESH(); DenseSched S{F.G, cblk, 32, 8, DM, (const char*)(F.ws() + WS_WOUTT)}; EpiX1 E{F.in[0], (const float*)(F.ws() + WS_MOD), (float*)(F.ws() + WS_X1)};
        g8::gemm_phase<EpiX1, DenseSched, true>(F.lds + RING_OFF, (const char*)(F.ws() + WS_AR), DM, S, E); } SEAM(8);
    if (IN(9)) for (int rep_ = 0; rep_ <= ((PROBE_DUP >> 9) & 1); ++rep_) { if (rep_) __syncthreads(); REFRESH(); p9_router(F); } SEAM(9);
    if (IN(10)) for (int rep_ = 0; rep_ <= ((PROBE_DUP >> 10) & 1); ++rep_) { if (rep_) __syncthreads(); REFRESH(); p10_lists(F); } SEAM(10);
    if (IN(11)) for (int rep_ = 0; rep_ <= ((PROBE_DUP >> 11) & 1); ++rep_) { if (rep_) __syncthreads(); REFRESH(); MoeSched S{F.G, cblk, 4, DM, 1, (const int*)(F.ws() + WS_TILEE), (const int*)(F.ws() + WS_ROWTOK), (const char*)(F.ws() + WS_W13T), (size_t)1024 * DM * 2};
        EpiHid E{(f16*)(F.ws() + WS_HID)};
        g8::gemm_phase<EpiHid, MoeSched, true>(F.lds + RING_OFF, (const char*)(F.ws() + WS_HX2), DM, S, E); } SEAM(11);
    if (IN(12)) for (int rep_ = 0; rep_ <= ((PROBE_DUP >> 12) & 1); ++rep_) { if (rep_) __syncthreads(); REFRESH(); MoeSched S{F.G, cblk, 8, EH, 0, (const int*)(F.ws() + WS_TILEE), (const int*)(F.ws() + WS_ROWTOK), (const char*)(F.ws() + WS_W2T), (size_t)DM * EH * 2};
        EpiYs E{(f16*)(F.ws() + WS_YS), (const int*)(F.ws() + WS_ROWDST), (const float*)(F.ws() + WS_ROWW)};
        g8::gemm_phase<EpiYs, MoeSched, true>(F.lds + RING_OFF, (const char*)(F.ws() + WS_HID), EH, S, E); } SEAM(12);
    if (IN(13)) for (int rep_ = 0; rep_ <= ((PROBE_DUP >> 13) & 1); ++rep_) { if (rep_) __syncthreads(); REFRESH(); p13_combine(F); }
#undef IN
#undef SEAM
}

extern "C" void kernel_launch(void* const* d_in, const int* in_sizes, int n_in, void* d_out, int out_size, void* d_ws, size_t ws_size, hipStream_t stream) {
    static int grid = 0;
    if (grid == 0) {
        if (n_in != 26 || in_sizes[0] != NTOK * DM || out_size != NTOK * DM || ws_size < WS_END) {
            fprintf(stderr, "kernel_launch: unexpected problem (n_in %d, in0 %d, out %d, ws %zu); nothing launched\n", n_in, n_in > 0 ? in_sizes[0] : -1, out_size, ws_size); grid = -1; return; }
        int dev = 0, cus = 0, per_cu = 0;
        if (hipGetDevice(&dev) != hipSuccess || hipDeviceGetAttribute(&cus, hipDeviceAttributeMultiprocessorCount, dev) != hipSuccess) { grid = -1; return; }
        if (hipFuncSetAttribute((const void*)fwd, hipFuncAttributeMaxDynamicSharedMemorySize, LDS_BYTES) != hipSuccess) { fprintf(stderr, "kernel_launch: hipFuncSetAttribute failed\n"); grid = -1; return; }
        if (hipOccupancyMaxActiveBlocksPerMultiprocessor(&per_cu, (const void*)fwd, NWAVES * 64, LDS_BYTES) != hipSuccess || per_cu < 1)
            fprintf(stderr, "kernel_launch: occupancy query reports %d workgroups per CU\n", per_cu);
        (void)hipGetLastError();
        grid = cus & ~7;
    }
    if (grid < 0) return;
    if (hipMemsetAsync((char*)d_ws + WS_CTL, 0, CTL_ZERO_BYTES, stream) != hipSuccess) return;
    Args a{};
    for (int i = 0; i < 26; ++i) a.in[i] = (const float*)d_in[i];
    a.out = (float*)d_out; a.ws = (unsigned char*)d_ws;
    if (MK_N_LAUNCHES == 1) { a.ph_lo = 0; a.ph_hi = NPHASE; a.li = 0; hipLaunchKernelGGL(fwd, dim3(grid), dim3(NWAVES * 64), LDS_BYTES, stream, a); }
    else { for (int li = 0; li < NPHASE; ++li) { a.ph_lo = li; a.ph_hi = li + 1; a.li = li; hipLaunchKernelGGL(fwd, dim3(grid), dim3(NWAVES * 64), LDS_BYTES, stream, a); } }
}
```

```cpp
#include <hip/hip_runtime.h>
#include <cstdio>
#include <cstdint>

#ifndef PROBE_DUP
#define PROBE_DUP 0
#endif
#ifndef MK_N_LAUNCHES
#define MK_N_LAUNCHES 1
#endif

#define LAS __attribute__((address_space(3)))
#define GAS __attribute__((address_space(1)))
typedef _Float16 f16;
typedef _Float16 f16x8 __attribute__((ext_vector_type(8)));
typedef _Float16 f16x4 __attribute__((ext_vector_type(4)));
typedef _Float16 f16x2 __attribute__((ext_vector_type(2)));
typedef float f32x4 __attribute__((ext_vector_type(4)));
typedef float f32x2 __attribute__((ext_vector_type(2)));
typedef unsigned u32x4 __attribute__((ext_vector_type(4)));
typedef unsigned u32x2 __attribute__((ext_vector_type(2)));
typedef GAS unsigned gu32;

constexpr int DM = 2048, NB = 2, SEQ = 4096, NTOK = NB * SEQ, CTXL = 256, NCTX = NB * CTXL, CHK = 128, NCH = SEQ / CHK;
constexpr int AW = 1024, INC = 6144, NH = 8, HD = 128;
constexpr int NE = 64, NE1 = 65, TOPK = 8, EH = 512, NSLOT = 9;
constexpr int NROWS_IN = NTOK + NCTX;
constexpr int MAXTILES = 360;
constexpr int MAXROWS = MAXTILES * 256;
constexpr float EPS = 1e-6f;
constexpr int NPHASE = 14;
constexpr int NWAVES = 8;

constexpr size_t MiB = 1u << 20;
constexpr size_t WS_CTL = 0, CTL_ZERO_BYTES = 1 * MiB;
constexpr size_t WS_MOD = 1 * MiB;
constexpr size_t WS_ROPE = WS_MOD + 256 * 1024;
constexpr size_t WS_VSTAT = 4 * MiB;
constexpr size_t WS_EIDX = WS_ROPE + 64 * 1024;
constexpr size_t WS_EW = WS_EIDX + 256 * 1024;
constexpr size_t WS_TILEE = WS_EW + 256 * 1024;
constexpr size_t WS_ROWTOK = 2 * MiB;
constexpr size_t WS_ROWDST = WS_ROWTOK + 512 * 1024;
constexpr size_t WS_ROWW = WS_ROWDST + 512 * 1024;
constexpr size_t WS_RWT = 5 * MiB;
constexpr size_t WS_CNT = 5 * MiB + 512 * 1024;
constexpr size_t WS_W13T = 8 * MiB;
constexpr size_t WS_W2T = WS_W13T + 260 * MiB;
constexpr size_t WS_WINT = WS_W2T + 130 * MiB;
constexpr size_t WS_WOUTT = WS_WINT + 24 * MiB;
constexpr size_t WS_X1 = WS_WOUTT + 8 * MiB;
constexpr size_t WS_HX2 = WS_X1 + 64 * MiB;
constexpr size_t WS_HID = WS_HX2 + 32 * MiB;
constexpr size_t WS_OVL = WS_HID + 90 * MiB;
static_assert(WS_OVL == 616 * MiB, "map");
constexpr size_t WS_HX = WS_OVL;
constexpr size_t WS_CBUF = WS_OVL + 34 * MiB;
constexpr size_t WS_ARAW = WS_CBUF;
constexpr size_t WS_PB = WS_CBUF + 32 * MiB;
constexpr size_t WS_AR = WS_CBUF + 64 * MiB;
constexpr size_t WS_OUTX = WS_CBUF + 96 * MiB;
constexpr size_t WS_PBUF = WS_OVL + 238 * MiB;
constexpr size_t WS_CK = WS_PBUF + 96 * MiB;
constexpr size_t WS_CV = WS_CK + 1 * MiB;
constexpr size_t WS_ST = WS_CV + 1 * MiB;
constexpr size_t WS_YS = WS_OVL;
constexpr size_t WS_END = 1024 * MiB;
static_assert(WS_ST + 70 * MiB <= WS_END && WS_YS + 288 * MiB <= WS_END && WS_OUTX + 64 * MiB <= WS_PBUF, "map");
constexpr int CW_BAR = 4096;

constexpr int RING_OFF = 0, RING_BYTES = 131072;
constexpr int LDS_BYTES = 147456;
constexpr int LDSCTL_OFF = LDS_BYTES - 1024, MISC_OFF = LDSCTL_OFF + 320;

#define RLX_AGENT __ATOMIC_RELAXED, __HIP_MEMORY_SCOPE_AGENT
#define LDS_WAIT() asm volatile("s_waitcnt lgkmcnt(0)" ::: "memory")
#define FENCE() do { asm volatile("" ::: "memory"); __builtin_amdgcn_sched_barrier(0); } while (0)
#define VM_WAIT() asm volatile("s_waitcnt vmcnt(0)" ::: "memory")

#define XB_TMO      128
#define XB_XCNT(j)  (256  + 64 * (j))
#define XB_XSUB(j)  (1280 + 64 * (j))
#define XB_XGEN(j)  (2304 + 64 * (j))
#define XB_TOP      3328
#define XB_TOPGEN   3392
#define XCD_BAR_WORDS 3456
#define XB_SPIN_CAP (1u << 18)
__device__ __forceinline__ unsigned xb_ld(unsigned* p)              { return __hip_atomic_load(p, __ATOMIC_RELAXED, __HIP_MEMORY_SCOPE_AGENT); }
__device__ __forceinline__ unsigned xb_add(unsigned* p, unsigned v) { return __hip_atomic_fetch_add(p, v, __ATOMIC_RELAXED, __HIP_MEMORY_SCOPE_AGENT); }
__device__ __forceinline__ unsigned xb_xcc_id() { return (unsigned)__builtin_amdgcn_s_getreg((3 << 11) | 20) & 0xFu; }
#define XB_SPIN(cond, bar) do { unsigned _sp = 0; while (cond) { __builtin_amdgcn_s_sleep(1); \
    if ((++_sp & 255u) == 0u) { if (xb_ld(&(bar)[XB_TMO])) break; if (_sp > XB_SPIN_CAP) { atomicAdd(&(bar)[XB_TMO], 1u); break; } } } } while (0)
struct XcdBarrier { unsigned* bar; volatile LAS unsigned* st; };
__device__ __forceinline__ void xcd_barrier_post(unsigned* bar) {
    if (threadIdx.x == 0) (void)xb_add(&bar[XB_XCNT(xb_xcc_id())], 1u);
}
__device__ __forceinline__ void xcd_barrier_complete(unsigned* bar, unsigned x, unsigned& nloc, unsigned& nx) {
    const unsigned G = gridDim.x * gridDim.y * gridDim.z;
    unsigned sum, cnt, mine, sp = 0u;
    for (;;) {
        sum = 0u; cnt = 0u; mine = 0u;
#pragma unroll
        for (unsigned j = 0; j < 16; ++j) { const unsigned c = xb_ld(&bar[XB_XCNT(j)]); sum += c; cnt += (c > 0u) ? 1u : 0u; mine = (j == x) ? c : mine; }
        if (sum == G) break;
        __builtin_amdgcn_s_sleep(1);
        if ((++sp & 255u) == 0u) { if (xb_ld(&bar[XB_TMO])) break; if (sp > XB_SPIN_CAP) { atomicAdd(&bar[XB_TMO], 1u); break; } }
    }
    nloc = mine > 0u ? mine : 1u; nx = cnt > 0u ? cnt : 1u;
}
__device__ __forceinline__ void xcd_barrier(const XcdBarrier& b) {
    asm volatile("s_waitcnt vmcnt(0)" ::: "memory");
    __syncthreads();
    if (threadIdx.x == 0) {
        unsigned* bar = b.bar; const unsigned bx = xb_xcc_id();
        __builtin_amdgcn_s_waitcnt(0);
        unsigned nloc = b.st[0], nx = b.st[1];
        if (nloc == 0u) { xcd_barrier_complete(bar, bx, nloc, nx); b.st[0] = nloc; b.st[1] = nx; }
        const unsigned old = xb_add(&bar[XB_XSUB(bx)], 1u);
        const unsigned gen = old / nloc;
        if (old + 1u == (gen + 1u) * nloc) {
            __builtin_amdgcn_fence(__ATOMIC_RELEASE, "agent");
            asm volatile("s_waitcnt vmcnt(0)" ::: "memory");
            const unsigned og = xb_add(&bar[XB_TOP], 1u);
            const unsigned tg = og / nx;
            if (og + 1u == (tg + 1u) * nx) xb_add(&bar[XB_TOPGEN], 1u);
            else XB_SPIN(xb_ld(&bar[XB_TOPGEN]) == tg, bar);
            __builtin_amdgcn_fence(__ATOMIC_ACQUIRE, "agent");
            xb_add(&bar[XB_XGEN(bx)], 1u);
            asm volatile("s_waitcnt vmcnt(0)" ::: "memory");
        } else {
            XB_SPIN(xb_ld(&bar[XB_XGEN(bx)]) == gen, bar);
            __builtin_amdgcn_fence(__ATOMIC_ACQUIRE, "agent");
            asm volatile("s_waitcnt vmcnt(0)" ::: "memory");
        }
    }
    __syncthreads();
}

namespace g8 {
constexpr int BM = 256, BK = 64, HALF = 128, HTB = HALF * BK * 2, STAGE_BYTES = 8 * HTB, NXCD = 8, WGM = 8;
__host__ __device__ __forceinline__ int lds_byte(int r, int c) { const int st = (r >> 4) * 2 + (c >> 5), rr = r & 15, cc = c & 31, ob = rr * 64 + cc * 2; return st * 1024 + (ob ^ (((ob >> 9) & 1) << 5)); }
__host__ __device__ __forceinline__ void stage_rc(int b, int& R, int& C) { const int st = b / 1024, sb = b % 1024, swz = sb ^ (((sb >> 9) & 1) << 5); R = (st >> 1) * 16 + swz / 64; C = (st & 1) * 32 + (swz % 64) / 2; }
__host__ __device__ __forceinline__ int perm32(int rho) { const int n = rho >> 4, i = rho & 15; return 8 * (i >> 2) + 4 * n + (i & 3); }

struct Unit { unsigned ao[2][2]; const char* B; int row0; int pn; int aux; int full; };

__device__ __forceinline__ bool dense_order(int L, int nM, int nN, int& pm, int& pn) {
    const int nwg = nM * nN; if (L >= nwg) return false;
    int wgid = L; { const int q = nwg / NXCD, r = nwg % NXCD, xcd = wgid % NXCD, off = wgid / NXCD; wgid = (xcd < r ? xcd * (q + 1) : r * (q + 1) + (xcd - r) * q) + off; }
    const int nig = WGM * nN, gid = wgid / nig, fm = gid * WGM, gsz = (nM - fm) < WGM ? (nM - fm) : WGM;
    pm = fm + ((wgid % nig) % gsz); pn = (wgid % nig) / gsz; return true;
}

template <class Epi, class Sched, bool ALIGN_EPI>
__device__ __forceinline__ void gemm_phase(LAS unsigned char* lds, const char* A, const int K, const Sched& S, const Epi& E) {
    int tid = threadIdx.x; asm volatile("" : "+v"(tid));
    const int wid = __builtin_amdgcn_readfirstlane(tid >> 6), lane = tid & 63, wr = wid >> 2, wc = wid & 3, fr = lane & 15, fq = lane >> 4;
    const int nt = K / BK;
    int R[2], C[2]; unsigned voffB[2];
#pragma unroll
    for (int i = 0; i < 2; ++i) { stage_rc(tid * 16 + i * 8192, R[i], C[i]); const int Rb = Epi::PERM ? ((R[i] & ~31) + perm32(R[i] & 31)) : R[i]; voffB[i] = (unsigned)(Rb * K + C[i]) * 2u; }
    const size_t kstep = (size_t)(BK * 2);
    const size_t hstep = (size_t)HALF * K * 2;
    const unsigned ldsw = (unsigned)wid * 1024u;
    const int aoff = lds_byte(wr * 64 + fr, fq * 8), boff = lds_byte(wc * 32 + fr, fq * 8);
#define G8_SA(b, h) (((b) * 2 + (h)) * HTB)
#define G8_SB(b, h) ((4 + (b) * 2 + (h)) * HTB)
#define G8_STAGE_B(bufoff, gbase) do { _Pragma("unroll") for (int _i = 0; _i < 2; ++_i) \
        __builtin_amdgcn_global_load_lds((const unsigned*)((const char*)(gbase) + voffB[_i]), (LAS unsigned*)(lds + (bufoff) + ldsw + _i * 8192), 16, 0, 0); } while (0)
#define G8_STAGE_A(bufoff, kb, o0, o1) do { \
        __builtin_amdgcn_global_load_lds((const unsigned*)(A + (size_t)(kb) + (o0)), (LAS unsigned*)(lds + (bufoff) + ldsw), 16, 0, 0); \
        __builtin_amdgcn_global_load_lds((const unsigned*)(A + (size_t)(kb) + (o1)), (LAS unsigned*)(lds + (bufoff) + ldsw + 8192), 16, 0, 0); } while (0)
#define G8_LDA(dst, b, h) do { _Pragma("unroll") for (int m = 0; m < 4; ++m) _Pragma("unroll") for (int k = 0; k < 2; ++k) dst[m][k] = *(const LAS f16x8*)(lds + G8_SA(b, h) + aoff + m * 2048 + k * 1024); } while (0)
#define G8_LDB(dst, b, h) do { _Pragma("unroll") for (int n = 0; n < 2; ++n) _Pragma("unroll") for (int k = 0; k < 2; ++k) dst[n][k] = *(const LAS f16x8*)(lds + G8_SB(b, h) + boff + n * 2048 + k * 1024); } while (0)
#define G8_MMA(ai, bj, At, Bt) do { __builtin_amdgcn_s_setprio(1); _Pragma("unroll") for (int m = 0; m < 4; ++m) _Pragma("unroll") for (int n = 0; n < 2; ++n) _Pragma("unroll") for (int k = 0; k < 2; ++k) \
        acc[ai][bj][m][n] = __builtin_amdgcn_mfma_f32_16x16x32_f16(Bt[n][k], At[m][k], acc[ai][bj][m][n], 0, 0, 0); __builtin_amdgcn_s_setprio(0); } while (0)
#define G8_WAIT_V(n) asm volatile("s_waitcnt vmcnt(" #n ")" ::: "memory")
#define G8_WAIT_L(n) asm volatile("s_waitcnt lgkmcnt(" #n ")" ::: "memory")
#define G8_BAR __builtin_amdgcn_s_barrier()
#define G8_SCHED __builtin_amdgcn_sched_barrier(0)
    Unit cur, nxt; int ui = 0;
    if (!S.next(0, cur, R, C)) return;
    f32x4 acc[2][2][4][2];
#pragma unroll
    for (int a = 0; a < 2; ++a)
#pragma unroll
        for (int b = 0; b < 2; ++b)
#pragma unroll
            for (int m = 0; m < 4; ++m)
#pragma unroll
                for (int n = 0; n < 2; ++n) acc[a][b][m][n] = (f32x4){0.f, 0.f, 0.f, 0.f};
    f16x8 At[4][2], B0[2][2], B1[2][2];
    {
        const char* cB = cur.B;
        G8_STAGE_B(G8_SB(0, 0), cB); G8_STAGE_B(G8_SB(0, 1), cB + hstep); G8_STAGE_A(G8_SA(0, 0), 0, cur.ao[0][0], cur.ao[0][1]); G8_STAGE_A(G8_SA(0, 1), 0, cur.ao[1][0], cur.ao[1][1]);
        if (wr == 1) G8_BAR;
        G8_WAIT_V(2); G8_BAR;
        G8_STAGE_B(G8_SB(1, 0), cB + kstep); G8_STAGE_A(G8_SA(1, 0), kstep, cur.ao[0][0], cur.ao[0][1]); G8_STAGE_B(G8_SB(1, 1), cB + hstep + kstep);
        G8_WAIT_V(6); G8_BAR;
    }
    for (;;) {
        const bool has_next = S.next(ui + 1, nxt, R, C);
        if (!has_next) nxt = cur;
        const char* cB = cur.B; const char* nB = nxt.B;
        for (int t = 0; t < nt; t += 2) {
            const bool last = (t == nt - 2);
            const size_t ka1 = (size_t)(t + 1) * kstep;
            const size_t ka2 = last ? 0 : (size_t)(t + 2) * kstep, ka3 = ka2 + kstep;
            const unsigned o00 = last ? nxt.ao[0][0] : cur.ao[0][0], o01 = last ? nxt.ao[0][1] : cur.ao[0][1], o10 = last ? nxt.ao[1][0] : cur.ao[1][0], o11 = last ? nxt.ao[1][1] : cur.ao[1][1];
            const char* b2 = last ? nB : cB + (size_t)(t + 2) * kstep; const char* b3 = b2 + kstep;
            G8_LDB(B0, 0, 0); G8_LDB(B1, 0, 1); G8_SCHED; G8_LDA(At, 0, 0); G8_STAGE_A(G8_SA(1, 1), ka1, cur.ao[1][0], cur.ao[1][1]);
            G8_WAIT_V(8); G8_WAIT_L(0); G8_BAR; G8_MMA(0, 0, At, B0); G8_MMA(0, 1, At, B1); G8_BAR; G8_SCHED;
            G8_LDA(At, 0, 1); G8_STAGE_B(G8_SB(0, 0), b2); G8_STAGE_B(G8_SB(0, 1), b2 + hstep); G8_STAGE_A(G8_SA(0, 0), ka2, o00, o01);
            G8_WAIT_V(8); G8_WAIT_L(0); G8_BAR; if (cur.full) { G8_MMA(1, 0, At, B0); G8_MMA(1, 1, At, B1); } G8_BAR; G8_SCHED;
            G8_LDB(B0, 1, 0); G8_LDB(B1, 1, 1); G8_SCHED; G8_LDA(At, 1, 0); G8_STAGE_A(G8_SA(0, 1), ka2, o10, o11);
            G8_WAIT_V(8); G8_WAIT_L(0); G8_BAR; G8_MMA(0, 0, At, B0); G8_MMA(0, 1, At, B1); G8_BAR; G8_SCHED;
            G8_LDA(At, 1, 1); G8_STAGE_B(G8_SB(1, 0), b3); G8_STAGE_B(G8_SB(1, 1), b3 + hstep); G8_STAGE_A(G8_SA(1, 0), ka3, o00, o01);
            G8_WAIT_V(8); G8_WAIT_L(0); G8_BAR; if (cur.full) { G8_MMA(1, 0, At, B0); G8_MMA(1, 1, At, B1); } G8_BAR; G8_SCHED;
        }
        if constexpr (ALIGN_EPI) { if (wr == 0) G8_BAR; }
        E(acc, cur, wr, wc, fr, fq);
        if (!has_next) break;
#pragma unroll
        for (int a = 0; a < 2; ++a)
#pragma unroll
            for (int b = 0; b < 2; ++b)
#pragma unroll
                for (int m = 0; m < 4; ++m)
#pragma unroll
                    for (int n = 0; n < 2; ++n) acc[a][b][m][n] = (f32x4){0.f, 0.f, 0.f, 0.f};
        cur = nxt; ++ui;
        if constexpr (ALIGN_EPI) { if (wr == 1) G8_BAR; }
    }
    G8_WAIT_V(0);
    if constexpr (!ALIGN_EPI) { if (wr == 0) G8_BAR; }
    G8_BAR;
#undef G8_SA
#undef G8_SB
#undef G8_STAGE_A
#undef G8_STAGE_B
#undef G8_LDA
#undef G8_LDB
#undef G8_MMA
#undef G8_WAIT_V
#undef G8_WAIT_L
#undef G8_BAR
#undef G8_SCHED
}

struct EpiF32 {
    static constexpr bool PERM = false;
    float* Cc; int ldc;
    __device__ __forceinline__ void operator()(const f32x4 (&acc)[2][2][4][2], const Unit& u, int wr, int wc, int fr, int fq) const {
        const int row0 = u.row0 + wr * 64 + fr, col0 = u.pn * BM + wc * 32 + 4 * fq;
#pragma unroll
        for (int ai = 0; ai < 2; ++ai)
#pragma unroll
            for (int m = 0; m < 4; ++m) { float* rowp = Cc + (size_t)(row0 + ai * HALF + m * 16) * ldc + col0;
#pragma unroll
                for (int bj = 0; bj < 2; ++bj)
#pragma unroll
                    for (int n = 0; n < 2; ++n) *(f32x4*)(rowp + bj * HALF + n * 16) = acc[ai][bj][m][n]; }
    }
};
}

struct ArgTable { LAS const unsigned* base;
    __device__ __forceinline__ const float* operator[](int i) const { const unsigned lo = base[2 * i], hi = base[2 * i + 1];
        const GAS float* g = (const GAS float*)(((unsigned long long)(unsigned)__builtin_amdgcn_readfirstlane(hi) << 32) | (unsigned)__builtin_amdgcn_readfirstlane(lo)); return (const float*)g; } };
struct Frame {
    LAS unsigned char* lds;
    int tid, lane, wave, vcu, G;
    ArgTable in;
    __device__ __forceinline__ float* out() const { return (float*)in[26]; }
    __device__ __forceinline__ unsigned char* ws() const { return (unsigned char*)in[27]; }
};
__device__ __forceinline__ float wave_sum(float v) {
#pragma unroll
    for (int o = 1; o < 64; o <<= 1) v += __shfl_xor(v, o);
    return v;
}
__device__ __forceinline__ float fast_sigmoid(float x) { return 1.0f / (1.0f + __expf(-x)); }
__device__ __forceinline__ float silu_f(float x) { return x * fast_sigmoid(x); }
__device__ __forceinline__ float gelu_f(float x) { const float y = 0.7978845608028654f * (x + 0.044715f * x * x * x); return x * fast_sigmoid(2.0f * y); }
__device__ __forceinline__ unsigned pkh(float a, float b) { f16x2 v; v.x = (f16)a; v.y = (f16)b; return __builtin_bit_cast(unsigned, v); }

struct TItem { const float* W; int ldw, k0, srccol0; f16* WT; int ldt, dstrow0; float scale; };
__device__ __forceinline__ void titem_load(const TItem& t, f32x4 (&tv)[8], int lane) {
    const float* base = t.W + (size_t)t.k0 * t.ldw + t.srccol0;
    const unsigned o0 = (unsigned)(2 * (lane >> 3)) * (unsigned)t.ldw + 4u * (unsigned)(lane & 7), st = 16u * (unsigned)t.ldw;
#pragma unroll
    for (int i = 0; i < 4; ++i) { tv[2 * i] = __builtin_nontemporal_load((const f32x4*)(base + (o0 + (unsigned)i * st))); tv[2 * i + 1] = __builtin_nontemporal_load((const f32x4*)(base + (o0 + (unsigned)i * st + (unsigned)t.ldw))); }
}
__device__ __forceinline__ void titem_store(const TItem& t, const f32x4 (&tv)[8], LAS float* scr, int lane) {
    LAS unsigned* T = (LAS unsigned*)scr; const int r = lane >> 3, n4 = 4 * (lane & 7); const float sc = t.scale;
#pragma unroll
    for (int i = 0; i < 4; ++i) { const f32x4 a = tv[2 * i] * sc, b = tv[2 * i + 1] * sc; LAS unsigned* p = T + n4 * 36 + r + 8 * i;
        p[0] = pkh(a.x, b.x); p[36] = pkh(a.y, b.y); p[72] = pkh(a.z, b.z); p[108] = pkh(a.w, b.w); }
    LDS_WAIT(); asm volatile("" ::: "memory");
    const int c = lane & 7; f16* ob = t.WT + (size_t)t.dstrow0 * t.ldt + t.k0;
    const unsigned oo = (unsigned)(lane >> 3) * (unsigned)t.ldt + 8u * (unsigned)c, ost = 8u * (unsigned)t.ldt;
#pragma unroll
    for (int j = 0; j < 4; ++j) { const u32x4 o = *(const LAS u32x4*)(T + ((lane >> 3) + 8 * j) * 36 + 4 * c);
        __builtin_nontemporal_store(o, (GAS u32x4*)(ob + (oo + (unsigned)j * ost))); }
    LDS_WAIT(); asm volatile("" ::: "memory");
}
__device__ __forceinline__ void transpose_item(const float* W, int ldw, int k0, int srccol0, f16* WT, int ldt, int dstrow0, float scale, LAS float* scr, int lane) {
    TItem t{W, ldw, k0, srccol0, WT, ldt, dstrow0, scale}; f32x4 tv[8]; titem_load(t, tv, lane); titem_store(t, tv, scr, lane);
}
__device__ __forceinline__ int win_srccol(int n0, float& scale) {
    const int t = n0 >> 8, c = n0 & 255; scale = 1.0f;
    if (t >= 8 && t < 16) {
        const int hl = 2 * (t & 3) + ((c & 127) >> 6), dim = (c & 63) + 64 * (c >> 7);
        if (t >= 12) scale = 0.08838834764831845f;
        return (t >= 12 ? 3072 : 2048) + hl * 128 + dim;
    }
    return n0;
}
__device__ __forceinline__ void p0_prologue(Frame& F) {
    LAS float* scr = (LAS float*)(F.lds + RING_OFF + F.wave * 16384);
    const int gw = F.vcu * NWAVES + F.wave, NGW = F.G * NWAVES;
    {
        LAS float* sc = (LAS float*)(F.lds + RING_OFF);
        LAS float* red = sc + 3 * 2048;
        const float* c = F.in[1]; const float* cc = F.in[3]; const float* wm = F.in[4]; const float* bm = F.in[5];
        for (int i = F.tid; i < 3 * 2048; i += 512) { const float v = i < 4096 ? c[i] : cc[i - 4096]; sc[i] = silu_f(v); }
        __syncthreads();
        for (int cb = F.vcu; cb < 256; cb += F.G) {
            const int col0 = cb * 48;
            const int r = F.lane / 12, c4 = F.lane % 12;
            f32x4 a0 = {0, 0, 0, 0}, a1 = {0, 0, 0, 0}, a2 = {0, 0, 0, 0};
            if (F.lane < 60) {
                for (int kb = F.wave * 5 + r; kb < 2048; kb += 320) {
                    f32x4 wv[8];
#pragma unroll
                    for (int j = 0; j < 8; ++j) { const int k = kb + 40 * j; wv[j] = (k < 2048) ? *(const f32x4*)(wm + (size_t)k * 12288 + col0 + 4 * c4) : (f32x4){0.f, 0.f, 0.f, 0.f}; }
#pragma unroll
                    for (int j = 0; j < 8; ++j) { const int k = (kb + 40 * j) & 2047; a0 += wv[j] * sc[k]; a1 += wv[j] * sc[2048 + k]; a2 += wv[j] * sc[4096 + k]; }
                }
                LAS float* rp = red + ((F.wave * 5 + r) * 3) * 48 + 4 * c4;
                *(LAS f32x4*)(rp) = a0; *(LAS f32x4*)(rp + 48) = a1; *(LAS f32x4*)(rp + 96) = a2;
            }
            __syncthreads();
            if (F.tid < 144) { float s = 0.f; for (int j = 0; j < 40; ++j) s += red[j * 144 + F.tid];
                const int v = F.tid / 48, cl = F.tid % 48; ((float*)(F.ws() + WS_MOD))[v * 12288 + col0 + cl] = s + bm[col0 + cl]; }
            __syncthreads();
        }
    }
    if (F.vcu == 0) { float* rope = (float*)(F.ws() + WS_ROPE);
        for (int i = F.tid; i < 2048; i += 512) { const int pos = i >> 5, j = i & 31; const float inv = powf(10000.0f, -(float)j / 32.0f); const float ang = (float)pos * inv;
            rope[i] = cosf(ang); rope[2048 + i] = sinf(ang); } }
    { const float* rw = F.in[17]; f16* rh = (f16*)(F.ws() + WS_RWT); f16* rl = rh + NE * DM;
      for (int idx = F.vcu * 512 + F.tid; idx < NE * DM; idx += F.G * 512) { const int k = idx >> 6, e = idx & 63; const float v = rw[idx]; const f16 hi = (f16)v; rh[e * DM + k] = hi; rl[e * DM + k] = (f16)((v - (float)hi) * 2048.0f); } }
    constexpr int I_IN = 32 * 192, I_OUT = 32 * 64;
    for (int it = gw; it < I_IN + I_OUT; it += NGW) {
        int r = it;
        if (r < I_IN) { const int kb = r / 192, nb = r % 192; float scale; const int src = win_srccol(nb * 32, scale);
            transpose_item(F.in[8], INC, kb * 64, src, (f16*)(F.ws() + WS_WINT), DM, nb * 32, scale, scr, F.lane); continue; }
        r -= I_IN;
        { const int kb = r / 64, nb = r % 64; transpose_item(F.in[16], DM, kb * 64, nb * 32, (f16*)(F.ws() + WS_WOUTT), DM, nb * 32, 1.0f, scr, F.lane); }
    }
}
__device__ __forceinline__ TItem expert_item(Frame& F, int it) {
    constexpr int I_E = 1536; const int e = it / I_E; int r = it % I_E; TItem t;
    if (r < 1024) {
        const int kb = r / 32, nb = r % 32, pn = nb >> 3, wi = nb & 7;
        t.W = (e < NE) ? ((wi < 4 ? F.in[19] : F.in[20]) + (size_t)e * DM * EH) : (wi < 4 ? F.in[22] : F.in[23]);
        t.ldw = EH; t.k0 = kb * 64; t.srccol0 = pn * 128 + (wi & 3) * 32; t.WT = (f16*)(F.ws() + WS_W13T) + (size_t)e * 1024 * DM; t.ldt = DM; t.dstrow0 = nb * 32; t.scale = 1.0f;
    } else {
        r -= 1024; const int kb = r / 64, nb = r % 64;
        t.W = (e < NE) ? (F.in[21] + (size_t)e * EH * DM) : F.in[24];
        t.ldw = DM; t.k0 = kb * 64; t.srccol0 = nb * 32; t.WT = (f16*)(F.ws() + WS_W2T) + (size_t)e * DM * EH; t.ldt = EH; t.dstrow0 = nb * 32; t.scale = 1.0f;
    }
    return t;
}
__device__ __forceinline__ void p2_expert_copies(Frame& F) {
    LAS float* scr = (LAS float*)(F.lds + RING_OFF + F.wave * 16384);
    constexpr int NIT = NE1 * 1536, N_CTXWG = 64, SH_CTX = 292, SH_REG = (NIT - N_CTXWG * SH_CTX) / 192, REM = (NIT - N_CTXWG * SH_CTX) % 192;
    int lo, n;
    if (F.vcu < N_CTXWG) { lo = F.vcu * SH_CTX; n = SH_CTX; }
    else { const int v = F.vcu - N_CTXWG; lo = N_CTXWG * SH_CTX + v * SH_REG + (v < REM ? v : REM); n = SH_REG + (v < REM ? 1 : 0); }
    const int hi = lo + n;
    TItem t0, t1, t2; f32x4 v0[8], v1[8], v2[8];
    int it = lo + F.wave;
    if (it < hi) { t0 = expert_item(F, it); titem_load(t0, v0, F.lane); }
    if (it + NWAVES < hi) { t1 = expert_item(F, it + NWAVES); titem_load(t1, v1, F.lane); }
    for (; it < hi; it += 3 * NWAVES) {
        if (it + 2 * NWAVES < hi) { t2 = expert_item(F, it + 2 * NWAVES); titem_load(t2, v2, F.lane); }
        titem_store(t0, v0, scr, F.lane);
        if (it + 3 * NWAVES < hi) { t0 = expert_item(F, it + 3 * NWAVES); titem_load(t0, v0, F.lane); }
        if (it + NWAVES < hi) titem_store(t1, v1, scr, F.lane);
        if (it + 4 * NWAVES < hi) { t1 = expert_item(F, it + 4 * NWAVES); titem_load(t1, v1, F.lane); }
        if (it + 2 * NWAVES < hi) titem_store(t2, v2, scr, F.lane);
    }
}

constexpr int IMG_LD = 136;
constexpr int IMG_BYTES = 128 * IMG_LD * 2;
__device__ __forceinline__ void wave_mma(f32x4 (&acc)[8], const f16x8 (&a)[4], const LAS f16* img, int fr, int fq) {
#pragma unroll
    for (int ks = 0; ks < 4; ++ks) { __builtin_amdgcn_sched_barrier(0);
#pragma unroll
        for (int t = 0; t < 8; ++t) { const f16x8 b = *(const LAS f16x8*)(img + (16 * t + fr) * IMG_LD + 32 * ks + 8 * fq); acc[t] = __builtin_amdgcn_mfma_f32_16x16x32_f16(b, a[ks], acc[t], 0, 0, 0); } }
    __builtin_amdgcn_sched_barrier(0);
}
__device__ __forceinline__ void zero8(f32x4 (&acc)[8]) {
#pragma unroll
    for (int t = 0; t < 8; ++t) acc[t] = (f32x4){0.f, 0.f, 0.f, 0.f};
}
__device__ __forceinline__ void stage_rows(LAS f16* img, const f16* src, int ld, int tid) {
#pragma unroll
    for (int it = 0; it < 4; ++it) { const int r = (tid >> 4) + 32 * it, cc = (tid & 15) * 8; *(LAS u32x4*)(img + r * IMG_LD + cc) = *(const u32x4*)(src + (size_t)r * ld + cc); }
}
__device__ __forceinline__ void stage_rows_f32(LAS f16* img, const float* src, int tid) {
#pragma unroll
    for (int it = 0; it < 8; ++it) { const int r = (tid >> 5) + 16 * it, cc = (tid & 31) * 4; const f32x4 v = *(const f32x4*)(src + (size_t)r * 128 + cc);
        u32x2 o; o.x = pkh(v.x, v.y); o.y = pkh(v.z, v.w); *(LAS u32x2*)(img + r * IMG_LD + cc) = o; }
}


__device__ __forceinline__ void p2_ctx_unit(Frame& F, int u) {
    const int rb = u >> 4, cb = u & 15, h = cb & 7; const bool isv = cb >= 8;
    const f16* HXc = (const f16*)(F.ws() + WS_HX) + (size_t)(NTOK + rb * 128) * DM; const f16* WT = (const f16*)(F.ws() + WS_WINT);
    LAS f16* imA = (LAS f16*)(F.lds); LAS f16* imB = (LAS f16*)(F.lds + IMG_BYTES);
    const int fr = F.lane & 15, fq = F.lane >> 4, w = F.wave;
    const int r0 = F.tid >> 4, cc = (F.tid & 15) * 8;
    const f16* ap[4]; const f16* bp[4];
#pragma unroll
    for (int it = 0; it < 4; ++it) { const int r = r0 + 32 * it; ap[it] = HXc + (size_t)r * DM + cc;
        const int brow = isv ? (4096 + h * 128 + r) : ((12 + (h >> 1)) * 256 + (r >> 6) * 128 + (h & 1) * 64 + (r & 63)); bp[it] = WT + (size_t)brow * DM + cc; }
    u32x4 aw[4], bw[4];
#pragma unroll
    for (int it = 0; it < 4; ++it) { aw[it] = *(const u32x4*)(ap[it]); bw[it] = *(const u32x4*)(bp[it]); }
    f32x4 acc[8]; zero8(acc);
    for (int kc = 0; kc < 16; ++kc) {
#pragma unroll
        for (int it = 0; it < 4; ++it) { const int r = r0 + 32 * it; *(LAS u32x4*)(imA + r * IMG_LD + cc) = aw[it]; *(LAS u32x4*)(imB + r * IMG_LD + cc) = bw[it]; }
        if (kc < 15) {
#pragma unroll
            for (int it = 0; it < 4; ++it) { aw[it] = *(const u32x4*)(ap[it] + (kc + 1) * 128); bw[it] = *(const u32x4*)(bp[it] + (kc + 1) * 128); } }
        __syncthreads();
        f16x8 a[4];
#pragma unroll
        for (int ks = 0; ks < 4; ++ks) a[ks] = *(const LAS f16x8*)(imA + (16 * w + fr) * IMG_LD + 32 * ks + 8 * fq);
        wave_mma(acc, a, imB, fr, fq);
        __syncthreads();
    }
    f16* dst = (f16*)(F.ws() + (isv ? WS_CV : WS_CK)) + (size_t)(rb * 128 + 16 * w + fr) * AW + h * 128;
#pragma unroll
    for (int t = 0; t < 8; ++t) { u32x2 o; o.x = pkh(acc[t].x, acc[t].y); o.y = pkh(acc[t].z, acc[t].w); *(u32x2*)(dst + 16 * t + 4 * fq) = o; }
}
__device__ __forceinline__ void p1_norm(Frame& F) {
    const int gw = F.vcu * NWAVES + F.wave, NGW = F.G * NWAVES;
    const float* g1 = F.in[6]; const float* xin = F.in[0]; const float* cin = F.in[2]; const float* modb = (const float*)(F.ws() + WS_MOD); f16* HX = (f16*)(F.ws() + WS_HX);
    f32x4 nx[8];
    { const int row = gw; const float* xr = row < NTOK ? xin + (size_t)row * DM : cin + (size_t)(row - NTOK) * DM;
#pragma unroll
      for (int j = 0; j < 8; ++j) nx[j] = *(const f32x4*)(xr + 4 * F.lane + 256 * j); }
    for (int row = gw; row < NROWS_IN; row += NGW) {
        f32x4 v[8]; float ss = 0.f;
#pragma unroll
        for (int j = 0; j < 8; ++j) { v[j] = nx[j]; ss += (v[j].x * v[j].x + v[j].y * v[j].y) + (v[j].z * v[j].z + v[j].w * v[j].w); }
        { const int r2 = row + NGW; if (r2 < NROWS_IN) { const float* xr = r2 < NTOK ? xin + (size_t)r2 * DM : cin + (size_t)(r2 - NTOK) * DM;
#pragma unroll
            for (int j = 0; j < 8; ++j) nx[j] = *(const f32x4*)(xr + 4 * F.lane + 256 * j); } }
        const float* mod = modb + (row < NTOK ? (row >> 12) : 2) * 12288;
        const float rstd = 1.0f / sqrtf(wave_sum(ss) * (1.0f / DM) + EPS);
        f16* orow = HX + (size_t)row * DM;
#pragma unroll
        for (int j = 0; j < 8; ++j) { const int col = 4 * F.lane + 256 * j;
            const f32x4 g = *(const f32x4*)(g1 + col), sh = *(const f32x4*)(mod + col), sc = *(const f32x4*)(mod + 2048 + col);
            const f32x4 h = (v[j] * rstd * g) * (sc + 1.0f) + sh;
            u32x2 o; o.x = pkh(h.x, h.y); o.y = pkh(h.z, h.w); *(u32x2*)(orow + col) = o; }
    }
}

struct InSched { int G, c; const char* Bt; int ulo, uhi;
    __device__ __forceinline__ bool next(int i, g8::Unit& u, const int (&R)[2], const int (&C)[2]) const {
        if (i + ulo >= uhi) return false; const int L = (i + ulo) * G + c; int pm, pn;
        if (!g8::dense_order(L, 32, 24, pm, pn)) return false;
#pragma unroll
        for (int h = 0; h < 2; ++h)
#pragma unroll
            for (int k = 0; k < 2; ++k) u.ao[h][k] = (unsigned)((pm * 256 + h * 128 + R[k]) * DM + C[k]) * 2u;
        u.B = Bt + (size_t)pn * 256 * DM * 2; u.row0 = pm * 256; u.pn = pn; u.aux = 0; u.full = 1;
        return true;
    }
};

struct EpiIn {
    static constexpr bool PERM = true;
    f16* PB; f16* CK; f16* CV; float* vstp; const float* rope;
    __device__ __forceinline__ void operator()(const f32x4 (&acc)[2][2][4][2], const g8::Unit& u, int wr, int wc, int fr, int fq) const {
        const int pn = u.pn, ty = pn >> 2; const bool ctx = u.row0 >= NTOK;
        const int c1 = wc * 32 + 8 * fq;
        if (ty == 2 || ty == 3) {
            const int head = 2 * (pn & 3) + (wc >> 1), i0 = c1 & 63, isq = (ty == 2);
            f16* dstb = ctx ? CK : (PB + (size_t)(isq ? 2 : 3) * NTOK * AW);
#pragma unroll
            for (int ai = 0; ai < 2; ++ai)
#pragma unroll
                for (int m = 0; m < 4; ++m) { const int row = u.row0 + ai * 128 + wr * 64 + m * 16 + fr;
                    const f32x4 a0 = acc[ai][0][m][0], a1 = acc[ai][0][m][1], b0 = acc[ai][1][m][0], b1 = acc[ai][1][m][1];
                    f32x4 c0 = {1.f, 1.f, 1.f, 1.f}, c1v = c0, s0 = {0.f, 0.f, 0.f, 0.f}, s1 = s0;
                    if (!ctx) { const int tpos = row & (SEQ - 1); const int pos = (wc & 1) ? (tpos & 63) : (tpos >> 6); const float* rp = rope + pos * 32 + (i0 & 31);
                        c0 = *(const f32x4*)(rp); c1v = *(const f32x4*)(rp + 4); s0 = *(const f32x4*)(rp + 2048); s1 = *(const f32x4*)(rp + 2052); }
                    const f32x4 o1a = a0 * c0 - b0 * s0, o1b = a1 * c1v - b1 * s1, o2a = a0 * s0 + b0 * c0, o2b = a1 * s1 + b1 * c1v;
                    const int drow = ctx ? row - NTOK : row;
                    f16* d = dstb + (size_t)drow * AW + head * 128 + i0;
                    u32x4 w1; w1.x = pkh(o1a[0], o1a[1]); w1.y = pkh(o1a[2], o1a[3]); w1.z = pkh(o1b[0], o1b[1]); w1.w = pkh(o1b[2], o1b[3]);
                    u32x4 w2; w2.x = pkh(o2a[0], o2a[1]); w2.y = pkh(o2a[2], o2a[3]); w2.z = pkh(o2b[0], o2b[1]); w2.w = pkh(o2b[2], o2b[3]);
                    *(u32x4*)d = w1; *(u32x4*)(d + 64) = w2; }
            return;
        }
        const int sel = (ty == 0) ? 0 : (ty == 1) ? 1 : (ty == 4) ? 4 : 5;
        f16* dstb = (ctx ? CV : PB + (size_t)sel * NTOK * AW) + (pn & 3) * 256 + c1;
#pragma unroll
        for (int ai = 0; ai < 2; ++ai)
#pragma unroll
            for (int m = 0; m < 4; ++m) { const int row = u.row0 + ai * 128 + wr * 64 + m * 16 + fr; const int drow = ctx ? row - NTOK : row;
                float s = 0.f, q = 0.f;
#pragma unroll
                for (int bj = 0; bj < 2; ++bj) { f32x4 v0 = acc[ai][bj][m][0], v1 = acc[ai][bj][m][1];
                    if (ty <= 1) {
#pragma unroll
                        for (int j = 0; j < 4; ++j) { v0[j] = gelu_f(v0[j]); v1[j] = gelu_f(v1[j]); } }
                    else if (ty == 5) {
#pragma unroll
                        for (int j = 0; j < 4; ++j) { v0[j] = silu_f(v0[j]); v1[j] = silu_f(v1[j]); } }
                    if (ty == 1) { s += (v0[0] + v0[1]) + (v0[2] + v0[3]) + (v1[0] + v1[1]) + (v1[2] + v1[3]);
                        q += (v0[0] * v0[0] + v0[1] * v0[1]) + (v0[2] * v0[2] + v0[3] * v0[3]) + (v1[0] * v1[0] + v1[1] * v1[1]) + (v1[2] * v1[2] + v1[3] * v1[3]); }
                    u32x4 o; o.x = pkh(v0[0], v0[1]); o.y = pkh(v0[2], v0[3]); o.z = pkh(v1[0], v1[1]); o.w = pkh(v1[2], v1[3]);
                    *(u32x4*)(dstb + (size_t)drow * AW + bj * 128) = o; }
                if (ty == 1) { s += __shfl_xor(s, 16); s += __shfl_xor(s, 32); q += __shfl_xor(q, 16); q += __shfl_xor(q, 32);
                    if (fq == 0) { f32x2 st; st.x = s; st.y = q; *(f32x2*)(vstp + ((size_t)row * 16 + (pn & 3) * 4 + wc) * 2) = st; } } }
    }
};
struct EpiX1 {
    static constexpr bool PERM = false;
    const float* x; const float* mod; float* X1;
    __device__ __forceinline__ void operator()(const f32x4 (&acc)[2][2][4][2], const g8::Unit& u, int wr, int wc, int fr, int fq) const {
        const int row0 = u.row0 + wr * 64 + fr, col0 = u.pn * 256 + wc * 32 + 4 * fq;
        const float* g1 = mod + (u.row0 >> 12) * 12288 + 2 * 2048;
        f32x4 gv[2][2];
#pragma unroll
        for (int bj = 0; bj < 2; ++bj)
#pragma unroll
            for (int n = 0; n < 2; ++n) gv[bj][n] = *(const f32x4*)(g1 + col0 + bj * 128 + n * 16);
#pragma unroll
        for (int ai = 0; ai < 2; ++ai)
#pragma unroll
            for (int m = 0; m < 4; ++m) { const size_t off = (size_t)(row0 + ai * 128 + m * 16) * DM + col0;
#pragma unroll
                for (int bj = 0; bj < 2; ++bj)
#pragma unroll
                    for (int n = 0; n < 2; ++n) { const f32x4 xv = *(const f32x4*)(x + off + bj * 128 + n * 16); *(f32x4*)(X1 + off + bj * 128 + n * 16) = xv + gv[bj][n] * acc[ai][bj][m][n]; }
                if (m & 1) asm volatile("" ::: "memory"); }
    }
};
__device__ __forceinline__ void p3_post(Frame& F) {
    const int gw = F.vcu * NWAVES + F.wave, NGW = F.G * NWAVES;
    const float* CB = (const float*)(F.ws() + WS_CBUF);
    f16* UG = (f16*)(F.ws() + WS_PBUF); f16* VG = UG + (size_t)NTOK * AW; f16* Qb = VG + (size_t)NTOK * AW; f16* Kb = Qb + (size_t)NTOK * AW; f16* VR = Kb + (size_t)NTOK * AW; f16* GS = VR + (size_t)NTOK * AW;
    f16* CK = (f16*)(F.ws() + WS_CK); f16* CV = (f16*)(F.ws() + WS_CV);
    const float* rope = (const float*)(F.ws() + WS_ROPE);
    float* vstat = (float*)(F.ws() + WS_VSTAT);
    for (int row = gw; row < NROWS_IN; row += NGW) {
        const float* cr = CB + (size_t)row * INC;
        if (row < NTOK) {
            float gv[16]; float s = 0.f;
#pragma unroll
            for (int j = 0; j < 4; ++j) { const int col = 256 * j + 4 * F.lane;
                const f32x4 u = *(const f32x4*)(cr + col); u32x2 o; o.x = pkh(gelu_f(u.x), gelu_f(u.y)); o.y = pkh(gelu_f(u.z), gelu_f(u.w)); *(u32x2*)(UG + (size_t)row * AW + col) = o;
                const f32x4 v = *(const f32x4*)(cr + 1024 + col); gv[4 * j] = gelu_f(v.x); gv[4 * j + 1] = gelu_f(v.y); gv[4 * j + 2] = gelu_f(v.z); gv[4 * j + 3] = gelu_f(v.w);
                s += (gv[4 * j] + gv[4 * j + 1]) + (gv[4 * j + 2] + gv[4 * j + 3]);
                u32x2 o2; o2.x = pkh(gv[4 * j], gv[4 * j + 1]); o2.y = pkh(gv[4 * j + 2], gv[4 * j + 3]); *(u32x2*)(VG + (size_t)row * AW + col) = o2;
                const f32x4 w = *(const f32x4*)(cr + 4096 + col); u32x2 o3; o3.x = pkh(w.x, w.y); o3.y = pkh(w.z, w.w); *(u32x2*)(VR + (size_t)row * AW + col) = o3;
                const f32x4 g = *(const f32x4*)(cr + 5120 + col); u32x2 o4; o4.x = pkh(silu_f(g.x), silu_f(g.y)); o4.y = pkh(silu_f(g.z), silu_f(g.w)); *(u32x2*)(GS + (size_t)row * AW + col) = o4; }
            const float mean = wave_sum(s) * (1.0f / AW); float q = 0.f;
#pragma unroll
            for (int j = 0; j < 16; ++j) { const float d = gv[j] - mean; q += d * d; }
            const float rstd = 1.0f / sqrtf(wave_sum(q) * (1.0f / AW) + EPS);
            if (F.lane == 0) { vstat[2 * row] = mean; vstat[2 * row + 1] = rstd; }
            const int tpos = row & (SEQ - 1), rpos = tpos >> 6, cpos = tpos & 63;
            for (int t = 8; t < 16; ++t) {
#pragma unroll
                for (int cc = 0; cc < 2; ++cc) { const int c = F.lane + 64 * cc;
                    const float x1 = cr[256 * t + c], x2 = cr[256 * t + 128 + c];
                    const int head = 2 * (t & 3) + (c >> 6), i = c & 63;
                    const int ri = (i < 32) ? (rpos * 32 + i) : (cpos * 32 + (i - 32));
                    const float cs = rope[ri], sn = rope[2048 + ri];
                    f16* dst = (t < 12 ? Qb : Kb) + (size_t)row * AW + head * 128 + i;
                    dst[0] = (f16)(x1 * cs - x2 * sn); dst[64] = (f16)(x1 * sn + x2 * cs); }
            }
        } else {
            const int rc = row - NTOK;
            for (int t = 12; t < 16; ++t) {
#pragma unroll
                for (int cc = 0; cc < 2; ++cc) { const int c = F.lane + 64 * cc; const float x1 = cr[256 * t + c], x2 = cr[256 * t + 128 + c];
                    const int head = 2 * (t & 3) + (c >> 6), i = c & 63; f16* dst = CK + (size_t)rc * AW + head * 128 + i; dst[0] = (f16)x1; dst[64] = (f16)x2; }
            }
#pragma unroll
            for (int j = 0; j < 4; ++j) { const int col = 256 * j + 4 * F.lane; const f32x4 w = *(const f32x4*)(cr + 4096 + col); u32x2 o3; o3.x = pkh(w.x, w.y); o3.y = pkh(w.z, w.w); *(u32x2*)(CV + (size_t)rc * AW + col) = o3; }
        }
    }
}

__device__ __forceinline__ size_t st_index(int dir, int bh, int slot) { return ((size_t)(dir * 16 + bh) * 33 + slot) * 16384; }
__device__ __forceinline__ void p4_naive(Frame& F) {
    const int gt = F.vcu * 512 + F.tid, NGT = F.G * 512;
    const f16* UG = (const f16*)(F.ws() + WS_PBUF); const f16* VG = UG + (size_t)NTOK * AW; const f16* Kb = VG + (size_t)2 * NTOK * AW; const f16* VR = Kb + (size_t)NTOK * AW;
    const f16* CK = (const f16*)(F.ws() + WS_CK); const f16* CV = (const f16*)(F.ws() + WS_CV);
    const float* vstat = (const float*)(F.ws() + WS_VSTAT);
    const float* alng = F.in[9]; const float* aws = F.in[10]; const float* abs_ = F.in[11];
    const float* lgf = F.in[13]; const float* lgb = F.in[14];
    float* ARAW = (float*)(F.ws() + WS_ARAW);
    float* ST = (float*)(F.ws() + WS_ST);
    for (int idx = gt; idx < NTOK * AW; idx += NGT) {
        const int t = idx >> 10, j = idx & 1023, h = j >> 7, p = t & 127, t0 = t - p;
        float s = abs_[h * 128 + p]; const float g = alng[j]; const float* wrow = aws + (size_t)(h * 128 + p) * 128;
        for (int q = 0; q < 128; ++q) { const float vn = ((float)VG[(size_t)(t0 + q) * AW + j] - vstat[2 * (t0 + q)]) * vstat[2 * (t0 + q) + 1] * g; s += wrow[q] * vn; }
        ARAW[idx] = (float)UG[idx] * s;
    }
    for (int idx = gt; idx < 2 * 16 * 16384; idx += NGT) {
        const int d = idx & 127, v = (idx >> 7) & 127, bh = (idx >> 14) & 15, dir = idx >> 18, b = bh >> 3, h = bh & 7;
        const float lg = dir ? lgb[h] : lgf[h]; float s = 0.f;
        for (int l = 0; l < CTXL; ++l) { const float w = __expf(lg * (dir ? (float)l : (float)(CTXL - 1 - l)));
            s += w * (float)CV[(size_t)(b * CTXL + l) * AW + h * 128 + v] * (float)CK[(size_t)(b * CTXL + l) * AW + h * 128 + d]; }
        ST[st_index(dir, bh, 0) + v * 128 + d] = s;
    }
    for (int idx = gt; idx < 2 * 16 * 32 * 16384; idx += NGT) {
        const int d = idx & 127, v = (idx >> 7) & 127, i = (idx >> 14) & 31, bh = (idx >> 19) & 15, dir = idx >> 23, b = bh >> 3, h = bh & 7;
        const float lg = dir ? lgb[h] : lgf[h]; float s = 0.f; const size_t t0 = (size_t)b * SEQ + i * CHK;
        for (int m = 0; m < CHK; ++m) { const float w = __expf(lg * (dir ? (float)m : (float)(CHK - 1 - m)));
            s += w * (float)VR[(t0 + m) * AW + h * 128 + v] * (float)Kb[(t0 + m) * AW + h * 128 + d]; }
        ST[st_index(dir, bh, dir ? 32 - i : i + 1) + v * 128 + d] = s;
    }
}

__device__ __forceinline__ void p4_fast(Frame& F) {
    const f16* UG = (const f16*)(F.ws() + WS_PBUF); const f16* VG = UG + (size_t)NTOK * AW; const f16* Kb = VG + (size_t)2 * NTOK * AW; const f16* VR = Kb + (size_t)NTOK * AW;
    const f16* CK = (const f16*)(F.ws() + WS_CK); const f16* CV = (const f16*)(F.ws() + WS_CV);
    const float* vstat = (const float*)(F.ws() + WS_VSTAT);
    const float* alng = F.in[9]; const float* aws = F.in[10]; const float* abs_ = F.in[11];
    const float* lgf = F.in[13]; const float* lgb = F.in[14];
    float* ARAW = (float*)(F.ws() + WS_ARAW); float* ST = (float*)(F.ws() + WS_ST);
    LAS f16* im0 = (LAS f16*)(F.lds); LAS f16* im1 = (LAS f16*)(F.lds + IMG_BYTES); LAS f16* im2 = (LAS f16*)(F.lds + 2 * IMG_BYTES);
    const int fr = F.lane & 15, fq = F.lane >> 4, w = F.wave;
    constexpr int NU_MLP = 512, NU_LOC = 512, NU_CTX = 32, NU = NU_MLP + NU_LOC + NU_CTX;
    for (int u = F.vcu; u < NU; u += F.G) {
        if (u < NU_MLP) {
            const int h = u & 7, ci = u >> 3, t0 = ci * CHK, hc = h * 128;
            float mean, rstd; { const float* pp = vstat + (size_t)(t0 + (F.tid & 127)) * 32; float ssum = 0.f, qsum = 0.f;
#pragma unroll
                for (int k = 0; k < 16; ++k) { const f32x2 st = *(const f32x2*)(pp + 2 * k); ssum += st.x; qsum += st.y; }
                mean = ssum * (1.0f / AW); rstd = 1.0f / sqrtf(fmaxf(qsum * (1.0f / AW) - mean * mean, 0.f) + EPS); }
#pragma unroll
            for (int it = 0; it < 4; ++it) { const int q = F.tid & 127, cc = ((F.tid >> 7) + 4 * it) * 8;
                const f16x8 v = *(const f16x8*)(VG + (size_t)(t0 + q) * AW + hc + cc);
#pragma unroll
                for (int j = 0; j < 8; ++j) im0[(cc + j) * IMG_LD + q] = (f16)(((float)v[j] - mean) * rstd * alng[hc + cc + j]); }
            f16x8 a[4]; const float* wrow = aws + (size_t)(hc + 16 * w + fr) * 128;
#pragma unroll
            for (int ks = 0; ks < 4; ++ks) { const f32x4 x0 = *(const f32x4*)(wrow + 32 * ks + 8 * fq), x1 = *(const f32x4*)(wrow + 32 * ks + 8 * fq + 4);
                a[ks][0] = (f16)x0.x; a[ks][1] = (f16)x0.y; a[ks][2] = (f16)x0.z; a[ks][3] = (f16)x0.w; a[ks][4] = (f16)x1.x; a[ks][5] = (f16)x1.y; a[ks][6] = (f16)x1.z; a[ks][7] = (f16)x1.w; }
            __syncthreads();
            f32x4 acc[8]; zero8(acc); wave_mma(acc, a, im0, fr, fq);
            const int p = 16 * w + fr; const float bias = abs_[hc + p];
#pragma unroll
            for (int t = 0; t < 8; ++t) { const int d = 16 * t + 4 * fq; const f16x4 ug = *(const f16x4*)(UG + (size_t)(t0 + p) * AW + hc + d);
                f32x4 o; o.x = (float)ug.x * (acc[t].x + bias); o.y = (float)ug.y * (acc[t].y + bias); o.z = (float)ug.z * (acc[t].z + bias); o.w = (float)ug.w * (acc[t].w + bias);
                *(f32x4*)(ARAW + (size_t)(t0 + p) * AW + hc + d) = o; }
            __syncthreads();
        } else {
            const bool isctx = (u >= NU_MLP + NU_LOC); const int uu = isctx ? (u - NU_MLP - NU_LOC) : (u - NU_MLP);
            const int bh = isctx ? (uu >> 1) : (uu >> 5), i = isctx ? 0 : (uu & 31), b = bh >> 3, h = bh & 7, hc = h * 128, chf = uu & 1;
            const float lf = lgf[h], lb = lgb[h];
            f32x4 af[8], ab[8]; zero8(af); zero8(ab);
            { const int hf = isctx ? chf : 0;
                const f16* ksrc = isctx ? (CK + (size_t)(b * CTXL + hf * 128) * AW + hc) : (Kb + (size_t)(b * SEQ + i * CHK) * AW + hc);
                const f16* vsrc = isctx ? (CV + (size_t)(b * CTXL + hf * 128) * AW + hc) : (VR + (size_t)(b * SEQ + i * CHK) * AW + hc);
                const int L = isctx ? CTXL : CHK;
#pragma unroll
                for (int it = 0; it < 4; ++it) { const int m = F.tid & 127, cc = ((F.tid >> 7) + 4 * it) * 8; const int l = hf * 128 + m;
                    const f16x8 kv = *(const f16x8*)(ksrc + (size_t)m * AW + cc); const f16x8 vv = *(const f16x8*)(vsrc + (size_t)m * AW + cc);
                    const float wf = __expf(lf * (float)(L - 1 - l)), wb = __expf(lb * (float)l);
#pragma unroll
                    for (int j = 0; j < 8; ++j) { im0[(cc + j) * IMG_LD + m] = vv[j]; im1[(cc + j) * IMG_LD + m] = (f16)((float)kv[j] * wf); im2[(cc + j) * IMG_LD + m] = (f16)((float)kv[j] * wb); } }
                __syncthreads();
                f16x8 a[4];
#pragma unroll
                for (int ks = 0; ks < 4; ++ks) a[ks] = *(const LAS f16x8*)(im0 + (16 * w + fr) * IMG_LD + 32 * ks + 8 * fq);
                wave_mma(af, a, im1, fr, fq); wave_mma(ab, a, im2, fr, fq);
                __syncthreads();
            }
            const int sf = isctx ? (chf ? 32 : 0) : i + 1, sb = isctx ? (chf ? 32 : 0) : 32 - i;
            float* df = ST + st_index(0, bh, sf) + (16 * w + fr) * 128; float* db = ST + st_index(1, bh, sb) + (16 * w + fr) * 128;
            if (isctx || sf != 32) {
#pragma unroll
                for (int t = 0; t < 8; ++t) *(f32x4*)(df + 16 * t + 4 * fq) = af[t]; }
            if (isctx || sb != 32) {
#pragma unroll
                for (int t = 0; t < 8; ++t) *(f32x4*)(db + 16 * t + 4 * fq) = ab[t]; }
        }
    }
}
__device__ __forceinline__ void p6_fast(Frame& F) {
    const f16* Qb = (const f16*)(F.ws() + WS_PBUF) + (size_t)2 * NTOK * AW; const f16* Kb = Qb + (size_t)NTOK * AW; const f16* VR = Kb + (size_t)NTOK * AW; const f16* GS = VR + (size_t)NTOK * AW;
    const float* ST = (const float*)(F.ws() + WS_ST);
    const float* lgf = F.in[13]; const float* lgb = F.in[14]; const float* gng = F.in[15]; f16* AR = (f16*)(F.ws() + WS_AR);
    LAS f16* imK = (LAS f16*)(F.lds); LAS f16* imV = (LAS f16*)(F.lds + IMG_BYTES); LAS f16* imS = (LAS f16*)(F.lds + 2 * IMG_BYTES); LAS f16* imP = (LAS f16*)(F.lds + 3 * IMG_BYTES);
    const int fr = F.lane & 15, fq = F.lane >> 4, w = F.wave;
    constexpr float L2E = 1.4426950408889634f;
    for (int u = F.vcu; u < 512; u += F.G) {
        const int bh = u >> 5, i = u & 31, b = bh >> 3, h = bh & 7, hc = h * 128; const size_t t0 = (size_t)b * SEQ + i * CHK;
        const float lf = lgf[h] * L2E, lb = lgb[h] * L2E;
        stage_rows(imK, Kb + t0 * AW + hc, AW, F.tid);
#pragma unroll
        for (int it = 0; it < 4; ++it) { const int m = F.tid & 127, cc = ((F.tid >> 7) + 4 * it) * 8; const f16x8 vv = *(const f16x8*)(VR + (t0 + m) * AW + hc + cc);
#pragma unroll
            for (int j = 0; j < 8; ++j) imV[(cc + j) * IMG_LD + m] = vv[j]; }
        stage_rows_f32(imS, ST + st_index(0, bh, i), F.tid);
        stage_rows_f32(imP, ST + st_index(1, bh, 31 - i), F.tid);
        const int n = 16 * w + fr; const size_t trow = t0 + n;
        f16x8 qa[4];
#pragma unroll
        for (int ks = 0; ks < 4; ++ks) qa[ks] = *(const f16x8*)(Qb + trow * AW + hc + 32 * ks + 8 * fq);
        f16x4 gsv[8];
#pragma unroll
        for (int t = 0; t < 8; ++t) gsv[t] = *(const f16x4*)(GS + trow * AW + hc + 16 * t + 4 * fq);
        __syncthreads();
        f32x4 acc[8], o[8]; zero8(acc); wave_mma(acc, qa, imS, fr, fq);
        const float qf = exp2f(lf * (float)(n + 1)), qb = exp2f(lb * (float)(CHK - n));
#pragma unroll
        for (int t = 0; t < 8; ++t) o[t] = acc[t] * qf;
        zero8(acc); wave_mma(acc, qa, imP, fr, fq);
#pragma unroll
        for (int t = 0; t < 8; ++t) o[t] += acc[t] * qb;
        zero8(acc); wave_mma(acc, qa, imK, fr, fq);
        __syncthreads();
        int nn = n; asm volatile("" : "+v"(nn));
        LAS f16* pw = imP + (16 * w) * IMG_LD;
#pragma unroll
        for (int t = 0; t < 8; ++t) { float pv[4];
#pragma unroll
            for (int r = 0; r < 4; ++r) { const float dm = (float)(nn - (16 * t + 4 * fq + r)); const float dec = exp2f(lf * fmaxf(dm, 0.f) + lb * fmaxf(-dm, 0.f)) + (1.0f - fminf(fabsf(dm), 1.0f)); pv[r] = acc[t][r] * dec; }
            u32x2 pk; pk.x = pkh(pv[0], pv[1]); pk.y = pkh(pv[2], pv[3]); *(LAS u32x2*)(pw + fr * IMG_LD + 16 * t + 4 * fq) = pk; }
        f16x8 pa[4];
#pragma unroll
        for (int ks = 0; ks < 4; ++ks) pa[ks] = *(const LAS f16x8*)(pw + fr * IMG_LD + 32 * ks + 8 * fq);
        wave_mma(o, pa, imV, fr, fq);
        float s = 0.f;
#pragma unroll
        for (int t = 0; t < 8; ++t) s += (o[t].x + o[t].y) + (o[t].z + o[t].w);
        s += __shfl_xor(s, 16); s += __shfl_xor(s, 32);
        const float mean = s * (1.0f / 128.0f); float q = 0.f;
#pragma unroll
        for (int t = 0; t < 8; ++t) { o[t] = o[t] - mean; q += (o[t].x * o[t].x + o[t].y * o[t].y) + (o[t].z * o[t].z + o[t].w * o[t].w); }
        q += __shfl_xor(q, 16); q += __shfl_xor(q, 32);
        const float rstd = 1.0f / sqrtf(q * (1.0f / 128.0f) + EPS);
#pragma unroll
        for (int t = 0; t < 8; ++t) { const int col = hc + 16 * t + 4 * fq; const f32x4 g = *(const f32x4*)(gng + col); const f16x4 gs = gsv[t];
            u32x2 pk; pk.x = pkh(o[t].x * rstd * g.x * (float)gs.x, o[t].y * rstd * g.y * (float)gs.y); pk.y = pkh(o[t].z * rstd * g.z * (float)gs.z, o[t].w * rstd * g.w * (float)gs.w);
            *(u32x2*)(AR + trow * DM + AW + col) = pk; }
        __syncthreads();
    }
}
__device__ __forceinline__ void p5_naive(Frame& F) {
    const int gw = F.vcu * NWAVES + F.wave, NGW = F.G * NWAVES; const int gt = F.vcu * 512 + F.tid, NGT = F.G * 512;
    const float* ARAW = (const float*)(F.ws() + WS_ARAW); f16* AR = (f16*)(F.ws() + WS_AR); const float* aog = F.in[12];
    for (int row = gw; row < NTOK; row += NGW) {
        f32x4 v[4]; float ss = 0.f;
#pragma unroll
        for (int j = 0; j < 4; ++j) { v[j] = *(const f32x4*)(ARAW + (size_t)row * AW + 4 * F.lane + 256 * j); ss += (v[j].x * v[j].x + v[j].y * v[j].y) + (v[j].z * v[j].z + v[j].w * v[j].w); }
        const float rstd = 1.0f / sqrtf(wave_sum(ss) * (1.0f / AW) + EPS);
#pragma unroll
        for (int j = 0; j < 4; ++j) { const int col = 4 * F.lane + 256 * j; const f32x4 g = *(const f32x4*)(aog + col); const f32x4 h = v[j] * rstd * g;
            u32x2 o; o.x = pkh(h.x, h.y); o.y = pkh(h.z, h.w); *(u32x2*)(AR + (size_t)row * DM + col) = o; }
    }
    float* ST = (float*)(F.ws() + WS_ST); const float* lgf = F.in[13]; const float* lgb = F.in[14];
    for (int idx = gt; idx < 2 * 16 * 16384; idx += NGT) {
        const int e = idx & 16383, bh = (idx >> 14) & 15, dir = idx >> 18, h = bh & 7;
        const float cd = __expf((dir ? lgb[h] : lgf[h]) * (float)CHK);
        float* p0 = ST + st_index(dir, bh, 0) + e; float uv[32];
#pragma unroll
        for (int s = 0; s < 32; ++s) uv[s] = p0[(size_t)s * 16384];
        uv[0] += p0[(size_t)32 * 16384]; p0[0] = uv[0];
#pragma unroll
        for (int s = 1; s < 32; ++s) { uv[s] = cd * uv[s - 1] + uv[s]; p0[(size_t)s * 16384] = uv[s]; }
    }
}
__device__ __forceinline__ void p6_naive(Frame& F) {
    const int gt = F.vcu * 512 + F.tid, NGT = F.G * 512;
    const f16* Qb = (const f16*)(F.ws() + WS_PBUF) + (size_t)2 * NTOK * AW; const f16* Kb = Qb + (size_t)NTOK * AW;
    const float* lgf = F.in[13]; const float* lgb = F.in[14]; float* PB = (float*)(F.ws() + WS_PB);
    for (int idx = gt; idx < 16 * 32 * 16384; idx += NGT) {
        const int m = idx & 127, n = (idx >> 7) & 127, i = (idx >> 14) & 31, bh = idx >> 19, b = bh >> 3, h = bh & 7;
        const size_t t0 = (size_t)b * SEQ + i * CHK; const f16* q = Qb + (t0 + n) * AW + h * 128; const f16* k = Kb + (t0 + m) * AW + h * 128;
        float s = 0.f; for (int d = 0; d < 128; ++d) s += (float)q[d] * (float)k[d];
        const float dec = (n > m) ? __expf(lgf[h] * (float)(n - m)) : (n < m) ? __expf(lgb[h] * (float)(m - n)) : 2.0f;
        PB[idx] = s * dec;
    }
}
__device__ __forceinline__ void p7_naive(Frame& F) {
    const int gw = F.vcu * NWAVES + F.wave, NGW = F.G * NWAVES;
    const f16* Qb = (const f16*)(F.ws() + WS_PBUF) + (size_t)2 * NTOK * AW; const f16* VR = Qb + (size_t)2 * NTOK * AW; const f16* GS = VR + (size_t)NTOK * AW;
    const float* PB = (const float*)(F.ws() + WS_PB); const float* ST = (const float*)(F.ws() + WS_ST);
    const float* lgf = F.in[13]; const float* lgb = F.in[14]; const float* gng = F.in[15]; f16* AR = (f16*)(F.ws() + WS_AR);
    for (int it = gw; it < NTOK * NH; it += NGW) {
        const int t = it >> 3, h = it & 7, b = t >> 12, tp = t & (SEQ - 1), i = tp >> 7, n = tp & 127, bh = b * 8 + h;
        const size_t t0 = (size_t)b * SEQ + i * CHK;
        const float* prow = PB + (((size_t)bh * 32 + i) * 128 + n) * 128;
        float o0 = 0.f, o1 = 0.f;
        for (int m = 0; m < 128; ++m) { const float p = prow[m]; const f16* vr = VR + (t0 + m) * AW + h * 128; o0 += p * (float)vr[F.lane]; o1 += p * (float)vr[F.lane + 64]; }
        const f16* q = Qb + (size_t)t * AW + h * 128;
        const float* sf = ST + st_index(0, bh, i); const float* sb = ST + st_index(1, bh, 31 - i);
        float f0 = 0.f, f1 = 0.f, b0 = 0.f, b1 = 0.f;
        for (int d = 0; d < 128; ++d) { const float qd = (float)q[d]; f0 += qd * sf[F.lane * 128 + d]; f1 += qd * sf[(F.lane + 64) * 128 + d]; b0 += qd * sb[F.lane * 128 + d]; b1 += qd * sb[(F.lane + 64) * 128 + d]; }
        const float qf = __expf(lgf[h] * (float)(n + 1)), qb = __expf(lgb[h] * (float)(CHK - n));
        o0 += qf * f0 + qb * b0; o1 += qf * f1 + qb * b1;
        const float mean = wave_sum(o0 + o1) * (1.0f / 128.0f); const float d0 = o0 - mean, d1 = o1 - mean;
        const float rstd = 1.0f / sqrtf(wave_sum(d0 * d0 + d1 * d1) * (1.0f / 128.0f) + EPS);
        const int j0 = h * 128 + F.lane;
        AR[(size_t)t * DM + AW + j0] = (f16)(d0 * rstd * gng[j0] * (float)GS[(size_t)t * AW + j0]);
        AR[(size_t)t * DM + AW + j0 + 64] = (f16)(d1 * rstd * gng[j0 + 64] * (float)GS[(size_t)t * AW + j0 + 64]);
    }
}
struct DenseSched { int G, c, nM, nN, K; const char* Bt;
    __device__ __forceinline__ bool next(int i, g8::Unit& u, const int (&R)[2], const int (&C)[2]) const {
        int pm, pn; if (!g8::dense_order(i * G + c, nM, nN, pm, pn)) return false;
#pragma unroll
        for (int h = 0; h < 2; ++h)
#pragma unroll
            for (int k = 0; k < 2; ++k) u.ao[h][k] = (unsigned)((pm * 256 + h * 128 + R[k]) * K + C[k]) * 2u;
        u.B = Bt + (size_t)pn * 256 * K * 2; u.row0 = pm * 256; u.pn = pn; u.aux = 0; u.full = 1; return true; } };
__device__ __forceinline__ void p9_router(Frame& F) {
    const float* X1 = (const float*)(F.ws() + WS_X1); f16* HX2 = (f16*)(F.ws() + WS_HX2);
    const float* g2 = F.in[7]; const float* rbias = F.in[18];
    const f16* RWH = (const f16*)(F.ws() + WS_RWT); const f16* RWL = RWH + NE * DM;
    int* EIDX = (int*)(F.ws() + WS_EIDX); float* EW = (float*)(F.ws() + WS_EW); int* CNT = (int*)(F.ws() + WS_CNT);
    LAS float* RED = (LAS float*)F.lds; LAS float* LOG = (LAS float*)(F.lds + 32768); LAS float* PART = (LAS float*)(F.lds + 36864); LAS int* lcnt = (LAS int*)(F.lds + 37888);
    const int r = F.lane & 15, q = F.lane >> 4, w = F.wave;
    for (int u = F.vcu; u < 512; u += F.G) {
        if (F.tid < 64) lcnt[F.tid] = 0;
        const int row = u * 16 + r; const int kb = 256 * w + 8 * q;
        const float* mod = (const float*)(F.ws() + WS_MOD) + ((u * 16) >> 12) * 12288;
        float ss = 0.f; const float* xrow = X1 + (size_t)row * DM + kb;
        {   f32x4 xa[8], xb[8];
#pragma unroll
            for (int ks = 0; ks < 8; ++ks) { xa[ks] = *(const f32x4*)(xrow + 32 * ks); xb[ks] = *(const f32x4*)(xrow + 32 * ks + 4); }
#pragma unroll
            for (int ks = 0; ks < 8; ++ks) ss += (xa[ks].x * xa[ks].x + xa[ks].y * xa[ks].y) + (xa[ks].z * xa[ks].z + xa[ks].w * xa[ks].w) + (xb[ks].x * xb[ks].x + xb[ks].y * xb[ks].y) + (xb[ks].z * xb[ks].z + xb[ks].w * xb[ks].w); }
        ss += __shfl_xor(ss, 16); ss += __shfl_xor(ss, 32);
        if (q == 0) PART[w * 16 + r] = ss;
        __syncthreads();
        float tot = 0.f;
#pragma unroll
        for (int ww = 0; ww < 8; ++ww) tot += PART[ww * 16 + r];
        const float rstd = 1.0f / sqrtf(tot * (1.0f / DM) + EPS);
        f32x4 am[4], al[4];
#pragma unroll
        for (int nt = 0; nt < 4; ++nt) { am[nt] = (f32x4){0.f, 0.f, 0.f, 0.f}; al[nt] = am[nt]; }
        const f16* rwh = RWH + (size_t)r * DM + kb; const f16* rwl = RWL + (size_t)r * DM + kb;
#pragma unroll 1
        for (int ks = 0; ks < 8; ++ks) { const int col = kb + 32 * ks;
            const f32x4 xa = *(const f32x4*)(xrow + 32 * ks), xb = *(const f32x4*)(xrow + 32 * ks + 4);
            const f32x4 ga = *(const f32x4*)(g2 + col), gb = *(const f32x4*)(g2 + col + 4), sha = *(const f32x4*)(mod + 3 * 2048 + col), shb = *(const f32x4*)(mod + 3 * 2048 + col + 4), sca = *(const f32x4*)(mod + 4 * 2048 + col), scb = *(const f32x4*)(mod + 4 * 2048 + col + 4);
            f16x8 bh[4], bl[4];
#pragma unroll
            for (int nt = 0; nt < 4; ++nt) { bh[nt] = *(const f16x8*)(rwh + (size_t)(16 * nt) * DM + 32 * ks); bl[nt] = *(const f16x8*)(rwl + (size_t)(16 * nt) * DM + 32 * ks); }
            const f32x4 ha = (xa * rstd * ga) * (sca + 1.0f) + sha, hb = (xb * rstd * gb) * (scb + 1.0f) + shb;
            f16x8 hi, lo;
            hi[0] = (f16)ha.x; hi[1] = (f16)ha.y; hi[2] = (f16)ha.z; hi[3] = (f16)ha.w; hi[4] = (f16)hb.x; hi[5] = (f16)hb.y; hi[6] = (f16)hb.z; hi[7] = (f16)hb.w;
            lo[0] = (f16)((ha.x - (float)hi[0]) * 2048.0f); lo[1] = (f16)((ha.y - (float)hi[1]) * 2048.0f); lo[2] = (f16)((ha.z - (float)hi[2]) * 2048.0f); lo[3] = (f16)((ha.w - (float)hi[3]) * 2048.0f);
            lo[4] = (f16)((hb.x - (float)hi[4]) * 2048.0f); lo[5] = (f16)((hb.y - (float)hi[5]) * 2048.0f); lo[6] = (f16)((hb.z - (float)hi[6]) * 2048.0f); lo[7] = (f16)((hb.w - (float)hi[7]) * 2048.0f);
            *(f16x8*)(HX2 + (size_t)row * DM + col) = hi;
#pragma unroll
            for (int nt = 0; nt < 4; ++nt) {
                am[nt] = __builtin_amdgcn_mfma_f32_16x16x32_f16(hi, bh[nt], am[nt], 0, 0, 0);
                al[nt] = __builtin_amdgcn_mfma_f32_16x16x32_f16(lo, bh[nt], al[nt], 0, 0, 0);
                al[nt] = __builtin_amdgcn_mfma_f32_16x16x32_f16(hi, bl[nt], al[nt], 0, 0, 0); } }
#pragma unroll
        for (int nt = 0; nt < 4; ++nt)
#pragma unroll
            for (int rg = 0; rg < 4; ++rg) RED[(w * 16 + 4 * q + rg) * 64 + 16 * nt + r] = am[nt][rg] + al[nt][rg] * (1.0f / 2048.0f);
        __syncthreads();
#pragma unroll
        for (int o2 = 0; o2 < 2; ++o2) { const int o = F.tid + 512 * o2; float sacc = 0.f;
#pragma unroll
            for (int ww = 0; ww < 8; ++ww) sacc += RED[ww * 1024 + o];
            LOG[o] = sacc; }
        __syncthreads();
        for (int rr = 0; rr < 2; ++rr) { const int rl = 2 * w + rr, trow = u * 16 + rl;
            const float logit = LOG[rl * 64 + F.lane];
            const float s = 1.0f / (1.0f + expf(-logit)); const float sel = s + rbias[F.lane];
            float m1 = sel; m1 = fmaxf(m1, __shfl_xor(m1, 1)); m1 = fmaxf(m1, __shfl_xor(m1, 2)); m1 = fmaxf(m1, __shfl_xor(m1, 4));
            const unsigned long long bm = __ballot(sel == m1); const int gbase = F.lane & ~7; const unsigned gb = (unsigned)(bm >> gbase) & 0xffu; const int first = gbase + __builtin_ctz(gb);
            float m2 = (F.lane == first) ? -INFINITY : sel; m2 = fmaxf(m2, __shfl_xor(m2, 1)); m2 = fmaxf(m2, __shfl_xor(m2, 2)); m2 = fmaxf(m2, __shfl_xor(m2, 4));
            const float gs = m1 + m2; const int myg = F.lane >> 3; int beat = 0;
#pragma unroll
            for (int g = 0; g < 8; ++g) { const float og = __shfl(gs, g * 8); beat += (og > gs || (og == gs && g < myg)) ? 1 : 0; }
            const float cand = (beat < 4) ? sel : -INFINITY; int rank = 0;
            for (int e = 0; e < NE; ++e) { const float oc = __shfl(cand, e); rank += (oc > cand || (oc == cand && e < F.lane)) ? 1 : 0; }
            const bool chosen = (rank < TOPK) && (beat < 4);
            const float wsum = wave_sum(chosen ? s : 0.f);
            if (chosen) { EIDX[trow * 8 + rank] = F.lane; EW[trow * 8 + rank] = s / wsum * 2.5f; __hip_atomic_fetch_add(&lcnt[F.lane], 1, __ATOMIC_RELAXED, __HIP_MEMORY_SCOPE_WORKGROUP); }
        }
        __syncthreads();
        if (F.tid < 64) CNT[u * 64 + F.tid] = lcnt[F.tid];
        __syncthreads();
    }
}
__device__ __forceinline__ void p10_lists(Frame& F) {
    LAS int* pre = (LAS int*)(F.lds);
    LAS int* tot = pre + 128; LAS int* rb = pre + 256; LAS int* lfill = pre + 384;
    const int* CNT = (const int*)(F.ws() + WS_CNT);
    const int* EIDX = (const int*)(F.ws() + WS_EIDX); const float* EW = (const float*)(F.ws() + WS_EW);
    int* TILEE = (int*)(F.ws() + WS_TILEE); int* ROWTOK = (int*)(F.ws() + WS_ROWTOK); int* ROWDST = (int*)(F.ws() + WS_ROWDST); float* ROWW = (float*)(F.ws() + WS_ROWW);
    const int u1 = F.vcu, u2 = F.vcu + F.G;
    {
        LAS int* segs = pre + 512;
        const int e = F.tid & 63, seg = F.tid >> 6; int run = 0, q1 = 0, q2 = 0;
        { int cv[64];
#pragma unroll
            for (int j = 0; j < 64; ++j) cv[j] = CNT[(seg * 64 + j) * 64 + e];
#pragma unroll
            for (int j = 0; j < 64; ++j) { const int uu = seg * 64 + j; if (uu == u1) q1 = run; if (uu == u2) q2 = run; run += cv[j]; } }
        segs[seg * 64 + e] = run; if ((u1 >> 6) == seg) segs[512 + e] = q1; if ((u2 >> 6) == seg) segs[576 + e] = q2;
        __syncthreads();
        if (F.tid < 64) { int r2 = 0, p1 = 0, p2 = 0;
#pragma unroll
            for (int sg = 0; sg < 8; ++sg) { if (sg == (u1 >> 6)) p1 = r2 + segs[512 + e]; if (sg == (u2 >> 6)) p2 = r2 + segs[576 + e]; r2 += segs[sg * 64 + e]; }
            pre[e] = p1; pre[64 + e] = p2; tot[e] = r2; }
    }
    __syncthreads();
    if (F.tid == 0) { tot[NE] = NTOK; int tiles = 0; for (int e = 0; e < NE1; ++e) { rb[e] = tiles * 256; const int nt = (tot[e] + 255) >> 8; if (F.vcu == 0) for (int j = 0; j < nt; ++j) { TILEE[tiles + j] = e; TILEE[512 + tiles + j] = (j + 1 < nt) ? 256 : (tot[e] - 256 * j); } tiles += nt; } rb[NE1] = tiles * 256; if (F.vcu == 0) TILEE[511] = tiles; }
    __syncthreads();
    for (int k = 0; k < 2; ++k) { const int u = k ? u2 : u1; if (u >= 512) break;
        if (F.tid < 64) lfill[F.tid] = 0;
        __syncthreads();
        if (F.tid < 128) { const int i = u * 128 + F.tid; const int e = EIDX[i]; const int pos = pre[k * 64 + e] + __hip_atomic_fetch_add(&lfill[e], 1, __ATOMIC_RELAXED, __HIP_MEMORY_SCOPE_WORKGROUP);
            const int row = rb[e] + pos; ROWTOK[row] = i >> 3; ROWDST[row] = (i >> 3) * NSLOT + (i & 7); ROWW[row] = EW[i]; }
        else if (F.tid < 144) { const int t = u * 16 + (F.tid - 128); const int row = rb[NE] + t; ROWTOK[row] = t; ROWDST[row] = t * NSLOT + 8; ROWW[row] = 1.0f; }
        __syncthreads();
    }
    if (F.vcu < NE1) { const int e = F.vcu; const int lo = rb[e] + tot[e], hi = rb[e + 1]; for (int r = lo + F.tid; r < hi; r += 512) { ROWTOK[r] = 0; ROWDST[r] = -1; ROWW[r] = 0.f; } }
}
struct MoeSched { int G, c, nN, K, gather; const int* TILEE; const int* ROWTOK; const char* Bt; size_t bstride_e;
    __device__ __forceinline__ bool next(int i, g8::Unit& u, const int (&R)[2], const int (&C)[2]) const {
        const int ntile = __builtin_amdgcn_readfirstlane(TILEE[511]), total = ntile * nN, per = (total + 7) >> 3, x = c & 7, lc = c >> 3, li = i * (G >> 3) + lc;
        if (li >= per) return false; const int idx = x * per + li; if (idx >= total) return false;
        const int j = idx / nN, pn = idx % nN, e = __builtin_amdgcn_readfirstlane(TILEE[j]);
#pragma unroll
        for (int h = 0; h < 2; ++h)
#pragma unroll
            for (int k = 0; k < 2; ++k) { const int r = j * 256 + h * 128 + R[k]; const int src = gather ? ROWTOK[r] : r; u.ao[h][k] = (unsigned)(src * K + C[k]) * 2u; }
        u.B = Bt + (size_t)e * bstride_e + (size_t)pn * 256 * K * 2; u.row0 = j * 256; u.pn = pn; u.aux = e; u.full = __builtin_amdgcn_readfirstlane(TILEE[512 + j]) > 128; return true; } };
struct EpiHid {
    static constexpr bool PERM = true;
    f16* HID;
    __device__ __forceinline__ void operator()(const f32x4 (&acc)[2][2][4][2], const g8::Unit& u, int wr, int wc, int fr, int fq) const {
        const int row0 = u.row0 + wr * 64 + fr, col0 = u.pn * 128 + wc * 32 + 8 * fq;
#pragma unroll
        for (int ai = 0; ai < 2; ++ai)
#pragma unroll
            for (int m = 0; m < 4; ++m) { const f32x4 a0 = acc[ai][0][m][0], a1 = acc[ai][0][m][1], b0 = acc[ai][1][m][0], b1 = acc[ai][1][m][1];
                u32x4 w; w.x = pkh(silu_f(a0[0]) * b0[0], silu_f(a0[1]) * b0[1]); w.y = pkh(silu_f(a0[2]) * b0[2], silu_f(a0[3]) * b0[3]);
                w.z = pkh(silu_f(a1[0]) * b1[0], silu_f(a1[1]) * b1[1]); w.w = pkh(silu_f(a1[2]) * b1[2], silu_f(a1[3]) * b1[3]);
                *(u32x4*)(HID + (size_t)(row0 + ai * 128 + m * 16) * EH + col0) = w; }
    }
};
struct EpiYs {
    static constexpr bool PERM = true;
    f16* YS; const int* ROWDST; const float* ROWW;
    __device__ __forceinline__ void operator()(const f32x4 (&acc)[2][2][4][2], const g8::Unit& u, int wr, int wc, int fr, int fq) const {
        const int row0 = u.row0 + wr * 64 + fr, col0 = u.pn * 256 + wc * 32 + 8 * fq;
#pragma unroll
        for (int ai = 0; ai < 2; ++ai)
#pragma unroll
            for (int m = 0; m < 4; ++m) { const int row = row0 + ai * 128 + m * 16; const int dst = ROWDST[row]; const float w = ROWW[row];
                if (dst >= 0) {
#pragma unroll
                    for (int bj = 0; bj < 2; ++bj) { const f32x4 a0 = acc[ai][bj][m][0] * w, a1 = acc[ai][bj][m][1] * w;
                        u32x4 o; o.x = pkh(a0[0], a0[1]); o.y = pkh(a0[2], a0[3]); o.z = pkh(a1[0], a1[1]); o.w = pkh(a1[2], a1[3]);
                        *(u32x4*)(YS + (size_t)dst * DM + col0 + bj * 128) = o; } } }
    }
};
__device__ __forceinline__ void p13_combine(Frame& F) {
    const int gw = F.vcu * NWAVES + F.wave, NGW = F.G * NWAVES;
    const float* X1 = (const float*)(F.ws() + WS_X1); const f16* YS = (const f16*)(F.ws() + WS_YS); const float* fg = F.in[25]; float* outp = F.out();
    for (int row = gw; row < NTOK; row += NGW) {
        const float* g2 = (const float*)(F.ws() + WS_MOD) + (row >> 12) * 12288 + 5 * 2048;
        const f16* yrow = YS + (size_t)row * NSLOT * DM + 8 * F.lane; const float* xrow = X1 + (size_t)row * DM + 8 * F.lane;
        f32x4 v[4][2]; float ss = 0.f;
        f16x8 y[NSLOT], yn[NSLOT]; f32x4 xa, xb, xna, xnb;
#pragma unroll
        for (int sl = 0; sl < NSLOT; ++sl) y[sl] = __builtin_nontemporal_load((const f16x8*)(yrow + (size_t)sl * DM));
        xa = *(const f32x4*)(xrow); xb = *(const f32x4*)(xrow + 4);
#pragma unroll
        for (int j = 0; j < 4; ++j) { const int col = 8 * F.lane + 512 * j;
            if (j < 3) {
#pragma unroll
                for (int sl = 0; sl < NSLOT; ++sl) yn[sl] = __builtin_nontemporal_load((const f16x8*)(yrow + (size_t)sl * DM + 512 * (j + 1)));
                xna = *(const f32x4*)(xrow + 512 * (j + 1)); xnb = *(const f32x4*)(xrow + 512 * (j + 1) + 4); }
            const f32x4 ga = *(const f32x4*)(g2 + col), gb = *(const f32x4*)(g2 + col + 4);
            f32x4 a = {0.f, 0.f, 0.f, 0.f}, b = a;
#pragma unroll
            for (int sl = 0; sl < NSLOT; ++sl) { a.x += (float)y[sl][0]; a.y += (float)y[sl][1]; a.z += (float)y[sl][2]; a.w += (float)y[sl][3]; b.x += (float)y[sl][4]; b.y += (float)y[sl][5]; b.z += (float)y[sl][6]; b.w += (float)y[sl][7]; }
            v[j][0] = xa + ga * a; v[j][1] = xb + gb * b;
            ss += (v[j][0].x * v[j][0].x + v[j][0].y * v[j][0].y) + (v[j][0].z * v[j][0].z + v[j][0].w * v[j][0].w) + (v[j][1].x * v[j][1].x + v[j][1].y * v[j][1].y) + (v[j][1].z * v[j][1].z + v[j][1].w * v[j][1].w);
            FENCE();
            if (j < 3) {
#pragma unroll
                for (int sl = 0; sl < NSLOT; ++sl) y[sl] = yn[sl];
                xa = xna; xb = xnb; } }
        const float rstd = 1.0f / sqrtf(wave_sum(ss) * (1.0f / DM) + EPS);
#pragma unroll
        for (int j = 0; j < 4; ++j) { const int col = 8 * F.lane + 512 * j; const f32x4 ga = *(const f32x4*)(fg + col), gb = *(const f32x4*)(fg + col + 4);
            __builtin_nontemporal_store(v[j][0] * rstd * ga, (f32x4*)(outp + (size_t)row * DM + col)); __builtin_nontemporal_store(v[j][1] * rstd * gb, (f32x4*)(outp + (size_t)row * DM + col + 4)); }
    }
}

struct Args { const float* in[26]; float* out; unsigned char* ws; int ph_lo, ph_hi, li, pad; };
__global__ void __launch_bounds__(NWAVES * 64, 2) fwd(Args args) {
    extern __shared__ __attribute__((aligned(16))) unsigned char lds[];
    Frame F;
    F.lds = (LAS unsigned char*)lds;
    F.tid = threadIdx.x; F.lane = F.tid & 63; F.wave = __builtin_amdgcn_readfirstlane(F.tid >> 6);
    F.G = gridDim.x; { const int bx = blockIdx.x; F.vcu = (bx & 7) * (F.G >> 3) + (bx >> 3); }
    F.in.base = (LAS const unsigned*)(F.lds + LDSCTL_OFF + 512);
    {
        const unsigned* ka = (const unsigned*)__builtin_amdgcn_kernarg_segment_ptr();
        if (F.tid < 128) ((LAS unsigned*)(F.lds + LDSCTL_OFF))[F.tid] = 0u;
        if (F.tid >= 128 && F.tid < 128 + 60) ((LAS unsigned*)(F.lds + LDSCTL_OFF + 512))[F.tid - 128] = ka[F.tid - 128];
    }
    __syncthreads();
    const int ph_lo = (int)__builtin_amdgcn_readfirstlane(((LAS const unsigned*)(F.lds + LDSCTL_OFF + 512))[56]), ph_hi = (int)__builtin_amdgcn_readfirstlane(((LAS const unsigned*)(F.lds + LDSCTL_OFF + 512))[57]);
    if (MK_N_LAUNCHES == 1) xcd_barrier_post((unsigned*)(F.ws() + WS_CTL) + CW_BAR);
    const int lo = ph_lo, hi = ph_hi;
#define REFRESH() do { int t_ = threadIdx.x; asm volatile("" : "+v"(t_)); F.tid = t_; F.lane = t_ & 63; F.wave = __builtin_amdgcn_readfirstlane(t_ >> 6); } while (0)
#define IN(k) (lo <= (k) && (k) < hi)
#define SEAM(k) do { if (IN(k) && IN((k) + 1)) { XcdBarrier bar_; bar_.bar = (unsigned*)(F.ws() + WS_CTL) + CW_BAR; bar_.st = (volatile LAS unsigned*)((LAS unsigned char*)lds + MISC_OFF) + 8; xcd_barrier(bar_); } } while (0)
    const int cblk = (int)blockIdx.x;
    if (IN(0)) for (int rep_ = 0; rep_ <= ((PROBE_DUP >> 0) & 1); ++rep_) { if (rep_) __syncthreads(); REFRESH(); p0_prologue(F); } SEAM(0);
    if (IN(1)) for (int rep_ = 0; rep_ <= ((PROBE_DUP >> 1) & 1); ++rep_) { if (rep_) __syncthreads(); REFRESH(); p1_norm(F); } SEAM(1);
    if (IN(2)) for (int rep_ = 0; rep_ <= ((PROBE_DUP >> 2) & 1); ++rep_) { if (rep_) __syncthreads(); REFRESH(); InSched S{F.G, cblk, (const char*)(F.ws() + WS_WINT), 0, 1000};
        EpiIn E{(f16*)(F.ws() + WS_PBUF), (f16*)(F.ws() + WS_CK), (f16*)(F.ws() + WS_CV), (float*)(F.ws() + WS_VSTAT), (const float*)(F.ws() + WS_ROPE)};
        const int grp = (cblk >> 3) & 3;
        for (int part = 0; part < 2; ++part) {
            S.ulo = part ? grp : 0; S.uhi = part ? 1000 : grp;
            if (S.uhi > S.ulo) g8::gemm_phase<EpiIn, InSched, true>(F.lds + RING_OFF, (const char*)(F.ws() + WS_HX), DM, S, E);
            if (part == 0) { __syncthreads(); REFRESH(); if (F.vcu < 64) { p2_ctx_unit(F, F.vcu); __syncthreads(); } p2_expert_copies(F); __syncthreads(); } } } SEAM(2);
    if (IN(4)) for (int rep_ = 0; rep_ <= ((PROBE_DUP >> 4) & 1); ++rep_) { if (rep_) __syncthreads(); REFRESH(); p4_fast(F); } SEAM(4);
    if (IN(5)) for (int rep_ = 0; rep_ <= ((PROBE_DUP >> 5) & 1); ++rep_) { if (rep_) __syncthreads(); REFRESH(); p5_naive(F); } SEAM(5);
    if (IN(6)) for (int rep_ = 0; rep_ <= ((PROBE_DUP >> 6) & 1); ++rep_) { if (rep_) __syncthreads(); REFRESH(); p6_fast(F); } SEAM(6);
    if (IN(8)) for (int rep_ = 0; rep_ <= ((PROBE_DUP >> 8) & 1); ++rep_) { if (rep_) __syncthreads(); REFRESH(); DenseSched S{F.G, cblk, 32, 8, DM, (const char*)(F.ws() + WS_WOUTT)}; EpiX1 E{F.in[0], (const float*)(F.ws() + WS_MOD), (float*)(F.ws() + WS_X1)};
        g8::gemm_phase<EpiX1, DenseSched, true>(F.lds + RING_OFF, (const char*)(F.ws() + WS_AR), DM, S, E); } SEAM(8);
    if (IN(9)) for (int rep_ = 0; rep_ <= ((PROBE_DUP >> 9) & 1); ++rep_) { if (rep_) __syncthreads(); REFRESH(); p9_router(F); } SEAM(9);
    if (IN(10)) for (int rep_ = 0; rep_ <= ((PROBE_DUP >> 10) & 1); ++rep_) { if (rep_) __syncthreads(); REFRESH(); p10_lists(F); } SEAM(10);
    if (IN(11)) for (int rep_ = 0; rep_ <= ((PROBE_DUP >> 11) & 1); ++rep_) { if (rep_) __syncthreads(); REFRESH(); MoeSched S{F.G, cblk, 4, DM, 1, (const int*)(F.ws() + WS_TILEE), (const int*)(F.ws() + WS_ROWTOK), (const char*)(F.ws() + WS_W13T), (size_t)1024 * DM * 2};
        EpiHid E{(f16*)(F.ws() + WS_HID)};
        g8::gemm_phase<EpiHid, MoeSched, true>(F.lds + RING_OFF, (const char*)(F.ws() + WS_HX2), DM, S, E); } SEAM(11);
    if (IN(12)) for (int rep_ = 0; rep_ <= ((PROBE_DUP >> 12) & 1); ++rep_) { if (rep_) __syncthreads(); REFRESH(); MoeSched S{F.G, cblk, 8, EH, 0, (const int*)(F.ws() + WS_TILEE), (const int*)(F.ws() + WS_ROWTOK), (const char*)(F.ws() + WS_W2T), (size_t)DM * EH * 2};
        EpiYs E{(f16*)(F.ws() + WS_YS), (const int*)(F.ws() + WS_ROWDST), (const float*)(F.ws() + WS_ROWW)};
        g8::gemm_phase<EpiYs, MoeSched, true>(F.lds + RING_OFF, (const char*)(F.ws() + WS_HID), EH, S, E); } SEAM(12);
    if (IN(13)) for (int rep_ = 0; rep_ <= ((PROBE_DUP >> 13) & 1); ++rep_) { if (rep_) __syncthreads(); REFRESH(); p13_combine(F); }
#undef IN
#undef SEAM
}

extern "C" void kernel_launch(void* const* d_in, const int* in_sizes, int n_in, void* d_out, int out_size, void* d_ws, size_t ws_size, hipStream_t stream) {
    static int grid = 0;
    if (grid == 0) {
        if (n_in != 26 || in_sizes[0] != NTOK * DM || out_size != NTOK * DM || ws_size < WS_END) {
            fprintf(stderr, "kernel_launch: unexpected problem (n_in %d, in0 %d, out %d, ws %zu); nothing launched\n", n_in, n_in > 0 ? in_sizes[0] : -1, out_size, ws_size); grid = -1; return; }
        int dev = 0, cus = 0, per_cu = 0;
        if (hipGetDevice(&dev) != hipSuccess || hipDeviceGetAttribute(&cus, hipDeviceAttributeMultiprocessorCount, dev) != hipSuccess) { grid = -1; return; }
        if (hipFuncSetAttribute((const void*)fwd, hipFuncAttributeMaxDynamicSharedMemorySize, LDS_BYTES) != hipSuccess) { fprintf(stderr, "kernel_launch: hipFuncSetAttribute failed\n"); grid = -1; return; }
        if (hipOccupancyMaxActiveBlocksPerMultiprocessor(&per_cu, (const void*)fwd, NWAVES * 64, LDS_BYTES) != hipSuccess || per_cu < 1)
            fprintf(stderr, "kernel_launch: occupancy query reports %d workgroups per CU\n", per_cu);
        (void)hipGetLastError();
        grid = cus & ~7;
    }
    if (grid < 0) return;
    if (hipMemsetAsync((char*)d_ws + WS_CTL, 0, CTL_ZERO_BYTES, stream) != hipSuccess) return;
    Args a{};
    for (int i = 0; i < 26; ++i) a.in[i] = (const float*)d_in[i];
    a.out = (float*)d_out; a.ws = (unsigned char*)d_ws;
    if (MK_N_LAUNCHES == 1) { a.ph_lo = 0; a.ph_hi = NPHASE; a.li = 0; hipLaunchKernelGGL(fwd, dim3(grid), dim3(NWAVES * 64), LDS_BYTES, stream, a); }
    else { for (int li = 0; li < NPHASE; ++li) { a.ph_lo = li; a.ph_hi = li + 1; a.li = li; hipLaunchKernelGGL(fwd, dim3(grid), dim3(NWAVES * 64), LDS_BYTES, stream, a); } }
}
```

```cpp
#include <hip/hip_runtime.h>
#include <cstdio>
#include <cstdint>

#ifndef PROBE_DUP
#define PROBE_DUP 0
#endif
#ifndef MK_N_LAUNCHES
#define MK_N_LAUNCHES 1
#endif

#define LAS __attribute__((address_space(3)))
#define GAS __attribute__((address_space(1)))
typedef _Float16 f16;
typedef _Float16 f16x8 __attribute__((ext_vector_type(8)));
typedef _Float16 f16x4 __attribute__((ext_vector_type(4)));
typedef _Float16 f16x2 __attribute__((ext_vector_type(2)));
typedef float f32x4 __attribute__((ext_vector_type(4)));
typedef float f32x2 __attribute__((ext_vector_type(2)));
typedef unsigned u32x4 __attribute__((ext_vector_type(4)));
typedef unsigned u32x2 __attribute__((ext_vector_type(2)));
typedef GAS unsigned gu32;

constexpr int DM = 2048, NB = 2, SEQ = 4096, NTOK = NB * SEQ, CTXL = 256, NCTX = NB * CTXL, CHK = 128, NCH = SEQ / CHK;
constexpr int AW = 1024, INC = 6144, NH = 8, HD = 128;
constexpr int NE = 64, NE1 = 65, TOPK = 8, EH = 512, NSLOT = 9;
constexpr int NROWS_IN = NTOK + NCTX;
constexpr int MAXTILES = 360;
constexpr int MAXROWS = MAXTILES * 256;
constexpr float EPS = 1e-6f;
constexpr int NPHASE = 14;
constexpr int NWAVES = 8;

constexpr size_t MiB = 1u << 20;
constexpr size_t WS_CTL = 0, CTL_ZERO_BYTES = 1 * MiB;
constexpr size_t WS_MOD = 1 * MiB;
constexpr size_t WS_ROPE = WS_MOD + 256 * 1024;
constexpr size_t WS_VSTAT = 4 * MiB;
constexpr size_t WS_EIDX = WS_ROPE + 64 * 1024;
constexpr size_t WS_EW = WS_EIDX + 256 * 1024;
constexpr size_t WS_TILEE = WS_EW + 256 * 1024;
constexpr size_t WS_ROWTOK = 2 * MiB;
constexpr size_t WS_ROWDST = WS_ROWTOK + 512 * 1024;
constexpr size_t WS_ROWW = WS_ROWDST + 512 * 1024;
constexpr size_t WS_RWT = 5 * MiB;
constexpr size_t WS_CNT = 5 * MiB + 512 * 1024;
constexpr size_t WS_W13T = 8 * MiB;
constexpr size_t WS_W2T = WS_W13T + 260 * MiB;
constexpr size_t WS_WINT = WS_W2T + 130 * MiB;
constexpr size_t WS_WOUTT = WS_WINT + 24 * MiB;
constexpr size_t WS_X1 = WS_WOUTT + 8 * MiB;
constexpr size_t WS_HX2 = WS_X1 + 64 * MiB;
constexpr size_t WS_HID = WS_HX2 + 32 * MiB;
constexpr size_t WS_OVL = WS_HID + 90 * MiB;
static_assert(WS_OVL == 616 * MiB, "map");
constexpr size_t WS_HX = WS_OVL;
constexpr size_t WS_CBUF = WS_OVL + 34 * MiB;
constexpr size_t WS_ARAW = WS_CBUF;
constexpr size_t WS_PB = WS_CBUF + 32 * MiB;
constexpr size_t WS_AR = WS_CBUF + 64 * MiB;
constexpr size_t WS_OUTX = WS_CBUF + 96 * MiB;
constexpr size_t WS_PBUF = WS_OVL + 238 * MiB;
constexpr size_t WS_CK = WS_PBUF + 96 * MiB;
constexpr size_t WS_CV = WS_CK + 1 * MiB;
constexpr size_t WS_ST = WS_CV + 1 * MiB;
constexpr size_t WS_YS = WS_OVL;
constexpr size_t WS_END = 1024 * MiB;
static_assert(WS_ST + 70 * MiB <= WS_END && WS_YS + 360 * MiB <= WS_END && WS_OUTX + 64 * MiB <= WS_PBUF, "map");
constexpr int CW_BAR = 4096;

constexpr int RING_OFF = 0, RING_BYTES = 131072;
constexpr int LDS_BYTES = 147456;
constexpr int LDSCTL_OFF = LDS_BYTES - 1024, MISC_OFF = LDSCTL_OFF + 320;

#define RLX_AGENT __ATOMIC_RELAXED, __HIP_MEMORY_SCOPE_AGENT
#define LDS_WAIT() asm volatile("s_waitcnt lgkmcnt(0)" ::: "memory")
#define FENCE() do { asm volatile("" ::: "memory"); __builtin_amdgcn_sched_barrier(0); } while (0)
#define VM_WAIT() asm volatile("s_waitcnt vmcnt(0)" ::: "memory")

#define XB_TMO      128
#define XB_XCNT(j)  (256  + 64 * (j))
#define XB_XSUB(j)  (1280 + 64 * (j))
#define XB_XGEN(j)  (2304 + 64 * (j))
#define XB_TOP      3328
#define XB_TOPGEN   3392
#define XCD_BAR_WORDS 3456
#define XB_SPIN_CAP (1u << 18)
__device__ __forceinline__ unsigned xb_ld(unsigned* p)              { return __hip_atomic_load(p, __ATOMIC_RELAXED, __HIP_MEMORY_SCOPE_AGENT); }
__device__ __forceinline__ unsigned xb_add(unsigned* p, unsigned v) { return __hip_atomic_fetch_add(p, v, __ATOMIC_RELAXED, __HIP_MEMORY_SCOPE_AGENT); }
__device__ __forceinline__ unsigned xb_xcc_id() { return (unsigned)__builtin_amdgcn_s_getreg((3 << 11) | 20) & 0xFu; }
#define XB_SPIN(cond, bar) do { unsigned _sp = 0; while (cond) { __builtin_amdgcn_s_sleep(1); \
    if ((++_sp & 255u) == 0u) { if (xb_ld(&(bar)[XB_TMO])) break; if (_sp > XB_SPIN_CAP) { atomicAdd(&(bar)[XB_TMO], 1u); break; } } } } while (0)
struct XcdBarrier { unsigned* bar; volatile LAS unsigned* st; };
__device__ __forceinline__ void xcd_barrier_post(unsigned* bar) {
    if (threadIdx.x == 0) (void)xb_add(&bar[XB_XCNT(xb_xcc_id())], 1u);
}
__device__ __forceinline__ void xcd_barrier_complete(unsigned* bar, unsigned x, unsigned& nloc, unsigned& nx) {
    const unsigned G = gridDim.x * gridDim.y * gridDim.z;
    unsigned sum, cnt, mine, sp = 0u;
    for (;;) {
        sum = 0u; cnt = 0u; mine = 0u;
#pragma unroll
        for (unsigned j = 0; j < 16; ++j) { const unsigned c = xb_ld(&bar[XB_XCNT(j)]); sum += c; cnt += (c > 0u) ? 1u : 0u; mine = (j == x) ? c : mine; }
        if (sum == G) break;
        __builtin_amdgcn_s_sleep(1);
        if ((++sp & 255u) == 0u) { if (xb_ld(&bar[XB_TMO])) break; if (sp > XB_SPIN_CAP) { atomicAdd(&bar[XB_TMO], 1u); break; } }
    }
    nloc = mine > 0u ? mine : 1u; nx = cnt > 0u ? cnt : 1u;
}
__device__ __forceinline__ void xcd_barrier(const XcdBarrier& b) {
    asm volatile("s_waitcnt vmcnt(0)" ::: "memory");
    __syncthreads();
    if (threadIdx.x == 0) {
        unsigned* bar = b.bar; const unsigned bx = xb_xcc_id();
        __builtin_amdgcn_s_waitcnt(0);
        unsigned nloc = b.st[0], nx = b.st[1];
        if (nloc == 0u) { xcd_barrier_complete(bar, bx, nloc, nx); b.st[0] = nloc; b.st[1] = nx; }
        const unsigned old = xb_add(&bar[XB_XSUB(bx)], 1u);
        const unsigned gen = old / nloc;
        if (old + 1u == (gen + 1u) * nloc) {
            __builtin_amdgcn_fence(__ATOMIC_RELEASE, "agent");
            asm volatile("s_waitcnt vmcnt(0)" ::: "memory");
            const unsigned og = xb_add(&bar[XB_TOP], 1u);
            const unsigned tg = og / nx;
            if (og + 1u == (tg + 1u) * nx) xb_add(&bar[XB_TOPGEN], 1u);
            else XB_SPIN(xb_ld(&bar[XB_TOPGEN]) == tg, bar);
            __builtin_amdgcn_fence(__ATOMIC_ACQUIRE, "agent");
            xb_add(&bar[XB_XGEN(bx)], 1u);
            asm volatile("s_waitcnt vmcnt(0)" ::: "memory");
        } else {
            XB_SPIN(xb_ld(&bar[XB_XGEN(bx)]) == gen, bar);
            __builtin_amdgcn_fence(__ATOMIC_ACQUIRE, "agent");
            asm volatile("s_waitcnt vmcnt(0)" ::: "memory");
        }
    }
    __syncthreads();
}

namespace g8 {
constexpr int BM = 256, BK = 64, HALF = 128, HTB = HALF * BK * 2, STAGE_BYTES = 8 * HTB, NXCD = 8, WGM = 8;
__host__ __device__ __forceinline__ int lds_byte(int r, int c) { const int st = (r >> 4) * 2 + (c >> 5), rr = r & 15, cc = c & 31, ob = rr * 64 + cc * 2; return st * 1024 + (ob ^ (((ob >> 9) & 1) << 5)); }
__host__ __device__ __forceinline__ void stage_rc(int b, int& R, int& C) { const int st = b / 1024, sb = b % 1024, swz = sb ^ (((sb >> 9) & 1) << 5); R = (st >> 1) * 16 + swz / 64; C = (st & 1) * 32 + (swz % 64) / 2; }
__host__ __device__ __forceinline__ int perm32(int rho) { const int n = rho >> 4, i = rho & 15; return 8 * (i >> 2) + 4 * n + (i & 3); }

struct Unit { unsigned ao[2][2]; const char* B; int row0; int pn; int aux; int full; };

__device__ __forceinline__ bool dense_order(int L, int nM, int nN, int& pm, int& pn) {
    const int nwg = nM * nN; if (L >= nwg) return false;
    int wgid = L; { const int q = nwg / NXCD, r = nwg % NXCD, xcd = wgid % NXCD, off = wgid / NXCD; wgid = (xcd < r ? xcd * (q + 1) : r * (q + 1) + (xcd - r) * q) + off; }
    const int nig = WGM * nN, gid = wgid / nig, fm = gid * WGM, gsz = (nM - fm) < WGM ? (nM - fm) : WGM;
    pm = fm + ((wgid % nig) % gsz); pn = (wgid % nig) / gsz; return true;
}

template <class Epi, class Sched, bool ALIGN_EPI>
__device__ __forceinline__ void gemm_phase(LAS unsigned char* lds, const char* A, const int K, const Sched& S, const Epi& E) {
    int tid = threadIdx.x; asm volatile("" : "+v"(tid));
    const int wid = __builtin_amdgcn_readfirstlane(tid >> 6), lane = tid & 63, wr = wid >> 2, wc = wid & 3, fr = lane & 15, fq = lane >> 4;
    const int nt = K / BK;
    int R[2], C[2]; unsigned voffB[2];
#pragma unroll
    for (int i = 0; i < 2; ++i) { stage_rc(tid * 16 + i * 8192, R[i], C[i]); const int Rb = Epi::PERM ? ((R[i] & ~31) + perm32(R[i] & 31)) : R[i]; voffB[i] = (unsigned)(Rb * K + C[i]) * 2u; }
    const size_t kstep = (size_t)(BK * 2);
    const size_t hstep = (size_t)HALF * K * 2;
    const unsigned ldsw = (unsigned)wid * 1024u;
    const int aoff = lds_byte(wr * 64 + fr, fq * 8), boff = lds_byte(wc * 32 + fr, fq * 8);
#define G8_SA(b, h) (((b) * 2 + (h)) * HTB)
#define G8_SB(b, h) ((4 + (b) * 2 + (h)) * HTB)
#define G8_STAGE_B(bufoff, gbase) do { _Pragma("unroll") for (int _i = 0; _i < 2; ++_i) \
        __builtin_amdgcn_global_load_lds((const unsigned*)((const char*)(gbase) + voffB[_i]), (LAS unsigned*)(lds + (bufoff) + ldsw + _i * 8192), 16, 0, 0); } while (0)
#define G8_STAGE_A(bufoff, kb, o0, o1) do { \
        __builtin_amdgcn_global_load_lds((const unsigned*)(A + (size_t)(kb) + (o0)), (LAS unsigned*)(lds + (bufoff) + ldsw), 16, 0, 0); \
        __builtin_amdgcn_global_load_lds((const unsigned*)(A + (size_t)(kb) + (o1)), (LAS unsigned*)(lds + (bufoff) + ldsw + 8192), 16, 0, 0); } while (0)
#define G8_LDA(dst, b, h) do { _Pragma("unroll") for (int m = 0; m < 4; ++m) _Pragma("unroll") for (int k = 0; k < 2; ++k) dst[m][k] = *(const LAS f16x8*)(lds + G8_SA(b, h) + aoff + m * 2048 + k * 1024); } while (0)
#define G8_LDB(dst, b, h) do { _Pragma("unroll") for (int n = 0; n < 2; ++n) _Pragma("unroll") for (int k = 0; k < 2; ++k) dst[n][k] = *(const LAS f16x8*)(lds + G8_SB(b, h) + boff + n * 2048 + k * 1024); } while (0)
#define G8_MMA(ai, bj, At, Bt) do { __builtin_amdgcn_s_setprio(1); _Pragma("unroll") for (int m = 0; m < 4; ++m) _Pragma("unroll") for (int n = 0; n < 2; ++n) _Pragma("unroll") for (int k = 0; k < 2; ++k) \
        acc[ai][bj][m][n] = __builtin_amdgcn_mfma_f32_16x16x32_f16(Bt[n][k], At[m][k], acc[ai][bj][m][n], 0, 0, 0); __builtin_amdgcn_s_setprio(0); } while (0)
#define G8_WAIT_V(n) asm volatile("s_waitcnt vmcnt(" #n ")" ::: "memory")
#define G8_WAIT_L(n) asm volatile("s_waitcnt lgkmcnt(" #n ")" ::: "memory")
#define G8_BAR __builtin_amdgcn_s_barrier()
#define G8_SCHED __builtin_amdgcn_sched_barrier(0)
    Unit cur, nxt; int ui = 0;
    if (!S.next(0, cur, R, C)) return;
    f32x4 acc[2][2][4][2];
#pragma unroll
    for (int a = 0; a < 2; ++a)
#pragma unroll
        for (int b = 0; b < 2; ++b)
#pragma unroll
            for (int m = 0; m < 4; ++m)
#pragma unroll
                for (int n = 0; n < 2; ++n) acc[a][b][m][n] = (f32x4){0.f, 0.f, 0.f, 0.f};
    f16x8 At[4][2], B0[2][2], B1[2][2];
    {
        const char* cB = cur.B;
        G8_STAGE_B(G8_SB(0, 0), cB); G8_STAGE_B(G8_SB(0, 1), cB + hstep); G8_STAGE_A(G8_SA(0, 0), 0, cur.ao[0][0], cur.ao[0][1]); G8_STAGE_A(G8_SA(0, 1), 0, cur.ao[1][0], cur.ao[1][1]);
        if (wr == 1) G8_BAR;
        G8_WAIT_V(2); G8_BAR;
        G8_STAGE_B(G8_SB(1, 0), cB + kstep); G8_STAGE_A(G8_SA(1, 0), kstep, cur.ao[0][0], cur.ao[0][1]); G8_STAGE_B(G8_SB(1, 1), cB + hstep + kstep);
        G8_WAIT_V(6); G8_BAR;
    }
    for (;;) {
        const bool has_next = S.next(ui + 1, nxt, R, C);
        if (!has_next) nxt = cur;
        const char* cB = cur.B; const char* nB = nxt.B;
        const typename Epi::Pre pre = E.prefetch(cur, wr, lane);
        for (int t = 0; t < nt; t += 2) {
            const bool last = (t == nt - 2);
            const size_t ka1 = (size_t)(t + 1) * kstep;
            const size_t ka2 = last ? 0 : (size_t)(t + 2) * kstep, ka3 = ka2 + kstep;
            const unsigned o00 = last ? nxt.ao[0][0] : cur.ao[0][0], o01 = last ? nxt.ao[0][1] : cur.ao[0][1], o10 = last ? nxt.ao[1][0] : cur.ao[1][0], o11 = last ? nxt.ao[1][1] : cur.ao[1][1];
            const char* b2 = last ? nB : cB + (size_t)(t + 2) * kstep; const char* b3 = b2 + kstep;
            G8_LDB(B0, 0, 0); G8_LDB(B1, 0, 1); G8_SCHED; G8_LDA(At, 0, 0); G8_STAGE_A(G8_SA(1, 1), ka1, cur.ao[1][0], cur.ao[1][1]);
            G8_WAIT_V(8); G8_WAIT_L(0); G8_BAR; G8_MMA(0, 0, At, B0); G8_MMA(0, 1, At, B1); G8_BAR; G8_SCHED;
            G8_LDA(At, 0, 1); G8_STAGE_B(G8_SB(0, 0), b2); G8_STAGE_B(G8_SB(0, 1), b2 + hstep); G8_STAGE_A(G8_SA(0, 0), ka2, o00, o01);
            G8_WAIT_V(8); G8_WAIT_L(0); G8_BAR; if (cur.full) { G8_MMA(1, 0, At, B0); G8_MMA(1, 1, At, B1); } G8_BAR; G8_SCHED;
            G8_LDB(B0, 1, 0); G8_LDB(B1, 1, 1); G8_SCHED; G8_LDA(At, 1, 0); G8_STAGE_A(G8_SA(0, 1), ka2, o10, o11);
            G8_WAIT_V(8); G8_WAIT_L(0); G8_BAR; G8_MMA(0, 0, At, B0); G8_MMA(0, 1, At, B1); G8_BAR; G8_SCHED;
            G8_LDA(At, 1, 1); G8_STAGE_B(G8_SB(1, 0), b3); G8_STAGE_B(G8_SB(1, 1), b3 + hstep); G8_STAGE_A(G8_SA(1, 0), ka3, o00, o01);
            G8_WAIT_V(8); G8_WAIT_L(0); G8_BAR; if (cur.full) { G8_MMA(1, 0, At, B0); G8_MMA(1, 1, At, B1); } G8_BAR; G8_SCHED;
        }
        if constexpr (ALIGN_EPI) { if (wr == 0) G8_BAR; }
        E(acc, cur, wr, wc, fr, fq, pre);
        if (!has_next) break;
#pragma unroll
        for (int a = 0; a < 2; ++a)
#pragma unroll
            for (int b = 0; b < 2; ++b)
#pragma unroll
                for (int m = 0; m < 4; ++m)
#pragma unroll
                    for (int n = 0; n < 2; ++n) acc[a][b][m][n] = (f32x4){0.f, 0.f, 0.f, 0.f};
        cur = nxt; ++ui;
        if constexpr (ALIGN_EPI) { if (wr == 1) G8_BAR; }
    }
    G8_WAIT_V(0);
    if constexpr (!ALIGN_EPI) { if (wr == 0) G8_BAR; }
    G8_BAR;
#undef G8_SA
#undef G8_SB
#undef G8_STAGE_A
#undef G8_STAGE_B
#undef G8_LDA
#undef G8_LDB
#undef G8_MMA
#undef G8_WAIT_V
#undef G8_WAIT_L
#undef G8_BAR
#undef G8_SCHED
}

}

struct ArgTable { LAS const unsigned* base;
    __device__ __forceinline__ const float* operator[](int i) const { const unsigned lo = base[2 * i], hi = base[2 * i + 1];
        const GAS float* g = (const GAS float*)(((unsigned long long)(unsigned)__builtin_amdgcn_readfirstlane(hi) << 32) | (unsigned)__builtin_amdgcn_readfirstlane(lo)); return (const float*)g; } };
struct Frame {
    LAS unsigned char* lds;
    int tid, lane, wave, vcu, G;
    ArgTable in;
    __device__ __forceinline__ float* out() const { return (float*)in[26]; }
    __device__ __forceinline__ unsigned char* ws() const { return (unsigned char*)in[27]; }
};
__device__ __forceinline__ float wave_sum(float v) {
#pragma unroll
    for (int o = 1; o < 64; o <<= 1) v += __shfl_xor(v, o);
    return v;
}
__device__ __forceinline__ float fast_sigmoid(float x) { return __builtin_amdgcn_rcpf(1.0f + __expf(-x)); }
__device__ __forceinline__ float silu_f(float x) { return x * fast_sigmoid(x); }
__device__ __forceinline__ float gelu_f(float x) { const float y = 0.7978845608028654f * (x + 0.044715f * x * x * x); return x * fast_sigmoid(2.0f * y); }
__device__ __forceinline__ unsigned pkh(float a, float b) { f16x2 v; v.x = (f16)a; v.y = (f16)b; return __builtin_bit_cast(unsigned, v); }

struct TItem { const float* W; int ldw, k0, srccol0; f16* WT; int ldt, dstrow0; float scale; };
#ifndef COPY_LD_AUX
#define COPY_LD_AUX 19
#endif
__device__ __forceinline__ void titem_load(const TItem& t, f32x4 (&tv)[8], int lane) {
    const float* base = t.W + (size_t)t.k0 * t.ldw + t.srccol0;
    const auto rsrc = __builtin_amdgcn_make_buffer_rsrc((void*)base, (short)0, (int)(64 * t.ldw * 4), 0x00020000);
    const unsigned o0 = ((unsigned)(2 * (lane >> 3)) * (unsigned)t.ldw + 4u * (unsigned)(lane & 7)) * 4u, st = 64u * (unsigned)t.ldw;
#pragma unroll
    for (int i = 0; i < 4; ++i) { tv[2 * i] = __builtin_bit_cast(f32x4, __builtin_amdgcn_raw_buffer_load_b128(rsrc, (int)(o0 + (unsigned)i * st), 0, COPY_LD_AUX));
        tv[2 * i + 1] = __builtin_bit_cast(f32x4, __builtin_amdgcn_raw_buffer_load_b128(rsrc, (int)(o0 + (unsigned)i * st + 4u * (unsigned)t.ldw), 0, COPY_LD_AUX)); }
}
__device__ __forceinline__ void titem_store(const TItem& t, const f32x4 (&tv)[8], LAS float* scr, int lane) {
    LAS unsigned* T = (LAS unsigned*)scr; const int r = lane >> 3, n4 = 4 * (lane & 7); const float sc = t.scale;
#pragma unroll
    for (int i = 0; i < 4; ++i) { const f32x4 a = tv[2 * i] * sc, b = tv[2 * i + 1] * sc; LAS unsigned* p = T + n4 * 36 + r + 8 * i;
        p[0] = pkh(a.x, b.x); p[36] = pkh(a.y, b.y); p[72] = pkh(a.z, b.z); p[108] = pkh(a.w, b.w); }
    LDS_WAIT(); asm volatile("" ::: "memory");
    const int c = lane & 7; f16* ob = t.WT + (size_t)t.dstrow0 * t.ldt + t.k0;
    const unsigned oo = (unsigned)(lane >> 3) * (unsigned)t.ldt + 8u * (unsigned)c, ost = 8u * (unsigned)t.ldt;
#pragma unroll
    for (int j = 0; j < 4; ++j) { const u32x4 o = *(const LAS u32x4*)(T + ((lane >> 3) + 8 * j) * 36 + 4 * c);
        __builtin_nontemporal_store(o, (GAS u32x4*)(ob + (oo + (unsigned)j * ost))); }
    LDS_WAIT(); asm volatile("" ::: "memory");
}
__device__ __forceinline__ void transpose_item(const float* W, int ldw, int k0, int srccol0, f16* WT, int ldt, int dstrow0, float scale, LAS float* scr, int lane) {
    TItem t{W, ldw, k0, srccol0, WT, ldt, dstrow0, scale}; f32x4 tv[8]; titem_load(t, tv, lane); titem_store(t, tv, scr, lane);
}
__device__ __forceinline__ int win_srccol(int n0, float& scale) {
    const int t = n0 >> 8, c = n0 & 255; scale = 1.0f;
    if (t >= 8 && t < 16) {
        const int hl = 2 * (t & 3) + ((c & 127) >> 6), dim = (c & 63) + 64 * (c >> 7);
        if (t >= 12) scale = 0.08838834764831845f;
        return (t >= 12 ? 3072 : 2048) + hl * 128 + dim;
    }
    return n0;
}
__device__ __forceinline__ void p0_prologue(Frame& F) {
    LAS float* scr = (LAS float*)(F.lds + RING_OFF + F.wave * 16384);
    const int gw = F.vcu * NWAVES + F.wave, NGW = F.G * NWAVES;
    {
        LAS float* sc = (LAS float*)(F.lds + RING_OFF);
        LAS float* red = sc + 3 * 2048;
        const float* c = F.in[1]; const float* cc = F.in[3]; const float* wm = F.in[4]; const float* bm = F.in[5];
        for (int i = F.tid; i < 3 * 2048; i += 512) { const float v = i < 4096 ? c[i] : cc[i - 4096]; sc[i] = silu_f(v); }
        __syncthreads();
        for (int cb = F.vcu; cb < 256; cb += F.G) {
            const int col0 = cb * 48;
            const int r = F.lane / 12, c4 = F.lane % 12;
            f32x4 a0 = {0, 0, 0, 0}, a1 = {0, 0, 0, 0}, a2 = {0, 0, 0, 0};
            if (F.lane < 60) {
                for (int kb = F.wave * 5 + r; kb < 2048; kb += 320) {
                    f32x4 wv[8];
#pragma unroll
                    for (int j = 0; j < 8; ++j) { const int k = kb + 40 * j; wv[j] = (k < 2048) ? *(const f32x4*)(wm + (size_t)k * 12288 + col0 + 4 * c4) : (f32x4){0.f, 0.f, 0.f, 0.f}; }
#pragma unroll
                    for (int j = 0; j < 8; ++j) { const int k = (kb + 40 * j) & 2047; a0 += wv[j] * sc[k]; a1 += wv[j] * sc[2048 + k]; a2 += wv[j] * sc[4096 + k]; }
                }
                LAS float* rp = red + ((F.wave * 5 + r) * 3) * 48 + 4 * c4;
                *(LAS f32x4*)(rp) = a0; *(LAS f32x4*)(rp + 48) = a1; *(LAS f32x4*)(rp + 96) = a2;
            }
            __syncthreads();
            if (F.tid < 144) { float s = 0.f; for (int j = 0; j < 40; ++j) s += red[j * 144 + F.tid];
                const int v = F.tid / 48, cl = F.tid % 48; ((float*)(F.ws() + WS_MOD))[v * 12288 + col0 + cl] = s + bm[col0 + cl]; }
            __syncthreads();
        }
    }
    if (F.vcu == 0) { float* rope = (float*)(F.ws() + WS_ROPE);
        for (int i = F.tid; i < 2048; i += 512) { const int pos = i >> 5, j = i & 31; const float inv = powf(10000.0f, -(float)j / 32.0f); const float ang = (float)pos * inv;
            rope[i] = cosf(ang); rope[2048 + i] = sinf(ang); } }
    { const float* rw = F.in[17]; f16* rh = (f16*)(F.ws() + WS_RWT); f16* rl = rh + NE * DM;
      for (int idx = F.vcu * 512 + F.tid; idx < NE * DM; idx += F.G * 512) { const int k = idx >> 6, e = idx & 63; const float v = rw[idx]; const f16 hi = (f16)v;
          const int o = (((((k >> 5) * 4 + (e >> 4)) * 4 + ((k >> 3) & 3)) * 16 + (e & 15)) << 3) + (k & 7); rh[o] = hi; rl[o] = (f16)((v - (float)hi) * 2048.0f); } }
    constexpr int I_IN = 32 * 192, I_OUT = 32 * 64;
    for (int it = gw; it < I_IN + I_OUT; it += NGW) {
        int r = it;
        if (r < I_IN) { const int kb = r / 192, nb = r % 192; float scale; const int src = win_srccol(nb * 32, scale);
            transpose_item(F.in[8], INC, kb * 64, src, (f16*)(F.ws() + WS_WINT), DM, nb * 32, scale, scr, F.lane); continue; }
        r -= I_IN;
        { const int kb = r / 64, nb = r % 64; transpose_item(F.in[16], DM, kb * 64, nb * 32, (f16*)(F.ws() + WS_WOUTT), DM, nb * 32, 1.0f, scr, F.lane); }
    }
}
__device__ __forceinline__ TItem expert_item(Frame& F, int it) {
    constexpr int I_E = 1536; const int e = it / I_E; int r = it % I_E; TItem t;
    if (r < 1024) {
        const int kb = r / 32, nb = r % 32, pn = nb >> 3, wi = nb & 7;
        t.W = (e < NE) ? ((wi < 4 ? F.in[19] : F.in[20]) + (size_t)e * DM * EH) : (wi < 4 ? F.in[22] : F.in[23]);
        t.ldw = EH; t.k0 = kb * 64; t.srccol0 = pn * 128 + (wi & 3) * 32; t.WT = (f16*)(F.ws() + WS_W13T) + (size_t)e * 1024 * DM; t.ldt = DM; t.dstrow0 = nb * 32; t.scale = 1.0f;
    } else {
        r -= 1024; const int kb = r / 64, nb = r % 64;
        t.W = (e < NE) ? (F.in[21] + (size_t)e * EH * DM) : F.in[24];
        t.ldw = DM; t.k0 = kb * 64; t.srccol0 = nb * 32; t.WT = (f16*)(F.ws() + WS_W2T) + (size_t)e * DM * EH; t.ldt = EH; t.dstrow0 = nb * 32; t.scale = 1.0f;
    }
    return t;
}
__device__ __forceinline__ void p2_expert_copies(Frame& F) {
    LAS float* scr = (LAS float*)(F.lds + RING_OFF + F.wave * 16384);
    constexpr int NIT = NE1 * 1536, N_CTXWG = 64, SH_CTX = 292, SH_REG = (NIT - N_CTXWG * SH_CTX) / 192, REM = (NIT - N_CTXWG * SH_CTX) % 192;
    int lo, n;
    if (F.vcu < N_CTXWG) { lo = F.vcu * SH_CTX; n = SH_CTX; }
    else { const int v = F.vcu - N_CTXWG; lo = N_CTXWG * SH_CTX + v * SH_REG + (v < REM ? v : REM); n = SH_REG + (v < REM ? 1 : 0); }
    const int hi = lo + n;
    TItem t0, t1, t2; f32x4 v0[8], v1[8], v2[8];
    int it = lo + F.wave;
    if (it < hi) { t0 = expert_item(F, it); titem_load(t0, v0, F.lane); }
    if (it + NWAVES < hi) { t1 = expert_item(F, it + NWAVES); titem_load(t1, v1, F.lane); }
    for (; it < hi; it += 3 * NWAVES) {
        if (it + 2 * NWAVES < hi) { t2 = expert_item(F, it + 2 * NWAVES); titem_load(t2, v2, F.lane); }
        titem_store(t0, v0, scr, F.lane);
        if (it + 3 * NWAVES < hi) { t0 = expert_item(F, it + 3 * NWAVES); titem_load(t0, v0, F.lane); }
        if (it + NWAVES < hi) titem_store(t1, v1, scr, F.lane);
        if (it + 4 * NWAVES < hi) { t1 = expert_item(F, it + 4 * NWAVES); titem_load(t1, v1, F.lane); }
        if (it + 2 * NWAVES < hi) titem_store(t2, v2, scr, F.lane);
    }
}

constexpr int IMG_LD = 136;
constexpr int IMG_BYTES = 128 * IMG_LD * 2;
__device__ __forceinline__ void wave_mma(f32x4 (&acc)[8], const f16x8 (&a)[4], const LAS f16* img, int fr, int fq) {
#pragma unroll
    for (int ks = 0; ks < 4; ++ks) { __builtin_amdgcn_sched_barrier(0);
#pragma unroll
        for (int t = 0; t < 8; ++t) { const f16x8 b = *(const LAS f16x8*)(img + (16 * t + fr) * IMG_LD + 32 * ks + 8 * fq); acc[t] = __builtin_amdgcn_mfma_f32_16x16x32_f16(b, a[ks], acc[t], 0, 0, 0); } }
    __builtin_amdgcn_sched_barrier(0);
}
__device__ __forceinline__ void zero8(f32x4 (&acc)[8]) {
#pragma unroll
    for (int t = 0; t < 8; ++t) acc[t] = (f32x4){0.f, 0.f, 0.f, 0.f};
}
__device__ __forceinline__ void stage_rows(LAS f16* img, const f16* src, int ld, int tid) {
#pragma unroll
    for (int it = 0; it < 4; ++it) { const int r = (tid >> 4) + 32 * it, cc = (tid & 15) * 8; *(LAS u32x4*)(img + r * IMG_LD + cc) = *(const u32x4*)(src + (size_t)r * ld + cc); }
}
__device__ __forceinline__ void stage_rows_f32(LAS f16* img, const float* src, int tid) {
#pragma unroll
    for (int it = 0; it < 8; ++it) { const int r = (tid >> 5) + 16 * it, cc = (tid & 31) * 4; const f32x4 v = *(const f32x4*)(src + (size_t)r * 128 + cc);
        u32x2 o; o.x = pkh(v.x, v.y); o.y = pkh(v.z, v.w); *(LAS u32x2*)(img + r * IMG_LD + cc) = o; }
}


__device__ __forceinline__ void p2_ctx_unit(Frame& F, int u) {
    const int rb = u >> 4, cb = u & 15, h = cb & 7; const bool isv = cb >= 8;
    const f16* HXc = (const f16*)(F.ws() + WS_HX) + (size_t)(NTOK + rb * 128) * DM; const f16* WT = (const f16*)(F.ws() + WS_WINT);
    LAS f16* imA = (LAS f16*)(F.lds); LAS f16* imB = (LAS f16*)(F.lds + IMG_BYTES);
    const int fr = F.lane & 15, fq = F.lane >> 4, w = F.wave;
    const int r0 = F.tid >> 4, cc = (F.tid & 15) * 8;
    const f16* ap[4]; const f16* bp[4];
#pragma unroll
    for (int it = 0; it < 4; ++it) { const int r = r0 + 32 * it; ap[it] = HXc + (size_t)r * DM + cc;
        const int brow = isv ? (4096 + h * 128 + r) : ((12 + (h >> 1)) * 256 + (r >> 6) * 128 + (h & 1) * 64 + (r & 63)); bp[it] = WT + (size_t)brow * DM + cc; }
    u32x4 aw[4], bw[4];
#pragma unroll
    for (int it = 0; it < 4; ++it) { aw[it] = *(const u32x4*)(ap[it]); bw[it] = *(const u32x4*)(bp[it]); }
    f32x4 acc[8]; zero8(acc);
    for (int kc = 0; kc < 16; ++kc) {
#pragma unroll
        for (int it = 0; it < 4; ++it) { const int r = r0 + 32 * it; *(LAS u32x4*)(imA + r * IMG_LD + cc) = aw[it]; *(LAS u32x4*)(imB + r * IMG_LD + cc) = bw[it]; }
        if (kc < 15) {
#pragma unroll
            for (int it = 0; it < 4; ++it) { aw[it] = *(const u32x4*)(ap[it] + (kc + 1) * 128); bw[it] = *(const u32x4*)(bp[it] + (kc + 1) * 128); } }
        __syncthreads();
        f16x8 a[4];
#pragma unroll
        for (int ks = 0; ks < 4; ++ks) a[ks] = *(const LAS f16x8*)(imA + (16 * w + fr) * IMG_LD + 32 * ks + 8 * fq);
        wave_mma(acc, a, imB, fr, fq);
        __syncthreads();
    }
    f16* dst = (f16*)(F.ws() + (isv ? WS_CV : WS_CK)) + (size_t)(rb * 128 + 16 * w + fr) * AW + h * 128;
#pragma unroll
    for (int t = 0; t < 8; ++t) { u32x2 o; o.x = pkh(acc[t].x, acc[t].y); o.y = pkh(acc[t].z, acc[t].w); *(u32x2*)(dst + 16 * t + 4 * fq) = o; }
}
__device__ __forceinline__ void p1_norm(Frame& F) {
    const int gw = F.vcu * NWAVES + F.wave, NGW = F.G * NWAVES;
    const float* g1 = F.in[6]; const float* xin = F.in[0]; const float* cin = F.in[2]; const float* modb = (const float*)(F.ws() + WS_MOD); f16* HX = (f16*)(F.ws() + WS_HX);
    f32x4 nx[8];
    { const int row = gw; const float* xr = row < NTOK ? xin + (size_t)row * DM : cin + (size_t)(row - NTOK) * DM;
#pragma unroll
      for (int j = 0; j < 8; ++j) nx[j] = *(const f32x4*)(xr + 4 * F.lane + 256 * j); }
    for (int row = gw; row < NROWS_IN; row += NGW) {
        f32x4 v[8]; float ss = 0.f;
#pragma unroll
        for (int j = 0; j < 8; ++j) { v[j] = nx[j]; ss += (v[j].x * v[j].x + v[j].y * v[j].y) + (v[j].z * v[j].z + v[j].w * v[j].w); }
        { const int r2 = row + NGW; if (r2 < NROWS_IN) { const float* xr = r2 < NTOK ? xin + (size_t)r2 * DM : cin + (size_t)(r2 - NTOK) * DM;
#pragma unroll
            for (int j = 0; j < 8; ++j) nx[j] = *(const f32x4*)(xr + 4 * F.lane + 256 * j); } }
        const float* mod = modb + (row < NTOK ? (row >> 12) : 2) * 12288;
        const float rstd = 1.0f / sqrtf(wave_sum(ss) * (1.0f / DM) + EPS);
        f16* orow = HX + (size_t)row * DM;
#pragma unroll
        for (int j = 0; j < 8; ++j) { const int col = 4 * F.lane + 256 * j;
            const f32x4 g = *(const f32x4*)(g1 + col), sh = *(const f32x4*)(mod + col), sc = *(const f32x4*)(mod + 2048 + col);
            const f32x4 h = (v[j] * rstd * g) * (sc + 1.0f) + sh;
            u32x2 o; o.x = pkh(h.x, h.y); o.y = pkh(h.z, h.w); *(u32x2*)(orow + col) = o; }
    }
}

struct InSched { int G, c; const char* Bt; int ulo, uhi;
    __device__ __forceinline__ bool next(int i, g8::Unit& u, const int (&R)[2], const int (&C)[2]) const {
        if (i + ulo >= uhi) return false; const int L = (i + ulo) * G + c; int pm, pn;
        if (!g8::dense_order(L, 32, 24, pm, pn)) return false;
#pragma unroll
        for (int h = 0; h < 2; ++h)
#pragma unroll
            for (int k = 0; k < 2; ++k) u.ao[h][k] = (unsigned)((pm * 256 + h * 128 + R[k]) * DM + C[k]) * 2u;
        u.B = Bt + (size_t)pn * 256 * DM * 2; u.row0 = pm * 256; u.pn = pn; u.aux = 0; u.full = 1;
        return true;
    }
};

struct EpiIn {
    static constexpr bool PERM = true;
    f16* PB; f16* CK; f16* CV; float* vstp; const float* rope;
    struct Pre {}; __device__ __forceinline__ Pre prefetch(const g8::Unit&, int, int) const { return Pre{}; }
    __device__ __forceinline__ void operator()(const f32x4 (&acc)[2][2][4][2], const g8::Unit& u, int wr, int wc, int fr, int fq, const Pre&) const {
        const int pn = u.pn, ty = pn >> 2; const bool ctx = u.row0 >= NTOK;
        const int c1 = wc * 32 + 8 * fq;
        if (ty == 2 || ty == 3) {
            const int head = 2 * (pn & 3) + (wc >> 1), i0 = c1 & 63, isq = (ty == 2);
            f16* dstb = ctx ? CK : (PB + (size_t)(isq ? 2 : 3) * NTOK * AW);
#pragma unroll
            for (int ai = 0; ai < 2; ++ai)
#pragma unroll
                for (int m = 0; m < 4; ++m) { const int row = u.row0 + ai * 128 + wr * 64 + m * 16 + fr;
                    const f32x4 a0 = acc[ai][0][m][0], a1 = acc[ai][0][m][1], b0 = acc[ai][1][m][0], b1 = acc[ai][1][m][1];
                    f32x4 c0 = {1.f, 1.f, 1.f, 1.f}, c1v = c0, s0 = {0.f, 0.f, 0.f, 0.f}, s1 = s0;
                    if (!ctx) { const int tpos = row & (SEQ - 1); const int pos = (wc & 1) ? (tpos & 63) : (tpos >> 6); const float* rp = rope + pos * 32 + (i0 & 31);
                        c0 = *(const f32x4*)(rp); c1v = *(const f32x4*)(rp + 4); s0 = *(const f32x4*)(rp + 2048); s1 = *(const f32x4*)(rp + 2052); }
                    const f32x4 o1a = a0 * c0 - b0 * s0, o1b = a1 * c1v - b1 * s1, o2a = a0 * s0 + b0 * c0, o2b = a1 * s1 + b1 * c1v;
                    const int drow = ctx ? row - NTOK : row;
                    f16* d = dstb + (size_t)drow * AW + head * 128 + i0;
                    u32x4 w1; w1.x = pkh(o1a[0], o1a[1]); w1.y = pkh(o1a[2], o1a[3]); w1.z = pkh(o1b[0], o1b[1]); w1.w = pkh(o1b[2], o1b[3]);
                    u32x4 w2; w2.x = pkh(o2a[0], o2a[1]); w2.y = pkh(o2a[2], o2a[3]); w2.z = pkh(o2b[0], o2b[1]); w2.w = pkh(o2b[2], o2b[3]);
                    *(u32x4*)d = w1; *(u32x4*)(d + 64) = w2; }
            return;
        }
        const int sel = (ty == 0) ? 0 : (ty == 1) ? 1 : (ty == 4) ? 4 : 5;
        f16* dstb = (ctx ? CV : PB + (size_t)sel * NTOK * AW) + (pn & 3) * 256 + c1;
#pragma unroll
        for (int ai = 0; ai < 2; ++ai)
#pragma unroll
            for (int m = 0; m < 4; ++m) { const int row = u.row0 + ai * 128 + wr * 64 + m * 16 + fr; const int drow = ctx ? row - NTOK : row;
                float s = 0.f, q = 0.f;
#pragma unroll
                for (int bj = 0; bj < 2; ++bj) { f32x4 v0 = acc[ai][bj][m][0], v1 = acc[ai][bj][m][1];
                    if (ty <= 1) {
#pragma unroll
                        for (int j = 0; j < 4; ++j) { v0[j] = gelu_f(v0[j]); v1[j] = gelu_f(v1[j]); } }
                    else if (ty == 5) {
#pragma unroll
                        for (int j = 0; j < 4; ++j) { v0[j] = silu_f(v0[j]); v1[j] = silu_f(v1[j]); } }
                    if (ty == 1) { s += (v0[0] + v0[1]) + (v0[2] + v0[3]) + (v1[0] + v1[1]) + (v1[2] + v1[3]);
                        q += (v0[0] * v0[0] + v0[1] * v0[1]) + (v0[2] * v0[2] + v0[3] * v0[3]) + (v1[0] * v1[0] + v1[1] * v1[1]) + (v1[2] * v1[2] + v1[3] * v1[3]); }
                    u32x4 o; o.x = pkh(v0[0], v0[1]); o.y = pkh(v0[2], v0[3]); o.z = pkh(v1[0], v1[1]); o.w = pkh(v1[2], v1[3]);
                    *(u32x4*)(dstb + (size_t)drow * AW + bj * 128) = o; }
                if (ty == 1) { s += __shfl_xor(s, 16); s += __shfl_xor(s, 32); q += __shfl_xor(q, 16); q += __shfl_xor(q, 32);
                    if (fq == 0) { f32x2 st; st.x = s; st.y = q; *(f32x2*)(vstp + ((size_t)row * 16 + (pn & 3) * 4 + wc) * 2) = st; } } }
    }
};
struct EpiX1 {
    static constexpr bool PERM = false;
    const float* x; const float* mod; float* X1;
    struct Pre {}; __device__ __forceinline__ Pre prefetch(const g8::Unit&, int, int) const { return Pre{}; }
    __device__ __forceinline__ void operator()(const f32x4 (&acc)[2][2][4][2], const g8::Unit& u, int wr, int wc, int fr, int fq, const Pre&) const {
        const int row0 = u.row0 + wr * 64 + fr, col0 = u.pn * 256 + wc * 32 + 4 * fq;
        const float* g1 = mod + (u.row0 >> 12) * 12288 + 2 * 2048;
        f32x4 gv[2][2];
#pragma unroll
        for (int bj = 0; bj < 2; ++bj)
#pragma unroll
            for (int n = 0; n < 2; ++n) gv[bj][n] = *(const f32x4*)(g1 + col0 + bj * 128 + n * 16);
#pragma unroll
        for (int ai = 0; ai < 2; ++ai)
#pragma unroll
            for (int m = 0; m < 4; ++m) { const size_t off = (size_t)(row0 + ai * 128 + m * 16) * DM + col0;
#pragma unroll
                for (int bj = 0; bj < 2; ++bj)
#pragma unroll
                    for (int n = 0; n < 2; ++n) { const f32x4 xv = *(const f32x4*)(x + off + bj * 128 + n * 16); *(f32x4*)(X1 + off + bj * 128 + n * 16) = xv + gv[bj][n] * acc[ai][bj][m][n]; }
                if (m & 1) asm volatile("" ::: "memory"); }
    }
};
__device__ __forceinline__ void p3_post(Frame& F) {
    const int gw = F.vcu * NWAVES + F.wave, NGW = F.G * NWAVES;
    const float* CB = (const float*)(F.ws() + WS_CBUF);
    f16* UG = (f16*)(F.ws() + WS_PBUF); f16* VG = UG + (size_t)NTOK * AW; f16* Qb = VG + (size_t)NTOK * AW; f16* Kb = Qb + (size_t)NTOK * AW; f16* VR = Kb + (size_t)NTOK * AW; f16* GS = VR + (size_t)NTOK * AW;
    f16* CK = (f16*)(F.ws() + WS_CK); f16* CV = (f16*)(F.ws() + WS_CV);
    const float* rope = (const float*)(F.ws() + WS_ROPE);
    float* vstat = (float*)(F.ws() + WS_VSTAT);
    for (int row = gw; row < NROWS_IN; row += NGW) {
        const float* cr = CB + (size_t)row * INC;
        if (row < NTOK) {
            float gv[16]; float s = 0.f;
#pragma unroll
            for (int j = 0; j < 4; ++j) { const int col = 256 * j + 4 * F.lane;
                const f32x4 u = *(const f32x4*)(cr + col); u32x2 o; o.x = pkh(gelu_f(u.x), gelu_f(u.y)); o.y = pkh(gelu_f(u.z), gelu_f(u.w)); *(u32x2*)(UG + (size_t)row * AW + col) = o;
                const f32x4 v = *(const f32x4*)(cr + 1024 + col); gv[4 * j] = gelu_f(v.x); gv[4 * j + 1] = gelu_f(v.y); gv[4 * j + 2] = gelu_f(v.z); gv[4 * j + 3] = gelu_f(v.w);
                s += (gv[4 * j] + gv[4 * j + 1]) + (gv[4 * j + 2] + gv[4 * j + 3]);
                u32x2 o2; o2.x = pkh(gv[4 * j], gv[4 * j + 1]); o2.y = pkh(gv[4 * j + 2], gv[4 * j + 3]); *(u32x2*)(VG + (size_t)row * AW + col) = o2;
                const f32x4 w = *(const f32x4*)(cr + 4096 + col); u32x2 o3; o3.x = pkh(w.x, w.y); o3.y = pkh(w.z, w.w); *(u32x2*)(VR + (size_t)row * AW + col) = o3;
                const f32x4 g = *(const f32x4*)(cr + 5120 + col); u32x2 o4; o4.x = pkh(silu_f(g.x), silu_f(g.y)); o4.y = pkh(silu_f(g.z), silu_f(g.w)); *(u32x2*)(GS + (size_t)row * AW + col) = o4; }
            const float mean = wave_sum(s) * (1.0f / AW); float q = 0.f;
#pragma unroll
            for (int j = 0; j < 16; ++j) { const float d = gv[j] - mean; q += d * d; }
            const float rstd = 1.0f / sqrtf(wave_sum(q) * (1.0f / AW) + EPS);
            if (F.lane == 0) { vstat[2 * row] = mean; vstat[2 * row + 1] = rstd; }
            const int tpos = row & (SEQ - 1), rpos = tpos >> 6, cpos = tpos & 63;
            for (int t = 8; t < 16; ++t) {
#pragma unroll
                for (int cc = 0; cc < 2; ++cc) { const int c = F.lane + 64 * cc;
                    const float x1 = cr[256 * t + c], x2 = cr[256 * t + 128 + c];
                    const int head = 2 * (t & 3) + (c >> 6), i = c & 63;
                    const int ri = (i < 32) ? (rpos * 32 + i) : (cpos * 32 + (i - 32));
                    const float cs = rope[ri], sn = rope[2048 + ri];
                    f16* dst = (t < 12 ? Qb : Kb) + (size_t)row * AW + head * 128 + i;
                    dst[0] = (f16)(x1 * cs - x2 * sn); dst[64] = (f16)(x1 * sn + x2 * cs); }
            }
        } else {
            const int rc = row - NTOK;
            for (int t = 12; t < 16; ++t) {
#pragma unroll
                for (int cc = 0; cc < 2; ++cc) { const int c = F.lane + 64 * cc; const float x1 = cr[256 * t + c], x2 = cr[256 * t + 128 + c];
                    const int head = 2 * (t & 3) + (c >> 6), i = c & 63; f16* dst = CK + (size_t)rc * AW + head * 128 + i; dst[0] = (f16)x1; dst[64] = (f16)x2; }
            }
#pragma unroll
            for (int j = 0; j < 4; ++j) { const int col = 256 * j + 4 * F.lane; const f32x4 w = *(const f32x4*)(cr + 4096 + col); u32x2 o3; o3.x = pkh(w.x, w.y); o3.y = pkh(w.z, w.w); *(u32x2*)(CV + (size_t)rc * AW + col) = o3; }
        }
    }
}

__device__ __forceinline__ size_t st_index(int dir, int bh, int slot) { return ((size_t)(dir * 16 + bh) * 33 + slot) * 16384; }
__device__ __forceinline__ void p4_fast(Frame& F) {
    const f16* UG = (const f16*)(F.ws() + WS_PBUF); const f16* VG = UG + (size_t)NTOK * AW; const f16* Kb = VG + (size_t)2 * NTOK * AW; const f16* VR = Kb + (size_t)NTOK * AW;
    const f16* CK = (const f16*)(F.ws() + WS_CK); const f16* CV = (const f16*)(F.ws() + WS_CV);
    const float* vstat = (const float*)(F.ws() + WS_VSTAT);
    const float* alng = F.in[9]; const float* aws = F.in[10]; const float* abs_ = F.in[11];
    const float* lgf = F.in[13]; const float* lgb = F.in[14];
    f16* ARAW = (f16*)(F.ws() + WS_ARAW); f16* ST = (f16*)(F.ws() + WS_ST);
    LAS f16* im0 = (LAS f16*)(F.lds); LAS f16* im1 = (LAS f16*)(F.lds + IMG_BYTES); LAS f16* im2 = (LAS f16*)(F.lds + 2 * IMG_BYTES);
    const int fr = F.lane & 15, fq = F.lane >> 4, w = F.wave;
    constexpr int NU_MLP = 512, NU_LOC = 512, NU_CTX = 32, NU = NU_MLP + NU_LOC + NU_CTX;
    for (int u = F.vcu; u < NU; u += F.G) {
        if (u < NU_MLP) {
            const int h = u & 7, ci = u >> 3, t0 = ci * CHK, hc = h * 128;
            float mean, rstd; { const float* pp = vstat + (size_t)(t0 + (F.tid & 127)) * 32; float ssum = 0.f, qsum = 0.f;
#pragma unroll
                for (int k = 0; k < 16; ++k) { const f32x2 st = *(const f32x2*)(pp + 2 * k); ssum += st.x; qsum += st.y; }
                mean = ssum * (1.0f / AW); rstd = 1.0f / sqrtf(fmaxf(qsum * (1.0f / AW) - mean * mean, 0.f) + EPS); }
#pragma unroll
            for (int it = 0; it < 4; ++it) { const int q = F.tid & 127, cc = ((F.tid >> 7) + 4 * it) * 8;
                const f16x8 v = *(const f16x8*)(VG + (size_t)(t0 + q) * AW + hc + cc);
#pragma unroll
                for (int j = 0; j < 8; ++j) im0[(cc + j) * IMG_LD + q] = (f16)(((float)v[j] - mean) * rstd * alng[hc + cc + j]); }
            f16x8 a[4]; const float* wrow = aws + (size_t)(hc + 16 * w + fr) * 128;
#pragma unroll
            for (int ks = 0; ks < 4; ++ks) { const f32x4 x0 = *(const f32x4*)(wrow + 32 * ks + 8 * fq), x1 = *(const f32x4*)(wrow + 32 * ks + 8 * fq + 4);
                a[ks][0] = (f16)x0.x; a[ks][1] = (f16)x0.y; a[ks][2] = (f16)x0.z; a[ks][3] = (f16)x0.w; a[ks][4] = (f16)x1.x; a[ks][5] = (f16)x1.y; a[ks][6] = (f16)x1.z; a[ks][7] = (f16)x1.w; }
            __syncthreads();
            f32x4 acc[8]; zero8(acc); wave_mma(acc, a, im0, fr, fq);
            const int p = 16 * w + fr; const float bias = abs_[hc + p];
#pragma unroll
            for (int t = 0; t < 8; ++t) { const int d = 16 * t + 4 * fq; const f16x4 ug = *(const f16x4*)(UG + (size_t)(t0 + p) * AW + hc + d);
                u32x2 o; o.x = pkh((float)ug.x * (acc[t].x + bias), (float)ug.y * (acc[t].y + bias)); o.y = pkh((float)ug.z * (acc[t].z + bias), (float)ug.w * (acc[t].w + bias));
                *(u32x2*)(ARAW + (size_t)(t0 + p) * AW + hc + d) = o; }
            __syncthreads();
        } else {
            const bool isctx = (u >= NU_MLP + NU_LOC); const int uu = isctx ? (u - NU_MLP - NU_LOC) : (u - NU_MLP);
            const int bh = isctx ? (uu >> 1) : (uu >> 5), i = isctx ? 0 : (uu & 31), b = bh >> 3, h = bh & 7, hc = h * 128, chf = uu & 1;
            const float lf = lgf[h], lb = lgb[h];
            f32x4 af[8], ab[8]; zero8(af); zero8(ab);
            { const int hf = isctx ? chf : 0;
                const f16* ksrc = isctx ? (CK + (size_t)(b * CTXL + hf * 128) * AW + hc) : (Kb + (size_t)(b * SEQ + i * CHK) * AW + hc);
                const f16* vsrc = isctx ? (CV + (size_t)(b * CTXL + hf * 128) * AW + hc) : (VR + (size_t)(b * SEQ + i * CHK) * AW + hc);
                const int L = isctx ? CTXL : CHK;
#pragma unroll
                for (int it = 0; it < 4; ++it) { const int m = F.tid & 127, cc = ((F.tid >> 7) + 4 * it) * 8; const int l = hf * 128 + m;
                    const f16x8 kv = *(const f16x8*)(ksrc + (size_t)m * AW + cc); const f16x8 vv = *(const f16x8*)(vsrc + (size_t)m * AW + cc);
                    const float wf = __expf(lf * (float)(L - 1 - l)), wb = __expf(lb * (float)l);
#pragma unroll
                    for (int j = 0; j < 8; ++j) { im0[(cc + j) * IMG_LD + m] = vv[j]; im1[(cc + j) * IMG_LD + m] = (f16)((float)kv[j] * wf); im2[(cc + j) * IMG_LD + m] = (f16)((float)kv[j] * wb); } }
                __syncthreads();
                f16x8 a[4];
#pragma unroll
                for (int ks = 0; ks < 4; ++ks) a[ks] = *(const LAS f16x8*)(im0 + (16 * w + fr) * IMG_LD + 32 * ks + 8 * fq);
                wave_mma(af, a, im1, fr, fq); wave_mma(ab, a, im2, fr, fq);
                __syncthreads();
            }
            const int sf = isctx ? (chf ? 32 : 0) : i + 1, sb = isctx ? (chf ? 32 : 0) : 32 - i;
            f16* df = ST + st_index(0, bh, sf) + (16 * w + fr) * 128; f16* db = ST + st_index(1, bh, sb) + (16 * w + fr) * 128;
            if (isctx || sf != 32) {
#pragma unroll
                for (int t = 0; t < 8; ++t) { u32x2 o; o.x = pkh(af[t].x, af[t].y); o.y = pkh(af[t].z, af[t].w); *(u32x2*)(df + 16 * t + 4 * fq) = o; } }
            if (isctx || sb != 32) {
#pragma unroll
                for (int t = 0; t < 8; ++t) { u32x2 o; o.x = pkh(ab[t].x, ab[t].y); o.y = pkh(ab[t].z, ab[t].w); *(u32x2*)(db + 16 * t + 4 * fq) = o; } }
        }
    }
}
__device__ __forceinline__ void p6_fast(Frame& F) {
    const f16* Qb = (const f16*)(F.ws() + WS_PBUF) + (size_t)2 * NTOK * AW; const f16* Kb = Qb + (size_t)NTOK * AW; const f16* VR = Kb + (size_t)NTOK * AW; const f16* GS = VR + (size_t)NTOK * AW;
    const f16* ST = (const f16*)(F.ws() + WS_ST);
    const float* lgf = F.in[13]; const float* lgb = F.in[14]; const float* gng = F.in[15]; f16* AR = (f16*)(F.ws() + WS_AR);
    LAS f16* imK = (LAS f16*)(F.lds); LAS f16* imV = (LAS f16*)(F.lds + IMG_BYTES); LAS f16* imS = (LAS f16*)(F.lds + 2 * IMG_BYTES); LAS f16* imP = (LAS f16*)(F.lds + 3 * IMG_BYTES);
    const int fr = F.lane & 15, fq = F.lane >> 4, w = F.wave;
    constexpr float L2E = 1.4426950408889634f;
    for (int u = F.vcu; u < 512; u += F.G) {
        const int bh = u >> 5, i = u & 31, b = bh >> 3, h = bh & 7, hc = h * 128; const size_t t0 = (size_t)b * SEQ + i * CHK;
        const float lf = lgf[h] * L2E, lb = lgb[h] * L2E;
        stage_rows(imK, Kb + t0 * AW + hc, AW, F.tid);
#pragma unroll
        for (int it = 0; it < 4; ++it) { const int m = F.tid & 127, cc = ((F.tid >> 7) + 4 * it) * 8; const f16x8 vv = *(const f16x8*)(VR + (t0 + m) * AW + hc + cc);
#pragma unroll
            for (int j = 0; j < 8; ++j) imV[(cc + j) * IMG_LD + m] = vv[j]; }
        stage_rows(imS, ST + st_index(0, bh, i), 128, F.tid);
        stage_rows(imP, ST + st_index(1, bh, 31 - i), 128, F.tid);
        const int n = 16 * w + fr; const size_t trow = t0 + n;
        f16x8 qa[4];
#pragma unroll
        for (int ks = 0; ks < 4; ++ks) qa[ks] = *(const f16x8*)(Qb + trow * AW + hc + 32 * ks + 8 * fq);
        f16x4 gsv[8];
#pragma unroll
        for (int t = 0; t < 8; ++t) gsv[t] = *(const f16x4*)(GS + trow * AW + hc + 16 * t + 4 * fq);
        __syncthreads();
        f32x4 acc[8], o[8]; zero8(acc); wave_mma(acc, qa, imS, fr, fq);
        const float qf = exp2f(lf * (float)(n + 1)), qb = exp2f(lb * (float)(CHK - n));
#pragma unroll
        for (int t = 0; t < 8; ++t) o[t] = acc[t] * qf;
        zero8(acc); wave_mma(acc, qa, imP, fr, fq);
#pragma unroll
        for (int t = 0; t < 8; ++t) o[t] += acc[t] * qb;
        zero8(acc); wave_mma(acc, qa, imK, fr, fq);
        __syncthreads();
        int nn = n; asm volatile("" : "+v"(nn));
        LAS f16* pw = imP + (16 * w) * IMG_LD;
#pragma unroll
        for (int t = 0; t < 8; ++t) { float pv[4];
#pragma unroll
            for (int r = 0; r < 4; ++r) { const float dm = (float)(nn - (16 * t + 4 * fq + r)); const float dec = exp2f(lf * fmaxf(dm, 0.f) + lb * fmaxf(-dm, 0.f)) + (1.0f - fminf(fabsf(dm), 1.0f)); pv[r] = acc[t][r] * dec; }
            u32x2 pk; pk.x = pkh(pv[0], pv[1]); pk.y = pkh(pv[2], pv[3]); *(LAS u32x2*)(pw + fr * IMG_LD + 16 * t + 4 * fq) = pk; }
        f16x8 pa[4];
#pragma unroll
        for (int ks = 0; ks < 4; ++ks) pa[ks] = *(const LAS f16x8*)(pw + fr * IMG_LD + 32 * ks + 8 * fq);
        wave_mma(o, pa, imV, fr, fq);
        float s = 0.f;
#pragma unroll
        for (int t = 0; t < 8; ++t) s += (o[t].x + o[t].y) + (o[t].z + o[t].w);
        s += __shfl_xor(s, 16); s += __shfl_xor(s, 32);
        const float mean = s * (1.0f / 128.0f); float q = 0.f;
#pragma unroll
        for (int t = 0; t < 8; ++t) { o[t] = o[t] - mean; q += (o[t].x * o[t].x + o[t].y * o[t].y) + (o[t].z * o[t].z + o[t].w * o[t].w); }
        q += __shfl_xor(q, 16); q += __shfl_xor(q, 32);
        const float rstd = 1.0f / sqrtf(q * (1.0f / 128.0f) + EPS);
#pragma unroll
        for (int t = 0; t < 8; ++t) { const int col = hc + 16 * t + 4 * fq; const f32x4 g = *(const f32x4*)(gng + col); const f16x4 gs = gsv[t];
            u32x2 pk; pk.x = pkh(o[t].x * rstd * g.x * (float)gs.x, o[t].y * rstd * g.y * (float)gs.y); pk.y = pkh(o[t].z * rstd * g.z * (float)gs.z, o[t].w * rstd * g.w * (float)gs.w);
            *(u32x2*)(AR + trow * DM + AW + col) = pk; }
        __syncthreads();
    }
}
__device__ __forceinline__ void p5_naive(Frame& F) {
    const int gw = F.vcu * NWAVES + F.wave, NGW = F.G * NWAVES; const int gt = F.vcu * 512 + F.tid, NGT = F.G * 512;
    const f16* ARAW = (const f16*)(F.ws() + WS_ARAW); f16* AR = (f16*)(F.ws() + WS_AR); const float* aog = F.in[12];
    for (int row = gw; row < NTOK; row += NGW) {
        f16x8 v[2]; float ss = 0.f;
#pragma unroll
        for (int j = 0; j < 2; ++j) { v[j] = *(const f16x8*)(ARAW + (size_t)row * AW + 8 * F.lane + 512 * j);
#pragma unroll
            for (int k = 0; k < 8; ++k) ss += (float)v[j][k] * (float)v[j][k]; }
        const float rstd = 1.0f / sqrtf(wave_sum(ss) * (1.0f / AW) + EPS);
#pragma unroll
        for (int j = 0; j < 2; ++j) { const int col = 8 * F.lane + 512 * j; const f32x4 ga = *(const f32x4*)(aog + col), gb = *(const f32x4*)(aog + col + 4);
            u32x4 o; o.x = pkh((float)v[j][0] * rstd * ga.x, (float)v[j][1] * rstd * ga.y); o.y = pkh((float)v[j][2] * rstd * ga.z, (float)v[j][3] * rstd * ga.w);
            o.z = pkh((float)v[j][4] * rstd * gb.x, (float)v[j][5] * rstd * gb.y); o.w = pkh((float)v[j][6] * rstd * gb.z, (float)v[j][7] * rstd * gb.w);
            *(u32x4*)(AR + (size_t)row * DM + col) = o; }
    }
    f16* ST = (f16*)(F.ws() + WS_ST); const float* lgf = F.in[13]; const float* lgb = F.in[14];
    for (int idx = gt; idx < 2 * 16 * 8192; idx += NGT) {
        const int e = (idx & 8191) * 2, bh = (idx >> 13) & 15, dir = idx >> 17, h = bh & 7;
        const float cd = __expf((dir ? lgb[h] : lgf[h]) * (float)CHK);
        f16* p0 = ST + st_index(dir, bh, 0) + e; f16x2 uv[32];
#pragma unroll
        for (int s = 0; s < 32; ++s) uv[s] = *(const f16x2*)(p0 + (size_t)s * 16384);
        const f16x2 c2 = *(const f16x2*)(p0 + (size_t)32 * 16384);
        float a0 = (float)uv[0][0] + (float)c2[0], a1 = (float)uv[0][1] + (float)c2[1];
        { f16x2 o; o[0] = (f16)a0; o[1] = (f16)a1; *(f16x2*)p0 = o; }
#pragma unroll
        for (int s = 1; s < 32; ++s) { a0 = cd * a0 + (float)uv[s][0]; a1 = cd * a1 + (float)uv[s][1]; f16x2 o; o[0] = (f16)a0; o[1] = (f16)a1; *(f16x2*)(p0 + (size_t)s * 16384) = o; }
    }
}
struct DenseSched { int G, c, nM, nN, K; const char* Bt;
    __device__ __forceinline__ bool next(int i, g8::Unit& u, const int (&R)[2], const int (&C)[2]) const {
        int pm, pn; if (!g8::dense_order(i * G + c, nM, nN, pm, pn)) return false;
#pragma unroll
        for (int h = 0; h < 2; ++h)
#pragma unroll
            for (int k = 0; k < 2; ++k) u.ao[h][k] = (unsigned)((pm * 256 + h * 128 + R[k]) * K + C[k]) * 2u;
        u.B = Bt + (size_t)pn * 256 * K * 2; u.row0 = pm * 256; u.pn = pn; u.aux = 0; u.full = 1; return true; } };
template <int CTRL> __device__ __forceinline__ float dpp_f(float v) { return __builtin_bit_cast(float, __builtin_amdgcn_update_dpp(0, __builtin_bit_cast(int, v), CTRL, 0xf, 0xf, false)); }
__device__ __forceinline__ float max8(float v) {
    v = fmaxf(v, dpp_f<0xB1>(v)); v = fmaxf(v, dpp_f<0x4E>(v)); return fmaxf(v, dpp_f<0x141>(v)); }
__device__ __forceinline__ void p9_router(Frame& F) {
    const float* X1 = (const float*)(F.ws() + WS_X1); f16* HX2 = (f16*)(F.ws() + WS_HX2);
    const float* g2 = F.in[7]; const float* rbias = F.in[18];
    const f16* RWH = (const f16*)(F.ws() + WS_RWT); const f16* RWL = RWH + NE * DM;
    int* EIDX = (int*)(F.ws() + WS_EIDX); float* EW = (float*)(F.ws() + WS_EW); int* CNT = (int*)(F.ws() + WS_CNT);
    LAS float* RED = (LAS float*)F.lds; LAS float* LOG = (LAS float*)(F.lds + 32768); LAS float* PART = (LAS float*)(F.lds + 36864); LAS int* lcnt = (LAS int*)(F.lds + 37888);
    LAS float* C1 = (LAS float*)(F.lds + 40960); LAS float* C2 = (LAS float*)(F.lds + 49152);
    const int r = F.lane & 15, q = F.lane >> 4, w = F.wave;
    typedef unsigned int v4u_t __attribute__((__vector_size__(16)));
    const auto rw_rs = __builtin_amdgcn_make_buffer_rsrc((void*)RWH, (short)0, (int)(2 * NE * DM * 2), 0x00020000);
    const auto x_rs = __builtin_amdgcn_make_buffer_rsrc((void*)X1, (short)0, (int)(NTOK * DM * 4), 0x00020000);
    const auto h_rs = __builtin_amdgcn_make_buffer_rsrc((void*)HX2, (short)0, (int)(NTOK * DM * 2), 0x00020000);
    const int rwo = F.lane * 16, rws = w * 32768;
    for (int u = F.vcu; u < 512; u += F.G) {
        if (F.tid < 64) lcnt[F.tid] = 0;
        const int row = u * 16 + r; const int kb = 256 * w + 8 * q;
        const float* mod = (const float*)(F.ws() + WS_MOD) + ((u * 16) >> 12) * 12288;
        const int xo = (row * DM + kb) * 4, ho = (row * DM + kb) * 2;
        struct KS { f16x8 bh[4], bl[4]; };
#define P9_LOAD(S_, ks_) do { \
            _Pragma("unroll") for (int nt = 0; nt < 4; ++nt) { S_.bh[nt] = __builtin_bit_cast(f16x8, __builtin_amdgcn_raw_buffer_load_b128(rw_rs, rwo, rws + (ks_) * 4096 + nt * 1024, 0)); \
                S_.bl[nt] = __builtin_bit_cast(f16x8, __builtin_amdgcn_raw_buffer_load_b128(rw_rs, rwo, rws + NE * DM * 2 + (ks_) * 4096 + nt * 1024, 0)); } } while (0)
        f32x4 xa[8], xb[8];
#pragma unroll
        for (int ks = 0; ks < 8; ++ks) { xa[ks] = __builtin_bit_cast(f32x4, __builtin_amdgcn_raw_buffer_load_b128(x_rs, xo + 128 * ks, 0, 0)); xb[ks] = __builtin_bit_cast(f32x4, __builtin_amdgcn_raw_buffer_load_b128(x_rs, xo + 128 * ks + 16, 0, 0)); }
        {   const int c = 4 * F.tid; const f32x4 g = *(const f32x4*)(g2 + c), sh = *(const f32x4*)(mod + 3 * 2048 + c), sc = *(const f32x4*)(mod + 4 * 2048 + c);
            *(LAS f32x4*)(C1 + c) = g * (sc + 1.0f); *(LAS f32x4*)(C2 + c) = sh; }
        KS A, B; P9_LOAD(A, 0); P9_LOAD(B, 1);
        float ss = 0.f;
#pragma unroll
        for (int ks = 0; ks < 8; ++ks) ss += (xa[ks].x * xa[ks].x + xa[ks].y * xa[ks].y) + (xa[ks].z * xa[ks].z + xa[ks].w * xa[ks].w) + (xb[ks].x * xb[ks].x + xb[ks].y * xb[ks].y) + (xb[ks].z * xb[ks].z + xb[ks].w * xb[ks].w);
        ss += __shfl_xor(ss, 16); ss += __shfl_xor(ss, 32);
        if (q == 0) PART[w * 16 + r] = ss;
        __syncthreads();
        float tot = 0.f;
#pragma unroll
        for (int ww = 0; ww < 8; ++ww) tot += PART[ww * 16 + r];
        const float rstd = 1.0f / sqrtf(tot * (1.0f / DM) + EPS);
        f32x4 am[4], al[4];
#pragma unroll
        for (int nt = 0; nt < 4; ++nt) { am[nt] = (f32x4){0.f, 0.f, 0.f, 0.f}; al[nt] = am[nt]; }
#define P9_STEP(S_, ks_) do { const int col_ = kb + 32 * (ks_); \
            const f32x4 c1a_ = *(const LAS f32x4*)(C1 + col_), c1b_ = *(const LAS f32x4*)(C1 + col_ + 4), c2a_ = *(const LAS f32x4*)(C2 + col_), c2b_ = *(const LAS f32x4*)(C2 + col_ + 4); \
            const f32x4 ha = (xa[ks_] * rstd) * c1a_ + c2a_, hb = (xb[ks_] * rstd) * c1b_ + c2b_; f16x8 hi, lo; \
            hi[0] = (f16)ha.x; hi[1] = (f16)ha.y; hi[2] = (f16)ha.z; hi[3] = (f16)ha.w; hi[4] = (f16)hb.x; hi[5] = (f16)hb.y; hi[6] = (f16)hb.z; hi[7] = (f16)hb.w; \
            lo[0] = (f16)((ha.x - (float)hi[0]) * 2048.0f); lo[1] = (f16)((ha.y - (float)hi[1]) * 2048.0f); lo[2] = (f16)((ha.z - (float)hi[2]) * 2048.0f); lo[3] = (f16)((ha.w - (float)hi[3]) * 2048.0f); \
            lo[4] = (f16)((hb.x - (float)hi[4]) * 2048.0f); lo[5] = (f16)((hb.y - (float)hi[5]) * 2048.0f); lo[6] = (f16)((hb.z - (float)hi[6]) * 2048.0f); lo[7] = (f16)((hb.w - (float)hi[7]) * 2048.0f); \
            __builtin_amdgcn_raw_buffer_store_b128(__builtin_bit_cast(v4u_t, hi), h_rs, ho + 64 * (ks_), 0, 0); \
            _Pragma("unroll") for (int nt = 0; nt < 4; ++nt) { am[nt] = __builtin_amdgcn_mfma_f32_16x16x32_f16(hi, S_.bh[nt], am[nt], 0, 0, 0); al[nt] = __builtin_amdgcn_mfma_f32_16x16x32_f16(lo, S_.bh[nt], al[nt], 0, 0, 0); \
                al[nt] = __builtin_amdgcn_mfma_f32_16x16x32_f16(hi, S_.bl[nt], al[nt], 0, 0, 0); } } while (0)
        P9_STEP(A, 0); FENCE(); P9_LOAD(A, 2); P9_STEP(B, 1); FENCE(); P9_LOAD(B, 3); P9_STEP(A, 2); FENCE(); P9_LOAD(A, 4); P9_STEP(B, 3); FENCE();
        P9_LOAD(B, 5); P9_STEP(A, 4); FENCE(); P9_LOAD(A, 6); P9_STEP(B, 5); FENCE(); P9_LOAD(B, 7); P9_STEP(A, 6); FENCE(); P9_STEP(B, 7); FENCE();
#undef P9_LOAD
#undef P9_STEP
#pragma unroll
        for (int nt = 0; nt < 4; ++nt)
#pragma unroll
            for (int rg = 0; rg < 4; ++rg) RED[(w * 16 + 4 * q + rg) * 64 + 16 * nt + r] = am[nt][rg] + al[nt][rg] * (1.0f / 2048.0f);
        __syncthreads();
#pragma unroll
        for (int o2 = 0; o2 < 2; ++o2) { const int o = F.tid + 512 * o2; float sacc = 0.f;
#pragma unroll
            for (int ww = 0; ww < 8; ++ww) sacc += RED[ww * 1024 + o];
            LOG[o] = sacc; }
        __syncthreads();
#pragma unroll 1
        for (int rr = 0; rr < 2; ++rr) { const int rl = 2 * w + rr, trow = u * 16 + rl;
            const float logit = LOG[rl * 64 + F.lane];
            const float s = 1.0f / (1.0f + expf(-logit)); const float sel = s + rbias[F.lane];
            const float m1 = max8(sel);
            const unsigned long long bm = __ballot(sel == m1); const int gbase = F.lane & ~7; const unsigned gb = (unsigned)(bm >> gbase) & 0xffu; const int first = gbase + __builtin_ctz(gb);
            const float m2 = max8((F.lane == first) ? -INFINITY : sel);
            const float gs = m1 + m2; const int myg = F.lane >> 3; int beat = 0;
#pragma unroll
            for (int g = 0; g < 8; ++g) { const float og = __builtin_bit_cast(float, __builtin_amdgcn_readlane(__builtin_bit_cast(int, gs), g * 8)); beat += (og > gs || (og == gs && g < myg)) ? 1 : 0; }
            const float cand = (beat < 4) ? sel : -INFINITY; int rank = 0;
#pragma unroll 8
            for (int e = 0; e < NE; ++e) { const float oc = __builtin_bit_cast(float, __builtin_amdgcn_readlane(__builtin_bit_cast(int, cand), e)); rank += (oc > cand) ? 1 : 0; }
            unsigned long long mask = __ballot(rank < TOPK && beat < 4);
            if (__builtin_popcountll(mask) != TOPK) { rank = 0;
#pragma unroll 8
                for (int e = 0; e < NE; ++e) { const float oc = __builtin_bit_cast(float, __builtin_amdgcn_readlane(__builtin_bit_cast(int, cand), e)); rank += (oc > cand || (oc == cand && e < F.lane)) ? 1 : 0; }
                mask = __ballot(rank < TOPK && beat < 4); }
            const bool chosen = (mask >> F.lane) & 1ull;
            const int slot = (int)__builtin_amdgcn_mbcnt_hi((unsigned)(mask >> 32), __builtin_amdgcn_mbcnt_lo((unsigned)mask, 0u));
            float wsum = 0.f; { unsigned long long mm = mask;
#pragma unroll
                for (int i = 0; i < TOPK; ++i) { const int l = __builtin_ctzll(mm); mm &= mm - 1ull; wsum += __builtin_bit_cast(float, __builtin_amdgcn_readlane(__builtin_bit_cast(int, s), l)); } }
            if (chosen) { EIDX[trow * 8 + slot] = F.lane; EW[trow * 8 + slot] = s / wsum * 2.5f; __hip_atomic_fetch_add(&lcnt[F.lane], 1, __ATOMIC_RELAXED, __HIP_MEMORY_SCOPE_WORKGROUP); }
        }
        __syncthreads();
        if (F.tid < 64) CNT[u * 64 + F.tid] = lcnt[F.tid];
        __syncthreads();
    }
}
__device__ __forceinline__ void p10_lists(Frame& F) {
    LAS int* pre = (LAS int*)(F.lds);
    LAS int* tot = pre + 128; LAS int* rb = pre + 256; LAS int* lfill = pre + 384;
    const int* CNT = (const int*)(F.ws() + WS_CNT);
    const int* EIDX = (const int*)(F.ws() + WS_EIDX); const float* EW = (const float*)(F.ws() + WS_EW);
    int* TILEE = (int*)(F.ws() + WS_TILEE); int* ROWTOK = (int*)(F.ws() + WS_ROWTOK); int* ROWDST = (int*)(F.ws() + WS_ROWDST); float* ROWW = (float*)(F.ws() + WS_ROWW);
    const int u1 = F.vcu, u2 = F.vcu + F.G;
    const int myk = (F.tid >> 7) & 1, myu = myk ? u2 : u1; const bool has = F.tid < 256 && myu < 512;
    const int myi = myu * 128 + (F.tid & 127); int mye = 0; float myw = 0.f; if (has) { mye = EIDX[myi]; myw = EW[myi]; }
    if (F.tid < 128) lfill[F.tid] = 0;
    {
        LAS int* segs = pre + 512;
        const int e = F.tid & 63, seg = F.tid >> 6; int run = 0, q1 = 0, q2 = 0;
        { int cv[64];
#pragma unroll
            for (int j = 0; j < 64; ++j) cv[j] = CNT[(seg * 64 + j) * 64 + e];
#pragma unroll
            for (int j = 0; j < 64; ++j) { const int uu = seg * 64 + j; if (uu == u1) q1 = run; if (uu == u2) q2 = run; run += cv[j]; } }
        segs[seg * 64 + e] = run; if ((u1 >> 6) == seg) segs[512 + e] = q1; if ((u2 >> 6) == seg) segs[576 + e] = q2;
        __syncthreads();
        if (F.tid < 64) { int r2 = 0, p1 = 0, p2 = 0;
#pragma unroll
            for (int sg = 0; sg < 8; ++sg) { if (sg == (u1 >> 6)) p1 = r2 + segs[512 + e]; if (sg == (u2 >> 6)) p2 = r2 + segs[576 + e]; r2 += segs[sg * 64 + e]; }
            pre[e] = p1; pre[64 + e] = p2; tot[e] = r2;
            const int nt = (r2 + 255) >> 8; int inc = nt;
#pragma unroll
            for (int d = 1; d < 64; d <<= 1) { const int o = __shfl_up(inc, d); if (e >= d) inc += o; }
            const int first = inc - nt, all = __shfl(inc, 63);
            rb[e] = first * 256; if (e == 0) { tot[NE] = NTOK; rb[NE] = all * 256; rb[NE1] = (all + NTOK / 256) * 256; }
            if (F.vcu == 0) { for (int j = 0; j < nt; ++j) { TILEE[first + j] = e; TILEE[512 + first + j] = (j + 1 < nt) ? 256 : (r2 - 256 * j); }
                if (e < NTOK / 256) { TILEE[all + e] = NE; TILEE[512 + all + e] = 256; }
                if (e == 0) TILEE[511] = all + NTOK / 256; } }
    }
    __syncthreads();
    if (has) { const int pos = pre[myk * 64 + mye] + __hip_atomic_fetch_add(&lfill[myk * 64 + mye], 1, __ATOMIC_RELAXED, __HIP_MEMORY_SCOPE_WORKGROUP);
        const int row = rb[mye] + pos; ROWTOK[row] = myi >> 3; ROWDST[(myi >> 3) * NSLOT + (myi & 7)] = row; ROWW[row] = myw; }
    else if (F.tid >= 256 && F.tid < 288) { const int u = (F.tid & 16) ? u2 : u1; if (u < 512) { const int t = u * 16 + (F.tid & 15); const int row = rb[NE] + t; ROWTOK[row] = t; ROWDST[t * NSLOT + 8] = row; ROWW[row] = 1.0f; } }
    if (F.vcu < NE1) { const int e = F.vcu; const int lo = rb[e] + tot[e], hi = rb[e + 1]; for (int r = lo + F.tid; r < hi; r += 512) { ROWTOK[r] = 0; ROWW[r] = 0.f; } }
}
struct MoeSched { int G, c, nN, K, gather; const int* TILEE; const int* ROWTOK; const char* Bt; size_t bstride_e;
    __device__ __forceinline__ bool next(int i, g8::Unit& u, const int (&R)[2], const int (&C)[2]) const {
        const int ntile = __builtin_amdgcn_readfirstlane(TILEE[511]), total = ntile * nN, per = (total + 7) >> 3, x = c & 7, lc = c >> 3, li = i * (G >> 3) + lc;
        if (li >= per) return false; const int idx = x * per + li; if (idx >= total) return false;
        const int j = idx / nN, pn = idx % nN, e = __builtin_amdgcn_readfirstlane(TILEE[j]);
#pragma unroll
        for (int h = 0; h < 2; ++h)
#pragma unroll
            for (int k = 0; k < 2; ++k) { const int r = j * 256 + h * 128 + R[k]; const int src = gather ? ROWTOK[r] : r; u.ao[h][k] = (unsigned)(src * K + C[k]) * 2u; }
        u.B = Bt + (size_t)e * bstride_e + (size_t)pn * 256 * K * 2; u.row0 = j * 256; u.pn = pn; u.aux = e; u.full = __builtin_amdgcn_readfirstlane(TILEE[512 + j]) > 128; return true; } };
struct EpiHid {
    static constexpr bool PERM = true;
    f16* HID;
    struct Pre {}; __device__ __forceinline__ Pre prefetch(const g8::Unit&, int, int) const { return Pre{}; }
    __device__ __forceinline__ void operator()(const f32x4 (&acc)[2][2][4][2], const g8::Unit& u, int wr, int wc, int fr, int fq, const Pre&) const {
        const int row0 = u.row0 + wr * 64 + fr, col0 = u.pn * 128 + wc * 32 + 8 * fq;
#pragma unroll
        for (int ai = 0; ai < 2; ++ai)
#pragma unroll
            for (int m = 0; m < 4; ++m) { const f32x4 a0 = acc[ai][0][m][0], a1 = acc[ai][0][m][1], b0 = acc[ai][1][m][0], b1 = acc[ai][1][m][1];
                u32x4 w; w.x = pkh(silu_f(a0[0]) * b0[0], silu_f(a0[1]) * b0[1]); w.y = pkh(silu_f(a0[2]) * b0[2], silu_f(a0[3]) * b0[3]);
                w.z = pkh(silu_f(a1[0]) * b1[0], silu_f(a1[1]) * b1[1]); w.w = pkh(silu_f(a1[2]) * b1[2], silu_f(a1[3]) * b1[3]);
                *(u32x4*)(HID + (size_t)(row0 + ai * 128 + m * 16) * EH + col0) = w; }
    }
};
constexpr float YS_SCALE = 16.0f;
struct EpiYs {
    static constexpr bool PERM = true;
    unsigned char* YS; const float* ROWW;
    struct Pre { float w[2]; };
    __device__ __forceinline__ Pre prefetch(const g8::Unit& u, int wr, int lane) const { Pre p; p.w[0] = ROWW[u.row0 + wr * 64 + lane]; p.w[1] = ROWW[u.row0 + 128 + wr * 64 + lane]; return p; }
    __device__ __forceinline__ void operator()(const f32x4 (&acc)[2][2][4][2], const g8::Unit& u, int wr, int wc, int fr, int fq, const Pre& pre) const {
        unsigned char* base = YS + (size_t)(u.row0 + wr * 64 + fr) * DM + u.pn * 256 + wc * 64 + fq * 16;
#pragma unroll
        for (int ai = 0; ai < 2; ++ai)
#pragma unroll
            for (int m = 0; m < 4; ++m) { const float w = __shfl(pre.w[ai], m * 16 + fr) * YS_SCALE; u32x4 o;
#pragma unroll
                for (int bj = 0; bj < 2; ++bj) { const f32x4 a0 = acc[ai][bj][m][0] * w, a1 = acc[ai][bj][m][1] * w;
                    int d0 = __builtin_amdgcn_cvt_pk_fp8_f32(a0[0], a0[1], 0, false); d0 = __builtin_amdgcn_cvt_pk_fp8_f32(a0[2], a0[3], d0, true);
                    int d1 = __builtin_amdgcn_cvt_pk_fp8_f32(a1[0], a1[1], 0, false); d1 = __builtin_amdgcn_cvt_pk_fp8_f32(a1[2], a1[3], d1, true);
                    if (bj == 0) { o.x = (unsigned)d0; o.y = (unsigned)d1; } else { o.z = (unsigned)d0; o.w = (unsigned)d1; } }
                *(u32x4*)(base + (size_t)(ai * 128 + m * 16) * DM) = o; }
    }
};
__device__ __forceinline__ void p13_combine(Frame& F) {
    const int gw = F.vcu * NWAVES + F.wave, NGW = F.G * NWAVES;
    const float* X1 = (const float*)(F.ws() + WS_X1); const unsigned char* YS = (const unsigned char*)(F.ws() + WS_YS); const float* fg = F.in[25]; float* outp = F.out();
    const int* INV = (const int*)(F.ws() + WS_ROWDST);
    const unsigned char* yb = YS + 16 * F.lane;
    const int nc0 = 256 * (F.lane >> 4) + 32 * ((F.lane >> 2) & 3) + 8 * (F.lane & 3);
    int ninv = (F.lane < NSLOT && gw < NTOK) ? INV[gw * NSLOT + F.lane] : 0;
    for (int row = gw; row < NTOK; row += NGW) {
        const float* g2 = (const float*)(F.ws() + WS_MOD) + (row >> 12) * 12288 + 5 * 2048;
        const float* xrow = X1 + (size_t)row * DM + nc0;
        const int myinv = ninv; { const int nrow = row + NGW; ninv = (F.lane < NSLOT && nrow < NTOK) ? INV[nrow * NSLOT + F.lane] : 0; }
        f32x4 a[2][2][2];
#pragma unroll
        for (int j = 0; j < 2; ++j)
#pragma unroll
            for (int g = 0; g < 2; ++g) { a[j][g][0] = (f32x4){0.f, 0.f, 0.f, 0.f}; a[j][g][1] = a[j][g][0]; }
        u32x4 y[3][2];
#define P13_LOAD(buf_, sl_) do { const int r_ = __builtin_amdgcn_readlane(myinv, (sl_)); \
            _Pragma("unroll") for (int j = 0; j < 2; ++j) y[buf_][j] = __builtin_nontemporal_load((const u32x4*)(yb + (size_t)r_ * DM + 1024 * j)); } while (0)
        P13_LOAD(0, 0); P13_LOAD(1, 1); P13_LOAD(2, 2);
        f32x4 xv[2][2][2];
#pragma unroll
        for (int j = 0; j < 2; ++j)
#pragma unroll
            for (int g = 0; g < 2; ++g) { xv[j][g][0] = *(const f32x4*)(xrow + 1024 * j + 128 * g); xv[j][g][1] = *(const f32x4*)(xrow + 1024 * j + 128 * g + 4); }
        FENCE();
#pragma unroll
        for (int sl = 0; sl < NSLOT; ++sl) {
#pragma unroll
            for (int j = 0; j < 2; ++j) { const u32x4 yy = y[sl % 3][j];
#pragma unroll
                for (int g = 0; g < 2; ++g) { const int d0 = (int)(g ? yy.z : yy.x), d1 = (int)(g ? yy.w : yy.y);
                    const f32x2 p0 = __builtin_amdgcn_cvt_pk_f32_fp8(d0, false), p1 = __builtin_amdgcn_cvt_pk_f32_fp8(d0, true), p2 = __builtin_amdgcn_cvt_pk_f32_fp8(d1, false), p3 = __builtin_amdgcn_cvt_pk_f32_fp8(d1, true);
                    a[j][g][0].x += p0.x; a[j][g][0].y += p0.y; a[j][g][0].z += p1.x; a[j][g][0].w += p1.y; a[j][g][1].x += p2.x; a[j][g][1].y += p2.y; a[j][g][1].z += p3.x; a[j][g][1].w += p3.y;
                    asm volatile("" : "+v"(a[j][g][0]), "+v"(a[j][g][1])); } }
            FENCE();
            if (sl + 3 < NSLOT) { P13_LOAD(sl % 3, sl + 3); FENCE(); } }
#undef P13_LOAD
        float ss = 0.f; f32x4 v[2][2][2];
#pragma unroll
        for (int j = 0; j < 2; ++j)
#pragma unroll
            for (int g = 0; g < 2; ++g) { const int col = nc0 + 1024 * j + 128 * g;
                const f32x4 ga = *(const f32x4*)(g2 + col) * (1.0f / YS_SCALE), gb = *(const f32x4*)(g2 + col + 4) * (1.0f / YS_SCALE);
                v[j][g][0] = xv[j][g][0] + ga * a[j][g][0]; v[j][g][1] = xv[j][g][1] + gb * a[j][g][1];
#pragma unroll
                for (int k = 0; k < 2; ++k) { const f32x4 t = v[j][g][k]; ss += (t.x * t.x + t.y * t.y) + (t.z * t.z + t.w * t.w); } }
        const float rstd = 1.0f / sqrtf(wave_sum(ss) * (1.0f / DM) + EPS);
#pragma unroll
        for (int j = 0; j < 2; ++j)
#pragma unroll
            for (int g = 0; g < 2; ++g) { const int col = nc0 + 1024 * j + 128 * g; const f32x4 ga = *(const f32x4*)(fg + col), gb = *(const f32x4*)(fg + col + 4);
                __builtin_nontemporal_store(v[j][g][0] * rstd * ga, (f32x4*)(outp + (size_t)row * DM + col)); __builtin_nontemporal_store(v[j][g][1] * rstd * gb, (f32x4*)(outp + (size_t)row * DM + col + 4)); }
    }
}

struct Args { const float* in[26]; float* out; unsigned char* ws; int ph_lo, ph_hi, li, pad; };
__global__ void __launch_bounds__(NWAVES * 64, 2) fwd(Args args) {
    extern __shared__ __attribute__((aligned(16))) unsigned char lds[];
    Frame F;
    F.lds = (LAS unsigned char*)lds;
    F.tid = threadIdx.x; F.lane = F.tid & 63; F.wave = __builtin_amdgcn_readfirstlane(F.tid >> 6);
    F.G = gridDim.x; { const int bx = blockIdx.x; F.vcu = (bx & 7) * (F.G >> 3) + (bx >> 3); }
    F.in.base = (LAS const unsigned*)(F.lds + LDSCTL_OFF + 512);
    {
        const unsigned* ka = (const unsigned*)__builtin_amdgcn_kernarg_segment_ptr();
        if (F.tid < 128) ((LAS unsigned*)(F.lds + LDSCTL_OFF))[F.tid] = 0u;
        if (F.tid >= 128 && F.tid < 128 + 60) ((LAS unsigned*)(F.lds + LDSCTL_OFF + 512))[F.tid - 128] = ka[F.tid - 128];
    }
    __syncthreads();
    const int ph_lo = (int)__builtin_amdgcn_readfirstlane(((LAS const unsigned*)(F.lds + LDSCTL_OFF + 512))[56]), ph_hi = (int)__builtin_amdgcn_readfirstlane(((LAS const unsigned*)(F.lds + LDSCTL_OFF + 512))[57]);
    if (MK_N_LAUNCHES == 1) xcd_barrier_post((unsigned*)(F.ws() + WS_CTL) + CW_BAR);
    const int lo = ph_lo, hi = ph_hi;
#define REFRESH() do { int t_ = threadIdx.x; asm volatile("" : "+v"(t_)); F.tid = t_; F.lane = t_ & 63; F.wave = __builtin_amdgcn_readfirstlane(t_ >> 6); } while (0)
#define IN(k) (lo <= (k) && (k) < hi)
#define SEAM(k) do { if (IN(k) && IN((k) + 1)) { XcdBarrier bar_; bar_.bar = (unsigned*)(F.ws() + WS_CTL) + CW_BAR; bar_.st = (volatile LAS unsigned*)((LAS unsigned char*)lds + MISC_OFF) + 8; xcd_barrier(bar_); } } while (0)
    const int cblk = (int)blockIdx.x;
    if (IN(0)) for (int rep_ = 0; rep_ <= ((PROBE_DUP >> 0) & 1); ++rep_) { if (rep_) __syncthreads(); REFRESH(); p0_prologue(F); } SEAM(0);
    if (IN(1)) for (int rep_ = 0; rep_ <= ((PROBE_DUP >> 1) & 1); ++rep_) { if (rep_) __syncthreads(); REFRESH(); p1_norm(F); } SEAM(1);
    if (IN(2)) for (int rep_ = 0; rep_ <= ((PROBE_DUP >> 2) & 1); ++rep_) { if (rep_) __syncthreads(); REFRESH(); InSched S{F.G, cblk, (const char*)(F.ws() + WS_WINT), 0, 1000};
        EpiIn E{(f16*)(F.ws() + WS_PBUF), (f16*)(F.ws() + WS_CK), (f16*)(F.ws() + WS_CV), (float*)(F.ws() + WS_VSTAT), (const float*)(F.ws() + WS_ROPE)};
        const int grp = (cblk >> 3) & 3;
        for (int part = 0; part < 2; ++part) {
            S.ulo = part ? grp : 0; S.uhi = part ? 1000 : grp;
            if (S.uhi > S.ulo) g8::gemm_phase<EpiIn, InSched, true>(F.lds + RING_OFF, (const char*)(F.ws() + WS_HX), DM, S, E);
            if (part == 0) { __syncthreads(); REFRESH(); if (F.vcu < 64) { p2_ctx_unit(F, F.vcu); __syncthreads(); } p2_expert_copies(F); __syncthreads(); } } } SEAM(2);
    if (IN(4)) for (int rep_ = 0; rep_ <= ((PROBE_DUP >> 4) & 1); ++rep_) { if (rep_) __syncthreads(); REFRESH(); p4_fast(F); } SEAM(4);
    if (IN(5)) for (int rep_ = 0; rep_ <= ((PROBE_DUP >> 5) & 1); ++rep_) { if (rep_) __syncthreads(); REFRESH(); p5_naive(F); } SEAM(5);
    if (IN(6)) for (int rep_ = 0; rep_ <= ((PROBE_DUP >> 6) & 1); ++rep_) { if (rep_) __syncthreads(); REFRESH(); p6_fast(F); } SEAM(6);
    if (IN(8)) for (int rep_ = 0; rep_ <= ((PROBE_DUP >> 8) & 1); ++rep_) { if (rep_) __syncthreads(); REFRESH(); DenseSched S{F.G, cblk, 32, 8, DM, (const char*)(F.ws() + WS_WOUTT)}; EpiX1 E{F.in[0], (const float*)(F.ws() + WS_MOD), (float*)(F.ws() + WS_X1)};
        g8::gemm_phase<EpiX1, DenseSched, true>(F.lds + RING_OFF, (const char*)(F.ws() + WS_AR), DM, S, E); } SEAM(8);
    if (IN(9)) for (int rep_ = 0; rep_ <= ((PROBE_DUP >> 9) & 1); ++rep_) { if (rep_) __syncthreads(); REFRESH(); p9_router(F); } SEAM(9);
    if (IN(10)) for (int rep_ = 0; rep_ <= ((PROBE_DUP >> 10) & 1); ++rep_) { if (rep_) __syncthreads(); REFRESH(); p10_lists(F); } SEAM(10);
    if (IN(11)) for (int rep_ = 0; rep_ <= ((PROBE_DUP >> 11) & 1); ++rep_) { if (rep_) __syncthreads(); REFRESH(); MoeSched S{F.G, cblk, 4, DM, 1, (const int*)(F.ws() + WS_TILEE), (const int*)(F.ws() + WS_ROWTOK), (const char*)(F.ws() + WS_W13T), (size_t)1024 * DM * 2};
        EpiHid E{(f16*)(F.ws() + WS_HID)};
        g8::gemm_phase<EpiHid, MoeSched, true>(F.lds + RING_OFF, (const char*)(F.ws() + WS_HX2), DM, S, E); } SEAM(11);
    if (IN(12)) for (int rep_ = 0; rep_ <= ((PROBE_DUP >> 12) & 1); ++rep_) { if (rep_) __syncthreads(); REFRESH(); MoeSched S{F.G, cblk, 8, EH, 0, (const int*)(F.ws() + WS_TILEE), (const int*)(F.ws() + WS_ROWTOK), (const char*)(F.ws() + WS_W2T), (size_t)DM * EH * 2};
        EpiYs E{(unsigned char*)(F.ws() + WS_YS), (const float*)(F.ws() + WS_ROWW)};
        g8::gemm_phase<EpiYs, MoeSched, true>(F.lds + RING_OFF, (const char*)(F.ws() + WS_HID), EH, S, E); } SEAM(12);
    if (IN(13)) for (int rep_ = 0; rep_ <= ((PROBE_DUP >> 13) & 1); ++rep_) { if (rep_) __syncthreads(); REFRESH(); p13_combine(F); }
#undef IN
#undef SEAM
}

extern "C" void kernel_launch(void* const* d_in, const int* in_sizes, int n_in, void* d_out, int out_size, void* d_ws, size_t ws_size, hipStream_t stream) {
    static int grid = 0;
    if (grid == 0) {
        if (n_in != 26 || in_sizes[0] != NTOK * DM || out_size != NTOK * DM || ws_size < WS_END) {
            fprintf(stderr, "kernel_launch: unexpected problem (n_in %d, in0 %d, out %d, ws %zu); nothing launched\n", n_in, n_in > 0 ? in_sizes[0] : -1, out_size, ws_size); grid = -1; return; }
        int dev = 0, cus = 0, per_cu = 0;
        if (hipGetDevice(&dev) != hipSuccess || hipDeviceGetAttribute(&cus, hipDeviceAttributeMultiprocessorCount, dev) != hipSuccess) { grid = -1; return; }
        if (hipFuncSetAttribute((const void*)fwd, hipFuncAttributeMaxDynamicSharedMemorySize, LDS_BYTES) != hipSuccess) { fprintf(stderr, "kernel_launch: hipFuncSetAttribute failed\n"); grid = -1; return; }
        if (hipOccupancyMaxActiveBlocksPerMultiprocessor(&per_cu, (const void*)fwd, NWAVES * 64, LDS_BYTES) != hipSuccess || per_cu < 1)
            fprintf(stderr, "kernel_launch: occupancy query reports %d workgroups per CU\n", per_cu);
        (void)hipGetLastError();
        grid = cus & ~7;
    }
    if (grid < 0) return;
    if (hipMemsetAsync((char*)d_ws + WS_CTL, 0, CTL_ZERO_BYTES, stream) != hipSuccess) return;
    Args a{};
    for (int i = 0; i < 26; ++i) a.in[i] = (const float*)d_in[i];
    a.out = (float*)d_out; a.ws = (unsigned char*)d_ws;
    if (MK_N_LAUNCHES == 1) { a.ph_lo = 0; a.ph_hi = NPHASE; a.li = 0; hipLaunchKernelGGL(fwd, dim3(grid), dim3(NWAVES * 64), LDS_BYTES, stream, a); }
    else { for (int li = 0; li < NPHASE; ++li) { a.ph_lo = li; a.ph_hi = li + 1; a.li = li; hipLaunchKernelGGL(fwd, dim3(grid), dim3(NWAVES * 64), LDS_BYTES, stream, a); } }
}
```

```cpp
#include <hip/hip_runtime.h>
#include <cstdio>
#include <cstdint>

#ifndef PROBE_DUP
#define PROBE_DUP 0
#endif
#ifndef MK_N_LAUNCHES
#define MK_N_LAUNCHES 1
#endif

#define LAS __attribute__((address_space(3)))
#define GAS __attribute__((address_space(1)))
typedef _Float16 f16;
typedef _Float16 f16x8 __attribute__((ext_vector_type(8)));
typedef _Float16 f16x4 __attribute__((ext_vector_type(4)));
typedef _Float16 f16x2 __attribute__((ext_vector_type(2)));
typedef int i32x4 __attribute__((ext_vector_type(4)));
typedef int i32x8 __attribute__((ext_vector_type(8)));
typedef float f32x4 __attribute__((ext_vector_type(4)));
typedef float f32x2 __attribute__((ext_vector_type(2)));
typedef unsigned u32x4 __attribute__((ext_vector_type(4)));
typedef unsigned u32x2 __attribute__((ext_vector_type(2)));
typedef GAS unsigned gu32;

constexpr int DM = 2048, NB = 2, SEQ = 4096, NTOK = NB * SEQ, CTXL = 256, NCTX = NB * CTXL, CHK = 128, NCH = SEQ / CHK;
constexpr int AW = 1024, INC = 6144, NH = 8, HD = 128;
constexpr int NE = 64, NE1 = 65, TOPK = 8, EH = 512, NSLOT = 9;
constexpr int NROWS_IN = NTOK + NCTX;
constexpr int MAXTILES = 360;
constexpr int MAXROWS = MAXTILES * 256;
constexpr float EPS = 1e-6f;
constexpr int NPHASE = 14;
constexpr int NWAVES = 8;

constexpr size_t MiB = 1u << 20;
constexpr size_t WS_CTL = 0, CTL_ZERO_BYTES = 64 * 1024;
constexpr size_t WS_MOD = 1 * MiB;
constexpr size_t WS_ROPE = WS_MOD + 256 * 1024;
constexpr size_t WS_VSTAT = 4 * MiB;
constexpr size_t WS_EIDX = WS_ROPE + 64 * 1024;
constexpr size_t WS_EW = WS_EIDX + 256 * 1024;
constexpr size_t WS_TILEE = WS_EW + 256 * 1024;
constexpr size_t WS_ROWTOK = 2 * MiB;
constexpr size_t WS_ROWDST = WS_ROWTOK + 512 * 1024;
constexpr size_t WS_ROWW = WS_ROWDST + 512 * 1024;
constexpr size_t WS_RWT = 5 * MiB;
constexpr size_t WS_CNT = 5 * MiB + 512 * 1024;
constexpr size_t WS_W13T = 8 * MiB;
constexpr size_t WS_W2T = WS_W13T + 260 * MiB;
constexpr size_t WS_WINT_OLD = WS_W2T + 130 * MiB;
constexpr size_t WS_WOUTT_OLD = WS_WINT_OLD + 24 * MiB;
constexpr size_t WS_WINT = 792 * MiB;
constexpr size_t WS_WOUTT = 784 * MiB;
constexpr size_t WS_X1_OLD = WS_WOUTT_OLD + 8 * MiB;
constexpr size_t WS_HX2_OLD = WS_X1_OLD + 64 * MiB;
constexpr size_t WS_HID_OLD = WS_HX2_OLD + 32 * MiB;
constexpr size_t WS_OVL = WS_HID_OLD + 90 * MiB;
static_assert(WS_OVL == 616 * MiB, "map");
constexpr size_t WS_HX = 818 * MiB;
constexpr size_t WS_CBUF = WS_OVL + 34 * MiB;
constexpr size_t WS_ARAW = WS_CBUF;
constexpr size_t WS_PB = WS_CBUF + 32 * MiB;
constexpr size_t WS_AR = WS_CBUF + 64 * MiB;
constexpr size_t WS_HX2 = WS_AR;
constexpr size_t WS_OUTX = WS_CBUF + 96 * MiB;
constexpr size_t WS_PBUF = WS_OVL + 238 * MiB;
constexpr size_t WS_X1 = WS_PBUF;
constexpr size_t WS_CK = WS_PBUF + 96 * MiB;
constexpr size_t WS_HID = WS_CK;
constexpr size_t WS_CV = WS_CK + 1 * MiB;
constexpr size_t WS_ST = WS_CV + 1 * MiB;
constexpr size_t WS_YS = WS_OVL;
constexpr size_t WS_END = 1024 * MiB;
static_assert(WS_ST + 70 * MiB <= WS_END && WS_YS + 360 * MiB <= WS_END && WS_OUTX + 64 * MiB <= WS_PBUF, "map");
constexpr int CW_BAR = 4096;

constexpr float SH8 = 2.0f, SW2 = 16.0f;
constexpr float SX8 = 8.0f, SW13 = 256.0f;
constexpr int RING_OFF = 0, RING_BYTES = 131072;
constexpr int LDS_BYTES = 147456, TILE_LDS = 131072;
constexpr int LDSCTL_OFF = LDS_BYTES - 1024, MISC_OFF = LDSCTL_OFF + 320;

#define RLX_AGENT __ATOMIC_RELAXED, __HIP_MEMORY_SCOPE_AGENT
#define LDS_WAIT() asm volatile("s_waitcnt lgkmcnt(0)" ::: "memory")
#define FENCE() do { asm volatile("" ::: "memory"); __builtin_amdgcn_sched_barrier(0); } while (0)
#define VM_WAIT() asm volatile("s_waitcnt vmcnt(0)" ::: "memory")

#define XB_TMO      128
#define XB_XCNT(j)  (256  + 64 * (j))
#define XB_XSUB(j)  (1280 + 64 * (j))
#define XB_XGEN(j)  (2304 + 64 * (j))
#define XB_TOP      3328
#define XB_TOPGEN   3392
#define XCD_BAR_WORDS 3456
#define XB_SPIN_CAP (1u << 18)
__device__ __forceinline__ unsigned xb_ld(unsigned* p)              { return __hip_atomic_load(p, __ATOMIC_RELAXED, __HIP_MEMORY_SCOPE_AGENT); }
__device__ __forceinline__ unsigned xb_add(unsigned* p, unsigned v) { return __hip_atomic_fetch_add(p, v, __ATOMIC_RELAXED, __HIP_MEMORY_SCOPE_AGENT); }
__device__ __forceinline__ unsigned xb_xcc_id() { return (unsigned)__builtin_amdgcn_s_getreg((3 << 11) | 20) & 0xFu; }
#define XB_SPIN(cond, bar) do { unsigned _sp = 0; while (cond) { __builtin_amdgcn_s_sleep(1); \
    if ((++_sp & 255u) == 0u) { if (xb_ld(&(bar)[XB_TMO])) break; if (_sp > XB_SPIN_CAP) { atomicAdd(&(bar)[XB_TMO], 1u); break; } } } } while (0)
struct XcdBarrier { unsigned* bar; volatile LAS unsigned* st; };
__device__ __forceinline__ void xcd_barrier_post(unsigned* bar) {
    if (threadIdx.x == 0) (void)xb_add(&bar[XB_XCNT(xb_xcc_id())], 1u);
}
__device__ __forceinline__ void xcd_barrier_complete(unsigned* bar, unsigned x, unsigned& nloc, unsigned& nx) {
    const unsigned G = gridDim.x * gridDim.y * gridDim.z;
    unsigned sum, cnt, mine, sp = 0u;
    for (;;) {
        sum = 0u; cnt = 0u; mine = 0u;
#pragma unroll
        for (unsigned j = 0; j < 16; ++j) { const unsigned c = xb_ld(&bar[XB_XCNT(j)]); sum += c; cnt += (c > 0u) ? 1u : 0u; mine = (j == x) ? c : mine; }
        if (sum == G) break;
        __builtin_amdgcn_s_sleep(1);
        if ((++sp & 255u) == 0u) { if (xb_ld(&bar[XB_TMO])) break; if (sp > XB_SPIN_CAP) { atomicAdd(&bar[XB_TMO], 1u); break; } }
    }
    nloc = mine > 0u ? mine : 1u; nx = cnt > 0u ? cnt : 1u;
}
__device__ __forceinline__ void xcd_barrier(const XcdBarrier& b) {
    asm volatile("s_waitcnt vmcnt(0)" ::: "memory");
    __syncthreads();
    if (threadIdx.x == 0) {
        unsigned* bar = b.bar; const unsigned bx = xb_xcc_id();
        __builtin_amdgcn_s_waitcnt(0);
        unsigned nloc = b.st[0], nx = b.st[1];
        if (nloc == 0u) { xcd_barrier_complete(bar, bx, nloc, nx); b.st[0] = nloc; b.st[1] = nx; }
        const unsigned old = xb_add(&bar[XB_XSUB(bx)], 1u);
        const unsigned gen = old / nloc;
        if (old + 1u == (gen + 1u) * nloc) {
            __builtin_amdgcn_fence(__ATOMIC_RELEASE, "agent");
            asm volatile("s_waitcnt vmcnt(0)" ::: "memory");
            const unsigned og = xb_add(&bar[XB_TOP], 1u);
            const unsigned tg = og / nx;
            if (og + 1u == (tg + 1u) * nx) xb_add(&bar[XB_TOPGEN], 1u);
            else XB_SPIN(xb_ld(&bar[XB_TOPGEN]) == tg, bar);
            __builtin_amdgcn_fence(__ATOMIC_ACQUIRE, "agent");
            xb_add(&bar[XB_XGEN(bx)], 1u);
            asm volatile("s_waitcnt vmcnt(0)" ::: "memory");
        } else {
            XB_SPIN(xb_ld(&bar[XB_XGEN(bx)]) == gen, bar);
            __builtin_amdgcn_fence(__ATOMIC_ACQUIRE, "agent");
            asm volatile("s_waitcnt vmcnt(0)" ::: "memory");
        }
    }
    __syncthreads();
}

namespace g8 {
constexpr int BM = 256, BK = 64, HALF = 128, HTB = HALF * BK * 2, STAGE_BYTES = 8 * HTB, NXCD = 8, WGM = 8;
__host__ __device__ __forceinline__ int lds_byte(int r, int c) { const int st = (r >> 4) * 2 + (c >> 5), rr = r & 15, cc = c & 31, ob = rr * 64 + cc * 2; return st * 1024 + (ob ^ (((ob >> 9) & 1) << 5)); }
__host__ __device__ __forceinline__ void stage_rc(int b, int& R, int& C) { const int st = b / 1024, sb = b % 1024, swz = sb ^ (((sb >> 9) & 1) << 5); R = (st >> 1) * 16 + swz / 64; C = (st & 1) * 32 + (swz % 64) / 2; }
__host__ __device__ __forceinline__ int perm32(int rho) { const int n = rho >> 4, i = rho & 15; return 8 * (i >> 2) + 4 * n + (i & 3); }

struct Unit { unsigned ao[2][2]; const char* B; int row0; int pn; int aux; int full; };

__device__ __forceinline__ bool dense_order(int L, int nM, int nN, int& pm, int& pn) {
    const int nwg = nM * nN; if (L >= nwg) return false;
    int wgid = L; { const int q = nwg / NXCD, r = nwg % NXCD, xcd = wgid % NXCD, off = wgid / NXCD; wgid = (xcd < r ? xcd * (q + 1) : r * (q + 1) + (xcd - r) * q) + off; }
    const int nig = WGM * nN, gid = wgid / nig, fm = gid * WGM, gsz = (nM - fm) < WGM ? (nM - fm) : WGM;
    pm = fm + ((wgid % nig) % gsz); pn = (wgid % nig) / gsz; return true;
}

template <class Epi, class Sched, bool ALIGN_EPI, bool FP8 = false>
__device__ __forceinline__ void gemm_phase(LAS unsigned char* lds, const char* A, const int K, const Sched& S, const Epi& E) {
    int tid = threadIdx.x; asm volatile("" : "+v"(tid));
    const int wid = __builtin_amdgcn_readfirstlane(tid >> 6), lane = tid & 63, wr = wid >> 2, wc = wid & 3, fr = lane & 15, fq = lane >> 4;
    const int nt = K / BK;
    int R[2], C[2]; unsigned voffB[2];
#pragma unroll
    for (int i = 0; i < 2; ++i) { stage_rc(tid * 16 + i * 8192, R[i], C[i]); const int Rb = Epi::PERM ? ((R[i] & ~31) + perm32(R[i] & 31)) : R[i]; voffB[i] = (unsigned)(Rb * K + C[i]) * 2u; }
    const size_t kstep = (size_t)(BK * 2);
    const size_t hstep = (size_t)HALF * K * 2;
    const unsigned ldsw = (unsigned)wid * 1024u;
    const int aoff = lds_byte(wr * 64 + fr, fq * 8), boff = lds_byte(wc * 32 + fr, fq * 8);
#define G8_SA(b, h) (((b) * 2 + (h)) * HTB)
#define G8_SB(b, h) ((4 + (b) * 2 + (h)) * HTB)
#define G8_STAGE_B(bufoff, gbase) do { _Pragma("unroll") for (int _i = 0; _i < 2; ++_i) \
        __builtin_amdgcn_global_load_lds((const unsigned*)((const char*)(gbase) + voffB[_i]), (LAS unsigned*)(lds + (bufoff) + ldsw + _i * 8192), 16, 0, FP8 ? 0 : 1); } while (0)
#define G8_STAGE_A(bufoff, kb, o0, o1) do { \
        __builtin_amdgcn_global_load_lds((const unsigned*)(A + (size_t)(kb) + (o0)), (LAS unsigned*)(lds + (bufoff) + ldsw), 16, 0, 0); \
        __builtin_amdgcn_global_load_lds((const unsigned*)(A + (size_t)(kb) + (o1)), (LAS unsigned*)(lds + (bufoff) + ldsw + 8192), 16, 0, 0); } while (0)
#define G8_LDA(dst, b, h) do { _Pragma("unroll") for (int m = 0; m < 4; ++m) _Pragma("unroll") for (int k = 0; k < 2; ++k) dst[m][k] = *(const LAS f16x8*)(lds + G8_SA(b, h) + aoff + m * 2048 + k * 1024); } while (0)
#define G8_LDB(dst, b, h) do { _Pragma("unroll") for (int n = 0; n < 2; ++n) _Pragma("unroll") for (int k = 0; k < 2; ++k) dst[n][k] = *(const LAS f16x8*)(lds + G8_SB(b, h) + boff + n * 2048 + k * 1024); } while (0)
#define G8_MMA(ai, bj, At, Bt) do { __builtin_amdgcn_s_setprio(1); \
        if constexpr (FP8) { _Pragma("unroll") for (int m = 0; m < 4; ++m) _Pragma("unroll") for (int n = 0; n < 2; ++n) { \
            const i32x8 a8_ = __builtin_shufflevector(__builtin_bit_cast(i32x4, At[m][0]), __builtin_bit_cast(i32x4, At[m][1]), 0, 1, 2, 3, 4, 5, 6, 7); \
            const i32x8 b8_ = __builtin_shufflevector(__builtin_bit_cast(i32x4, Bt[n][0]), __builtin_bit_cast(i32x4, Bt[n][1]), 0, 1, 2, 3, 4, 5, 6, 7); \
            acc[ai][bj][m][n] = __builtin_amdgcn_mfma_scale_f32_16x16x128_f8f6f4(b8_, a8_, acc[ai][bj][m][n], 0, 0, 0, 0, 0, 0); } } \
        else { _Pragma("unroll") for (int m = 0; m < 4; ++m) _Pragma("unroll") for (int n = 0; n < 2; ++n) _Pragma("unroll") for (int k = 0; k < 2; ++k) \
            acc[ai][bj][m][n] = __builtin_amdgcn_mfma_f32_16x16x32_f16(Bt[n][k], At[m][k], acc[ai][bj][m][n], 0, 0, 0); } \
        __builtin_amdgcn_s_setprio(0); } while (0)
#define G8_WAIT_V(n) asm volatile("s_waitcnt vmcnt(" #n ")" ::: "memory")
#define G8_WAIT_L(n) asm volatile("s_waitcnt lgkmcnt(" #n ")" ::: "memory")
#define G8_BAR __builtin_amdgcn_s_barrier()
#define G8_SCHED __builtin_amdgcn_sched_barrier(0)
    Unit cur, nxt; int ui = 0;
    if (!S.next(0, cur, R, C)) return;
    f32x4 acc[2][2][4][2];
#pragma unroll
    for (int a = 0; a < 2; ++a)
#pragma unroll
        for (int b = 0; b < 2; ++b)
#pragma unroll
            for (int m = 0; m < 4; ++m)
#pragma unroll
                for (int n = 0; n < 2; ++n) acc[a][b][m][n] = (f32x4){0.f, 0.f, 0.f, 0.f};
    f16x8 At[4][2], B0[2][2], B1[2][2];
    {
        const char* cB = cur.B;
        G8_STAGE_B(G8_SB(0, 0), cB); G8_STAGE_B(G8_SB(0, 1), cB + hstep); G8_STAGE_A(G8_SA(0, 0), 0, cur.ao[0][0], cur.ao[0][1]); G8_STAGE_A(G8_SA(0, 1), 0, cur.ao[1][0], cur.ao[1][1]);
        if (wr == 1) G8_BAR;
        G8_WAIT_V(2); G8_BAR;
        G8_STAGE_B(G8_SB(1, 0), cB + kstep); G8_STAGE_A(G8_SA(1, 0), kstep, cur.ao[0][0], cur.ao[0][1]); G8_STAGE_B(G8_SB(1, 1), cB + hstep + kstep);
        G8_WAIT_V(6); G8_BAR;
    }
    for (;;) {
        const bool has_next = S.next(ui + 1, nxt, R, C);
        if (!has_next) nxt = cur;
        const char* cB = cur.B; const char* nB = nxt.B;
        const typename Epi::Pre pre = E.prefetch(cur, wr, lane);
        for (int t = 0; t < nt; t += 2) {
            const bool last = (t == nt - 2);
            const size_t ka1 = (size_t)(t + 1) * kstep;
            const size_t ka2 = last ? 0 : (size_t)(t + 2) * kstep, ka3 = ka2 + kstep;
            const unsigned o00 = last ? nxt.ao[0][0] : cur.ao[0][0], o01 = last ? nxt.ao[0][1] : cur.ao[0][1], o10 = last ? nxt.ao[1][0] : cur.ao[1][0], o11 = last ? nxt.ao[1][1] : cur.ao[1][1];
            const char* b2 = last ? nB : cB + (size_t)(t + 2) * kstep; const char* b3 = b2 + kstep;
            G8_LDB(B0, 0, 0); G8_LDB(B1, 0, 1); G8_SCHED; G8_LDA(At, 0, 0); G8_STAGE_A(G8_SA(1, 1), ka1, cur.ao[1][0], cur.ao[1][1]);
            G8_WAIT_V(8); G8_WAIT_L(0); G8_BAR; G8_MMA(0, 0, At, B0); G8_MMA(0, 1, At, B1); G8_BAR; G8_SCHED;
            G8_LDA(At, 0, 1); G8_STAGE_B(G8_SB(0, 0), b2); G8_STAGE_B(G8_SB(0, 1), b2 + hstep); G8_STAGE_A(G8_SA(0, 0), ka2, o00, o01);
            G8_WAIT_V(8); G8_WAIT_L(0); G8_BAR; if (cur.full) { G8_MMA(1, 0, At, B0); G8_MMA(1, 1, At, B1); } G8_BAR; G8_SCHED;
            G8_LDB(B0, 1, 0); G8_LDB(B1, 1, 1); G8_SCHED; G8_LDA(At, 1, 0); G8_STAGE_A(G8_SA(0, 1), ka2, o10, o11);
            G8_WAIT_V(8); G8_WAIT_L(0); G8_BAR; G8_MMA(0, 0, At, B0); G8_MMA(0, 1, At, B1); G8_BAR; G8_SCHED;
            G8_LDA(At, 1, 1); G8_STAGE_B(G8_SB(1, 0), b3); G8_STAGE_B(G8_SB(1, 1), b3 + hstep); G8_STAGE_A(G8_SA(1, 0), ka3, o00, o01);
            G8_WAIT_V(8); G8_WAIT_L(0); G8_BAR; if (cur.full) { G8_MMA(1, 0, At, B0); G8_MMA(1, 1, At, B1); } G8_BAR; G8_SCHED;
        }
        if constexpr (ALIGN_EPI) { if (wr == 0) G8_BAR; }
        E(acc, cur, wr, wc, fr, fq, pre);
        if (!has_next) break;
#pragma unroll
        for (int a = 0; a < 2; ++a)
#pragma unroll
            for (int b = 0; b < 2; ++b)
#pragma unroll
                for (int m = 0; m < 4; ++m)
#pragma unroll
                    for (int n = 0; n < 2; ++n) acc[a][b][m][n] = (f32x4){0.f, 0.f, 0.f, 0.f};
        cur = nxt; ++ui;
        if constexpr (ALIGN_EPI) { if (wr == 1) G8_BAR; }
    }
    G8_WAIT_V(0);
    if constexpr (!ALIGN_EPI) { if (wr == 0) G8_BAR; }
    G8_BAR;
#undef G8_SA
#undef G8_SB
#undef G8_STAGE_A
#undef G8_STAGE_B
#undef G8_LDA
#undef G8_LDB
#undef G8_MMA
#undef G8_WAIT_V
#undef G8_WAIT_L
#undef G8_BAR
#undef G8_SCHED
}

}

struct ArgTable { LAS const unsigned* base;
    __device__ __forceinline__ const float* operator[](int i) const { const unsigned lo = base[2 * i], hi = base[2 * i + 1];
        const GAS float* g = (const GAS float*)(((unsigned long long)(unsigned)__builtin_amdgcn_readfirstlane(hi) << 32) | (unsigned)__builtin_amdgcn_readfirstlane(lo)); return (const float*)g; } };
struct Frame {
    LAS unsigned char* lds;
    int tid, lane, wave, vcu, G;
    ArgTable in;
    __device__ __forceinline__ float* out() const { return (float*)in[26]; }
    __device__ __forceinline__ unsigned char* ws() const { return (unsigned char*)in[27]; }
};
__device__ __forceinline__ float wave_sum(float v) {
#pragma unroll
    for (int o = 1; o < 64; o <<= 1) v += __shfl_xor(v, o);
    return v;
}
__device__ __forceinline__ float fast_sigmoid(float x) { return __builtin_amdgcn_rcpf(1.0f + __expf(-x)); }
__device__ __forceinline__ float silu_f(float x) { return x * fast_sigmoid(x); }
__device__ __forceinline__ float gelu_f(float x) { const float y = 0.7978845608028654f * (x + 0.044715f * x * x * x); return x * fast_sigmoid(2.0f * y); }
__device__ __forceinline__ unsigned pkh(float a, float b) { f16x2 v; v.x = (f16)a; v.y = (f16)b; return __builtin_bit_cast(unsigned, v); }

struct TItem { const float* W; int ldw, k0, srccol0; f16* WT; int ldt, dstrow0; float scale; };
#ifndef COPY_LD_AUX
#define COPY_LD_AUX 19
#endif
__device__ __forceinline__ void titem_load(const TItem& t, f32x4 (&tv)[8], int lane) {
    const float* base = t.W + (size_t)t.k0 * t.ldw + t.srccol0;
    const auto rsrc = __builtin_amdgcn_make_buffer_rsrc((void*)base, (short)0, (int)(64 * t.ldw * 4), 0x00020000);
    const unsigned o0 = ((unsigned)(2 * (lane >> 3)) * (unsigned)t.ldw + 4u * (unsigned)(lane & 7)) * 4u, st = 64u * (unsigned)t.ldw;
#pragma unroll
    for (int i = 0; i < 4; ++i) { tv[2 * i] = __builtin_bit_cast(f32x4, __builtin_amdgcn_raw_buffer_load_b128(rsrc, (int)(o0 + (unsigned)i * st), 0, COPY_LD_AUX));
        tv[2 * i + 1] = __builtin_bit_cast(f32x4, __builtin_amdgcn_raw_buffer_load_b128(rsrc, (int)(o0 + (unsigned)i * st + 4u * (unsigned)t.ldw), 0, COPY_LD_AUX)); }
}
__device__ __forceinline__ void titem_store(const TItem& t, const f32x4 (&tv)[8], LAS float* scr, int lane) {
    LAS unsigned* T = (LAS unsigned*)scr; const int r = lane >> 3, n4 = 4 * (lane & 7); const float sc = t.scale;
#pragma unroll
    for (int i = 0; i < 4; ++i) { const f32x4 a = tv[2 * i] * sc, b = tv[2 * i + 1] * sc; LAS unsigned* p = T + n4 * 36 + r + 8 * i;
        p[0] = pkh(a.x, b.x); p[36] = pkh(a.y, b.y); p[72] = pkh(a.z, b.z); p[108] = pkh(a.w, b.w); }
    LDS_WAIT(); asm volatile("" ::: "memory");
    const int c = lane & 7; f16* ob = t.WT + (size_t)t.dstrow0 * t.ldt + t.k0;
    const unsigned oo = (unsigned)(lane >> 3) * (unsigned)t.ldt + 8u * (unsigned)c, ost = 8u * (unsigned)t.ldt;
#pragma unroll
    for (int j = 0; j < 4; ++j) { const u32x4 o = *(const LAS u32x4*)(T + ((lane >> 3) + 8 * j) * 36 + 4 * c);
        *(GAS u32x4*)(ob + (oo + (unsigned)j * ost)) = o; }
    LDS_WAIT(); asm volatile("" ::: "memory");
}
__device__ __forceinline__ void xitem_load(const TItem& t, f32x4 (&tv)[16], int lane) {
    const float* base = t.W + (size_t)t.k0 * t.ldw + t.srccol0;
    const auto rsrc = __builtin_amdgcn_make_buffer_rsrc((void*)base, (short)0, (int)(128 * t.ldw * 4), 0x00020000);
    const unsigned o0 = ((unsigned)(2 * (lane >> 3)) * (unsigned)t.ldw + 4u * (unsigned)(lane & 7)) * 4u, st = 64u * (unsigned)t.ldw;
#pragma unroll
    for (int i = 0; i < 8; ++i) { tv[2 * i] = __builtin_bit_cast(f32x4, __builtin_amdgcn_raw_buffer_load_b128(rsrc, (int)(o0 + (unsigned)i * st), 0, COPY_LD_AUX));
        tv[2 * i + 1] = __builtin_bit_cast(f32x4, __builtin_amdgcn_raw_buffer_load_b128(rsrc, (int)(o0 + (unsigned)i * st + 4u * (unsigned)t.ldw), 0, COPY_LD_AUX)); }
}
__device__ __forceinline__ void xitem_store(const TItem& t, const f32x4 (&tv)[16], LAS float* scr, int lane) {
    LAS unsigned char* T = (LAS unsigned char*)scr; const int r = lane >> 3, n4 = 4 * (lane & 7); const float sc = t.scale;
#pragma unroll
    for (int i = 0; i < 8; ++i) { const f32x4 a = tv[2 * i] * sc, b = tv[2 * i + 1] * sc; LAS unsigned char* p = T + n4 * 144 + 2 * (r + 8 * i);
        *(LAS unsigned short*)(p) = (unsigned short)__builtin_amdgcn_cvt_pk_fp8_f32(a.x, b.x, 0, false); *(LAS unsigned short*)(p + 144) = (unsigned short)__builtin_amdgcn_cvt_pk_fp8_f32(a.y, b.y, 0, false);
        *(LAS unsigned short*)(p + 288) = (unsigned short)__builtin_amdgcn_cvt_pk_fp8_f32(a.z, b.z, 0, false); *(LAS unsigned short*)(p + 432) = (unsigned short)__builtin_amdgcn_cvt_pk_fp8_f32(a.w, b.w, 0, false); }
    LDS_WAIT(); asm volatile("" ::: "memory");
    const int c = lane & 7; unsigned char* ob = (unsigned char*)t.WT + (size_t)t.dstrow0 * t.ldt + t.k0;
    const unsigned oo = (unsigned)(lane >> 3) * (unsigned)t.ldt + 16u * (unsigned)c, ost = 8u * (unsigned)t.ldt;
#pragma unroll
    for (int j = 0; j < 4; ++j) { const u32x4 o = *(const LAS u32x4*)(T + ((lane >> 3) + 8 * j) * 144 + 16 * c);
        __builtin_nontemporal_store(o, (GAS u32x4*)(ob + (oo + (unsigned)j * ost))); }
    LDS_WAIT(); asm volatile("" ::: "memory");
}
__device__ __forceinline__ void transpose_item(const float* W, int ldw, int k0, int srccol0, f16* WT, int ldt, int dstrow0, float scale, LAS float* scr, int lane) {
    TItem t{W, ldw, k0, srccol0, WT, ldt, dstrow0, scale}; f32x4 tv[8]; titem_load(t, tv, lane); titem_store(t, tv, scr, lane);
}
__device__ __forceinline__ int win_srccol(int n0, float& scale) {
    const int t = n0 >> 8, c = n0 & 255; scale = 1.0f;
    if (t >= 8 && t < 16) {
        const int hl = 2 * (t & 3) + ((c & 127) >> 6), dim = (c & 63) + 64 * (c >> 7);
        if (t >= 12) scale = 0.08838834764831845f;
        return (t >= 12 ? 3072 : 2048) + hl * 128 + dim;
    }
    return n0;
}
__device__ __forceinline__ void p0_prologue(Frame& F) {
    LAS float* scr = (LAS float*)(F.lds + RING_OFF + F.wave * 16384);
    const int gw = F.vcu * NWAVES + F.wave, NGW = F.G * NWAVES;
    {
        LAS float* sc = (LAS float*)(F.lds + RING_OFF);
        LAS float* red = sc + 3 * 2048;
        const float* c = F.in[1]; const float* cc = F.in[3]; const float* wm = F.in[4]; const float* bm = F.in[5];
        for (int i = F.tid; i < 3 * 2048; i += 512) { const float v = i < 4096 ? c[i] : cc[i - 4096]; sc[i] = silu_f(v); }
        __syncthreads();
        for (int cb = F.vcu; cb < 256; cb += F.G) {
            const int col0 = cb * 48;
            const int r = F.lane / 12, c4 = F.lane % 12;
            f32x4 a0 = {0, 0, 0, 0}, a1 = {0, 0, 0, 0}, a2 = {0, 0, 0, 0};
            if (F.lane < 60) {
                for (int kb = F.wave * 5 + r; kb < 2048; kb += 320) {
                    f32x4 wv[8];
#pragma unroll
                    for (int j = 0; j < 8; ++j) { const int k = kb + 40 * j; wv[j] = (k < 2048) ? __builtin_nontemporal_load((const f32x4*)(wm + (size_t)k * 12288 + col0 + 4 * c4)) : (f32x4){0.f, 0.f, 0.f, 0.f}; }
#pragma unroll
                    for (int j = 0; j < 8; ++j) { const int k = (kb + 40 * j) & 2047; a0 += wv[j] * sc[k]; a1 += wv[j] * sc[2048 + k]; a2 += wv[j] * sc[4096 + k]; }
                }
                LAS float* rp = red + ((F.wave * 5 + r) * 3) * 48 + 4 * c4;
                *(LAS f32x4*)(rp) = a0; *(LAS f32x4*)(rp + 48) = a1; *(LAS f32x4*)(rp + 96) = a2;
            }
            __syncthreads();
            if (F.tid < 144) { float s = 0.f; for (int j = 0; j < 40; ++j) s += red[j * 144 + F.tid];
                const int v = F.tid / 48, cl = F.tid % 48; ((float*)(F.ws() + WS_MOD))[v * 12288 + col0 + cl] = s + bm[col0 + cl]; }
            __syncthreads();
        }
    }
    if (F.vcu == 0) { float* rope = (float*)(F.ws() + WS_ROPE);
        for (int i = F.tid; i < 2048; i += 512) { const int pos = i >> 5, j = i & 31; const float inv = powf(10000.0f, -(float)j / 32.0f); const float ang = (float)pos * inv;
            rope[i] = cosf(ang); rope[2048 + i] = sinf(ang); } }
    { const float* rw = F.in[17]; f16* rh = (f16*)(F.ws() + WS_RWT); f16* rl = rh + NE * DM;
      for (int idx = F.vcu * 512 + F.tid; idx < NE * DM; idx += F.G * 512) { const int k = idx >> 6, e = idx & 63; const float v = rw[idx]; const f16 hi = (f16)v;
          const int o = (((((k >> 5) * 4 + (e >> 4)) * 4 + ((k >> 3) & 3)) * 16 + (e & 15)) << 3) + (k & 7); rh[o] = hi; rl[o] = (f16)((v - (float)hi) * 2048.0f); } }
    constexpr int I_IN = 32 * 192, I_OUT = 32 * 64;
    for (int it = gw; it < I_IN + I_OUT; it += NGW) {
        int r = it;
        if (r < I_IN) { const int kb = r / 192, nb = r % 192; float scale; const int src = win_srccol(nb * 32, scale);
            transpose_item(F.in[8], INC, kb * 64, src, (f16*)(F.ws() + WS_WINT), DM, nb * 32, scale, scr, F.lane); continue; }
        r -= I_IN;
        { const int kb = r / 64, nb = r % 64; transpose_item(F.in[16], DM, kb * 64, nb * 32, (f16*)(F.ws() + WS_WOUTT), DM, nb * 32, 1.0f, scr, F.lane); }
    }
}
__device__ __forceinline__ TItem expert_item(Frame& F, int it, const int kind) {
    const int e = kind ? (it >> 8) : (it >> 9); const int r = kind ? (it & 255) : (it & 511); TItem t;
    if (kind == 0) {
        const int kb = r / 32, nb = r % 32, pn = nb >> 3, wi = nb & 7;
        t.W = (e < NE) ? ((wi < 4 ? F.in[19] : F.in[20]) + (size_t)e * DM * EH) : (wi < 4 ? F.in[22] : F.in[23]);
        t.ldw = EH; t.k0 = kb * 128; t.srccol0 = pn * 128 + (wi & 3) * 32; t.WT = (f16*)(F.ws() + WS_W13T + (size_t)e * 1024 * DM); t.ldt = DM; t.dstrow0 = nb * 32; t.scale = SW13;
    } else {
        const int kb = r / 64, nb = r % 64;
        t.W = (e < NE) ? (F.in[21] + (size_t)e * EH * DM) : F.in[24];
        t.ldw = DM; t.k0 = kb * 128; t.srccol0 = nb * 32; t.WT = (f16*)(F.ws() + WS_W2T + (size_t)e * DM * EH); t.ldt = EH; t.dstrow0 = nb * 32; t.scale = SW2;
    }
    return t;
}
__device__ __forceinline__ void expert_copies(Frame& F, const int kind, const int lo, const int hi) {
    LAS float* scr = (LAS float*)(F.lds + RING_OFF + F.wave * 16384);
    TItem t0, t1; f32x4 v0[16], v1[16];
    int it = lo + F.wave;
    if (it < hi) { t0 = expert_item(F, it, kind); xitem_load(t0, v0, F.lane); }
    for (; it < hi; it += 2 * NWAVES) {
        if (it + NWAVES < hi) { t1 = expert_item(F, it + NWAVES, kind); xitem_load(t1, v1, F.lane); }
        xitem_store(t0, v0, scr, F.lane);
        if (it + 2 * NWAVES < hi) { t0 = expert_item(F, it + 2 * NWAVES, kind); xitem_load(t0, v0, F.lane); }
        if (it + NWAVES < hi) xitem_store(t1, v1, scr, F.lane);
    }
}
__device__ __forceinline__ void p2_expert_copies(Frame& F) {
    constexpr int NIT = NE1 * 512, N_CTXWG = 64, SH_CTX = 72, SH_REG = (NIT - N_CTXWG * SH_CTX) / 192, REM = (NIT - N_CTXWG * SH_CTX) % 192;
    int lo, n;
    if (F.vcu < N_CTXWG) { lo = F.vcu * SH_CTX; n = SH_CTX; }
    else { const int v = F.vcu - N_CTXWG; lo = N_CTXWG * SH_CTX + v * SH_REG + (v < REM ? v : REM); n = SH_REG + (v < REM ? 1 : 0); }
    expert_copies(F, 0, lo, lo + n);
}
#ifndef P11_FAKE_DEFICIT
#define P11_FAKE_DEFICIT 0
#endif
__device__ __forceinline__ int p11_units(int v, int nx, int total, int per) {
    const int x = v / nx, lc = v - x * nx; int cnt = total - x * per; cnt = cnt < 0 ? 0 : (cnt > per ? per : cnt);
    return cnt > lc ? (cnt - lc + nx - 1) / nx : 0; }
__device__ __forceinline__ void p11_expert_copies(Frame& F, const int ntile) {
    constexpr int NIT = NE1 * 256, UNIT_ITEMS = 68;
    const int nx = F.G >> 3, total = ntile * 4, per = (total + 7) >> 3, umax = (per + nx - 1) / nx;
    LAS int* sh = (LAS int*)(F.lds + TILE_LDS + 6144);
    int d = 0; if (F.tid < F.G) { d = umax - p11_units(F.tid, nx, total, per); if (P11_FAKE_DEFICIT) d += (F.tid % 5 == 0) ? 1 : 0; }
    int tot = d, bef = (F.tid < F.vcu) ? d : 0;
#pragma unroll
    for (int o = 1; o < 64; o <<= 1) { tot += __shfl_xor(tot, o); bef += __shfl_xor(bef, o); }
    if (F.lane == 0) { sh[2 * F.wave] = tot; sh[2 * F.wave + 1] = bef; }
    __syncthreads();
    int D = 0, Dbefore = 0;
#pragma unroll
    for (int w = 0; w < NWAVES; ++w) { D += sh[2 * w]; Dbefore += sh[2 * w + 1]; }
    int dme = umax - p11_units(F.vcu, nx, total, per); if (P11_FAKE_DEFICIT) dme += (F.vcu % 5 == 0) ? 1 : 0;
    D = __builtin_amdgcn_readfirstlane(D); Dbefore = __builtin_amdgcn_readfirstlane(Dbefore); dme = __builtin_amdgcn_readfirstlane(dme);
    int lo, n;
    if (NIT - UNIT_ITEMS * D < 0 || F.G > 512) { const int pe = (NIT + F.G - 1) / F.G; lo = F.vcu * pe; n = pe; }
    else { const int xb = (NIT - UNIT_ITEMS * D) / F.G, rem = NIT - (xb * F.G + UNIT_ITEMS * D); lo = xb * F.vcu + UNIT_ITEMS * Dbefore + (F.vcu < rem ? F.vcu : rem); n = xb + UNIT_ITEMS * dme + (F.vcu < rem ? 1 : 0); }
    const int hi = (lo + n < NIT) ? lo + n : NIT;
    __syncthreads();
    expert_copies(F, 1, lo < NIT ? lo : NIT, hi);
}

constexpr int IMG_LD = 136;
constexpr int IMG_BYTES = 128 * IMG_LD * 2;
__device__ __forceinline__ void wave_mma(f32x4 (&acc)[8], const f16x8 (&a)[4], const LAS f16* img, int fr, int fq) {
#pragma unroll
    for (int ks = 0; ks < 4; ++ks) { __builtin_amdgcn_sched_barrier(0);
#pragma unroll
        for (int t = 0; t < 8; ++t) { const f16x8 b = *(const LAS f16x8*)(img + (16 * t + fr) * IMG_LD + 32 * ks + 8 * fq); acc[t] = __builtin_amdgcn_mfma_f32_16x16x32_f16(b, a[ks], acc[t], 0, 0, 0); } }
    __builtin_amdgcn_sched_barrier(0);
}
__device__ __forceinline__ void zero8(f32x4 (&acc)[8]) {
#pragma unroll
    for (int t = 0; t < 8; ++t) acc[t] = (f32x4){0.f, 0.f, 0.f, 0.f};
}
template <bool NT = false>
__device__ __forceinline__ void stage_rows(LAS f16* img, const f16* src, int ld, int tid) {
#pragma unroll
    for (int it = 0; it < 4; ++it) { const int r = (tid >> 4) + 32 * it, cc = (tid & 15) * 8; const u32x4* p_ = (const u32x4*)(src + (size_t)r * ld + cc); *(LAS u32x4*)(img + r * IMG_LD + cc) = NT ? __builtin_nontemporal_load(p_) : *p_; }
}
__device__ __forceinline__ void stage_rows_f32(LAS f16* img, const float* src, int tid) {
#pragma unroll
    for (int it = 0; it < 8; ++it) { const int r = (tid >> 5) + 16 * it, cc = (tid & 31) * 4; const f32x4 v = *(const f32x4*)(src + (size_t)r * 128 + cc);
        u32x2 o; o.x = pkh(v.x, v.y); o.y = pkh(v.z, v.w); *(LAS u32x2*)(img + r * IMG_LD + cc) = o; }
}


__device__ __forceinline__ void p2_ctx_unit(Frame& F, int u) {
    const int rb = u >> 4, cb = u & 15, h = cb & 7; const bool isv = cb >= 8;
    const f16* HXc = (const f16*)(F.ws() + WS_HX) + (size_t)(NTOK + rb * 128) * DM; const f16* WT = (const f16*)(F.ws() + WS_WINT);
    LAS f16* imA = (LAS f16*)(F.lds); LAS f16* imB = (LAS f16*)(F.lds + IMG_BYTES);
    const int fr = F.lane & 15, fq = F.lane >> 4, w = F.wave;
    const int r0 = F.tid >> 4, cc = (F.tid & 15) * 8;
    const f16* ap[4]; const f16* bp[4];
#pragma unroll
    for (int it = 0; it < 4; ++it) { const int r = r0 + 32 * it; ap[it] = HXc + (size_t)r * DM + cc;
        const int brow = isv ? (4096 + h * 128 + r) : ((12 + (h >> 1)) * 256 + (r >> 6) * 128 + (h & 1) * 64 + (r & 63)); bp[it] = WT + (size_t)brow * DM + cc; }
    u32x4 aw[4], bw[4];
#pragma unroll
    for (int it = 0; it < 4; ++it) { aw[it] = *(const u32x4*)(ap[it]); bw[it] = *(const u32x4*)(bp[it]); }
    f32x4 acc[8]; zero8(acc);
    for (int kc = 0; kc < 16; ++kc) {
#pragma unroll
        for (int it = 0; it < 4; ++it) { const int r = r0 + 32 * it; *(LAS u32x4*)(imA + r * IMG_LD + cc) = aw[it]; *(LAS u32x4*)(imB + r * IMG_LD + cc) = bw[it]; }
        if (kc < 15) {
#pragma unroll
            for (int it = 0; it < 4; ++it) { aw[it] = *(const u32x4*)(ap[it] + (kc + 1) * 128); bw[it] = *(const u32x4*)(bp[it] + (kc + 1) * 128); } }
        __syncthreads();
        f16x8 a[4];
#pragma unroll
        for (int ks = 0; ks < 4; ++ks) a[ks] = *(const LAS f16x8*)(imA + (16 * w + fr) * IMG_LD + 32 * ks + 8 * fq);
        wave_mma(acc, a, imB, fr, fq);
        __syncthreads();
    }
    f16* dst = (f16*)(F.ws() + (isv ? WS_CV : WS_CK)) + (size_t)(rb * 128 + 16 * w + fr) * AW + h * 128;
#pragma unroll
    for (int t = 0; t < 8; ++t) { u32x2 o; o.x = pkh(acc[t].x, acc[t].y); o.y = pkh(acc[t].z, acc[t].w); *(u32x2*)(dst + 16 * t + 4 * fq) = o; }
}
__device__ __forceinline__ void p1_norm(Frame& F) {
    const int gw = F.vcu * NWAVES + F.wave, NGW = F.G * NWAVES;
    const float* g1 = F.in[6]; const float* xin = F.in[0]; const float* cin = F.in[2]; const float* modb = (const float*)(F.ws() + WS_MOD); f16* HX = (f16*)(F.ws() + WS_HX);
    f32x4 nx[8];
    { const int row = gw; const float* xr = row < NTOK ? xin + (size_t)row * DM : cin + (size_t)(row - NTOK) * DM;
#pragma unroll
      for (int j = 0; j < 8; ++j) nx[j] = __builtin_nontemporal_load((const f32x4*)(xr + 4 * F.lane + 256 * j)); }
    for (int row = gw; row < NROWS_IN; row += NGW) {
        f32x4 v[8]; float ss = 0.f;
#pragma unroll
        for (int j = 0; j < 8; ++j) { v[j] = nx[j]; ss += (v[j].x * v[j].x + v[j].y * v[j].y) + (v[j].z * v[j].z + v[j].w * v[j].w); }
        { const int r2 = row + NGW; if (r2 < NROWS_IN) { const float* xr = r2 < NTOK ? xin + (size_t)r2 * DM : cin + (size_t)(r2 - NTOK) * DM;
#pragma unroll
            for (int j = 0; j < 8; ++j) nx[j] = __builtin_nontemporal_load((const f32x4*)(xr + 4 * F.lane + 256 * j)); } }
        const float* mod = modb + (row < NTOK ? (row >> 12) : 2) * 12288;
        const float rstd = 1.0f / sqrtf(wave_sum(ss) * (1.0f / DM) + EPS);
        f16* orow = HX + (size_t)row * DM;
#pragma unroll
        for (int j = 0; j < 8; ++j) { const int col = 4 * F.lane + 256 * j;
            const f32x4 g = *(const f32x4*)(g1 + col), sh = *(const f32x4*)(mod + col), sc = *(const f32x4*)(mod + 2048 + col);
            const f32x4 h = (v[j] * rstd * g) * (sc + 1.0f) + sh;
            u32x2 o; o.x = pkh(h.x, h.y); o.y = pkh(h.z, h.w); *(u32x2*)(orow + col) = o; }
    }
}

struct InSched { int G, c; const char* Bt; int ulo, uhi;
    __device__ __forceinline__ bool next(int i, g8::Unit& u, const int (&R)[2], const int (&C)[2]) const {
        if (i + ulo >= uhi) return false; const int L = (i + ulo) * G + c; int pm, pn;
        if (!g8::dense_order(L, 32, 24, pm, pn)) return false;
#pragma unroll
        for (int h = 0; h < 2; ++h)
#pragma unroll
            for (int k = 0; k < 2; ++k) u.ao[h][k] = (unsigned)((pm * 256 + h * 128 + R[k]) * DM + C[k]) * 2u;
        u.B = Bt + (size_t)pn * 256 * DM * 2; u.row0 = pm * 256; u.pn = pn; u.aux = 0; u.full = 1;
        return true;
    }
};

struct EpiIn {
    static constexpr bool PERM = true;
    f16* PB; f16* CK; f16* CV; float* vstp; const float* rope;
    struct Pre {}; __device__ __forceinline__ Pre prefetch(const g8::Unit&, int, int) const { return Pre{}; }
    __device__ __forceinline__ void operator()(const f32x4 (&acc)[2][2][4][2], const g8::Unit& u, int wr, int wc, int fr, int fq, const Pre&) const {
        const int pn = u.pn, ty = pn >> 2; const bool ctx = u.row0 >= NTOK;
        const int c1 = wc * 32 + 8 * fq;
        if (ty == 2 || ty == 3) {
            const int head = 2 * (pn & 3) + (wc >> 1), i0 = c1 & 63, isq = (ty == 2);
            f16* dstb = ctx ? CK : (PB + (size_t)(isq ? 2 : 3) * NTOK * AW);
#pragma unroll
            for (int ai = 0; ai < 2; ++ai)
#pragma unroll
                for (int m = 0; m < 4; ++m) { const int row = u.row0 + ai * 128 + wr * 64 + m * 16 + fr;
                    const f32x4 a0 = acc[ai][0][m][0], a1 = acc[ai][0][m][1], b0 = acc[ai][1][m][0], b1 = acc[ai][1][m][1];
                    f32x4 c0 = {1.f, 1.f, 1.f, 1.f}, c1v = c0, s0 = {0.f, 0.f, 0.f, 0.f}, s1 = s0;
                    if (!ctx) { const int tpos = row & (SEQ - 1); const int pos = (wc & 1) ? (tpos & 63) : (tpos >> 6); const float* rp = rope + pos * 32 + (i0 & 31);
                        c0 = *(const f32x4*)(rp); c1v = *(const f32x4*)(rp + 4); s0 = *(const f32x4*)(rp + 2048); s1 = *(const f32x4*)(rp + 2052); }
                    const f32x4 o1a = a0 * c0 - b0 * s0, o1b = a1 * c1v - b1 * s1, o2a = a0 * s0 + b0 * c0, o2b = a1 * s1 + b1 * c1v;
                    const int drow = ctx ? row - NTOK : row;
                    f16* d = dstb + (size_t)drow * AW + head * 128 + i0;
                    u32x4 w1; w1.x = pkh(o1a[0], o1a[1]); w1.y = pkh(o1a[2], o1a[3]); w1.z = pkh(o1b[0], o1b[1]); w1.w = pkh(o1b[2], o1b[3]);
                    u32x4 w2; w2.x = pkh(o2a[0], o2a[1]); w2.y = pkh(o2a[2], o2a[3]); w2.z = pkh(o2b[0], o2b[1]); w2.w = pkh(o2b[2], o2b[3]);
                    *(u32x4*)d = w1; *(u32x4*)(d + 64) = w2; }
            return;
        }
        const int sel = (ty == 0) ? 0 : (ty == 1) ? 1 : (ty == 4) ? 4 : 5;
        f16* dstb = (ctx ? CV : PB + (size_t)sel * NTOK * AW) + (pn & 3) * 256 + c1;
#pragma unroll
        for (int ai = 0; ai < 2; ++ai)
#pragma unroll
            for (int m = 0; m < 4; ++m) { const int row = u.row0 + ai * 128 + wr * 64 + m * 16 + fr; const int drow = ctx ? row - NTOK : row;
                float s = 0.f, q = 0.f;
#pragma unroll
                for (int bj = 0; bj < 2; ++bj) { f32x4 v0 = acc[ai][bj][m][0], v1 = acc[ai][bj][m][1];
                    if (ty <= 1) {
#pragma unroll
                        for (int j = 0; j < 4; ++j) { v0[j] = gelu_f(v0[j]); v1[j] = gelu_f(v1[j]); } }
                    else if (ty == 5) {
#pragma unroll
                        for (int j = 0; j < 4; ++j) { v0[j] = silu_f(v0[j]); v1[j] = silu_f(v1[j]); } }
                    if (ty == 1) { s += (v0[0] + v0[1]) + (v0[2] + v0[3]) + (v1[0] + v1[1]) + (v1[2] + v1[3]);
                        q += (v0[0] * v0[0] + v0[1] * v0[1]) + (v0[2] * v0[2] + v0[3] * v0[3]) + (v1[0] * v1[0] + v1[1] * v1[1]) + (v1[2] * v1[2] + v1[3] * v1[3]); }
                    u32x4 o; o.x = pkh(v0[0], v0[1]); o.y = pkh(v0[2], v0[3]); o.z = pkh(v1[0], v1[1]); o.w = pkh(v1[2], v1[3]);
                    *(u32x4*)(dstb + (size_t)drow * AW + bj * 128) = o; }
                if (ty == 1) { s += __shfl_xor(s, 16); s += __shfl_xor(s, 32); q += __shfl_xor(q, 16); q += __shfl_xor(q, 32);
                    if (fq == 0) { f32x2 st; st.x = s; st.y = q; *(f32x2*)(vstp + ((size_t)row * 16 + (pn & 3) * 4 + wc) * 2) = st; } } }
    }
};
struct EpiX1 {
    static constexpr bool PERM = false;
    const float* x; const float* mod; float* X1;
    struct Pre {}; __device__ __forceinline__ Pre prefetch(const g8::Unit&, int, int) const { return Pre{}; }
    __device__ __forceinline__ void operator()(const f32x4 (&acc)[2][2][4][2], const g8::Unit& u, int wr, int wc, int fr, int fq, const Pre&) const {
        const int row0 = u.row0 + wr * 64 + fr, col0 = u.pn * 256 + wc * 32 + 4 * fq;
        const float* g1 = mod + (u.row0 >> 12) * 12288 + 2 * 2048;
        f32x4 gv[2][2];
#pragma unroll
        for (int bj = 0; bj < 2; ++bj)
#pragma unroll
            for (int n = 0; n < 2; ++n) gv[bj][n] = *(const f32x4*)(g1 + col0 + bj * 128 + n * 16);
#pragma unroll
        for (int ai = 0; ai < 2; ++ai)
#pragma unroll
            for (int m = 0; m < 4; ++m) { const size_t off = (size_t)(row0 + ai * 128 + m * 16) * DM + col0;
#pragma unroll
                for (int bj = 0; bj < 2; ++bj)
#pragma unroll
                    for (int n = 0; n < 2; ++n) { const f32x4 xv = __builtin_nontemporal_load((const f32x4*)(x + off + bj * 128 + n * 16)); *(f32x4*)(X1 + off + bj * 128 + n * 16) = xv + gv[bj][n] * acc[ai][bj][m][n]; }
                if (m & 1) asm volatile("" ::: "memory"); }
    }
};
__device__ __forceinline__ void p3_post(Frame& F) {
    const int gw = F.vcu * NWAVES + F.wave, NGW = F.G * NWAVES;
    const float* CB = (const float*)(F.ws() + WS_CBUF);
    f16* UG = (f16*)(F.ws() + WS_PBUF); f16* VG = UG + (size_t)NTOK * AW; f16* Qb = VG + (size_t)NTOK * AW; f16* Kb = Qb + (size_t)NTOK * AW; f16* VR = Kb + (size_t)NTOK * AW; f16* GS = VR + (size_t)NTOK * AW;
    f16* CK = (f16*)(F.ws() + WS_CK); f16* CV = (f16*)(F.ws() + WS_CV);
    const float* rope = (const float*)(F.ws() + WS_ROPE);
    float* vstat = (float*)(F.ws() + WS_VSTAT);
    for (int row = gw; row < NROWS_IN; row += NGW) {
        const float* cr = CB + (size_t)row * INC;
        if (row < NTOK) {
            float gv[16]; float s = 0.f;
#pragma unroll
            for (int j = 0; j < 4; ++j) { const int col = 256 * j + 4 * F.lane;
                const f32x4 u = *(const f32x4*)(cr + col); u32x2 o; o.x = pkh(gelu_f(u.x), gelu_f(u.y)); o.y = pkh(gelu_f(u.z), gelu_f(u.w)); *(u32x2*)(UG + (size_t)row * AW + col) = o;
                const f32x4 v = *(const f32x4*)(cr + 1024 + col); gv[4 * j] = gelu_f(v.x); gv[4 * j + 1] = gelu_f(v.y); gv[4 * j + 2] = gelu_f(v.z); gv[4 * j + 3] = gelu_f(v.w);
                s += (gv[4 * j] + gv[4 * j + 1]) + (gv[4 * j + 2] + gv[4 * j + 3]);
                u32x2 o2; o2.x = pkh(gv[4 * j], gv[4 * j + 1]); o2.y = pkh(gv[4 * j + 2], gv[4 * j + 3]); *(u32x2*)(VG + (size_t)row * AW + col) = o2;
                const f32x4 w = *(const f32x4*)(cr + 4096 + col); u32x2 o3; o3.x = pkh(w.x, w.y); o3.y = pkh(w.z, w.w); *(u32x2*)(VR + (size_t)row * AW + col) = o3;
                const f32x4 g = *(const f32x4*)(cr + 5120 + col); u32x2 o4; o4.x = pkh(silu_f(g.x), silu_f(g.y)); o4.y = pkh(silu_f(g.z), silu_f(g.w)); *(u32x2*)(GS + (size_t)row * AW + col) = o4; }
            const float mean = wave_sum(s) * (1.0f / AW); float q = 0.f;
#pragma unroll
            for (int j = 0; j < 16; ++j) { const float d = gv[j] - mean; q += d * d; }
            const float rstd = 1.0f / sqrtf(wave_sum(q) * (1.0f / AW) + EPS);
            if (F.lane == 0) { vstat[2 * row] = mean; vstat[2 * row + 1] = rstd; }
            const int tpos = row & (SEQ - 1), rpos = tpos >> 6, cpos = tpos & 63;
            for (int t = 8; t < 16; ++t) {
#pragma unroll
                for (int cc = 0; cc < 2; ++cc) { const int c = F.lane + 64 * cc;
                    const float x1 = cr[256 * t + c], x2 = cr[256 * t + 128 + c];
                    const int head = 2 * (t & 3) + (c >> 6), i = c & 63;
                    const int ri = (i < 32) ? (rpos * 32 + i) : (cpos * 32 + (i - 32));
                    const float cs = rope[ri], sn = rope[2048 + ri];
                    f16* dst = (t < 12 ? Qb : Kb) + (size_t)row * AW + head * 128 + i;
                    dst[0] = (f16)(x1 * cs - x2 * sn); dst[64] = (f16)(x1 * sn + x2 * cs); }
            }
        } else {
            const int rc = row - NTOK;
            for (int t = 12; t < 16; ++t) {
#pragma unroll
                for (int cc = 0; cc < 2; ++cc) { const int c = F.lane + 64 * cc; const float x1 = cr[256 * t + c], x2 = cr[256 * t + 128 + c];
                    const int head = 2 * (t & 3) + (c >> 6), i = c & 63; f16* dst = CK + (size_t)rc * AW + head * 128 + i; dst[0] = (f16)x1; dst[64] = (f16)x2; }
            }
#pragma unroll
            for (int j = 0; j < 4; ++j) { const int col = 256 * j + 4 * F.lane; const f32x4 w = *(const f32x4*)(cr + 4096 + col); u32x2 o3; o3.x = pkh(w.x, w.y); o3.y = pkh(w.z, w.w); *(u32x2*)(CV + (size_t)rc * AW + col) = o3; }
        }
    }
}

__device__ __forceinline__ size_t st_index(int dir, int bh, int slot) { return ((size_t)(dir * 16 + bh) * 33 + slot) * 16384; }
__device__ __forceinline__ void p4_fast(Frame& F) {
    const f16* UG = (const f16*)(F.ws() + WS_PBUF); const f16* VG = UG + (size_t)NTOK * AW; const f16* Kb = VG + (size_t)2 * NTOK * AW; const f16* VR = Kb + (size_t)NTOK * AW;
    const f16* CK = (const f16*)(F.ws() + WS_CK); const f16* CV = (const f16*)(F.ws() + WS_CV);
    const float* vstat = (const float*)(F.ws() + WS_VSTAT);
    const float* alng = F.in[9]; const float* aws = F.in[10]; const float* abs_ = F.in[11];
    const float* lgf = F.in[13]; const float* lgb = F.in[14];
    f16* ARAW = (f16*)(F.ws() + WS_ARAW); f16* ST = (f16*)(F.ws() + WS_ST);
    LAS f16* im0 = (LAS f16*)(F.lds); LAS f16* im1 = (LAS f16*)(F.lds + IMG_BYTES); LAS f16* im2 = (LAS f16*)(F.lds + 2 * IMG_BYTES);
    const int fr = F.lane & 15, fq = F.lane >> 4, w = F.wave;
    constexpr int NU_MLP = 512, NU_LOC = 512, NU_CTX = 32, NU = NU_MLP + NU_LOC + NU_CTX;
    for (int u = F.vcu; u < NU; u += F.G) {
        if (u < NU_MLP) {
            const int h = u & 7, ci = u >> 3, t0 = ci * CHK, hc = h * 128;
            float mean, rstd; { const float* pp = vstat + (size_t)(t0 + (F.tid & 127)) * 32; float ssum = 0.f, qsum = 0.f;
#pragma unroll
                for (int k = 0; k < 16; ++k) { const f32x2 st = *(const f32x2*)(pp + 2 * k); ssum += st.x; qsum += st.y; }
                mean = ssum * (1.0f / AW); rstd = 1.0f / sqrtf(fmaxf(qsum * (1.0f / AW) - mean * mean, 0.f) + EPS); }
#pragma unroll
            for (int it = 0; it < 4; ++it) { const int q = F.tid & 127, cc = ((F.tid >> 7) + 4 * it) * 8;
                const f16x8 v = *(const f16x8*)(VG + (size_t)(t0 + q) * AW + hc + cc);
#pragma unroll
                for (int j = 0; j < 8; ++j) im0[(cc + j) * IMG_LD + q] = (f16)(((float)v[j] - mean) * rstd * alng[hc + cc + j]); }
            f16x8 a[4]; const float* wrow = aws + (size_t)(hc + 16 * w + fr) * 128;
#pragma unroll
            for (int ks = 0; ks < 4; ++ks) { const f32x4 x0 = *(const f32x4*)(wrow + 32 * ks + 8 * fq), x1 = *(const f32x4*)(wrow + 32 * ks + 8 * fq + 4);
                a[ks][0] = (f16)x0.x; a[ks][1] = (f16)x0.y; a[ks][2] = (f16)x0.z; a[ks][3] = (f16)x0.w; a[ks][4] = (f16)x1.x; a[ks][5] = (f16)x1.y; a[ks][6] = (f16)x1.z; a[ks][7] = (f16)x1.w; }
            __syncthreads();
            f32x4 acc[8]; zero8(acc); wave_mma(acc, a, im0, fr, fq);
            const int p = 16 * w + fr; const float bias = abs_[hc + p];
#pragma unroll
            for (int t = 0; t < 8; ++t) { const int d = 16 * t + 4 * fq; const f16x4 ug = *(const f16x4*)(UG + (size_t)(t0 + p) * AW + hc + d);
                u32x2 o; o.x = pkh((float)ug.x * (acc[t].x + bias), (float)ug.y * (acc[t].y + bias)); o.y = pkh((float)ug.z * (acc[t].z + bias), (float)ug.w * (acc[t].w + bias));
                *(u32x2*)(ARAW + (size_t)(t0 + p) * AW + hc + d) = o; }
            __syncthreads();
        } else {
            const bool isctx = (u >= NU_MLP + NU_LOC); const int uu = isctx ? (u - NU_MLP - NU_LOC) : (u - NU_MLP);
            const int bh = isctx ? (uu >> 1) : (uu >> 5), i = isctx ? 0 : (uu & 31), b = bh >> 3, h = bh & 7, hc = h * 128, chf = uu & 1;
            const float lf = lgf[h], lb = lgb[h];
            f32x4 af[8], ab[8]; zero8(af); zero8(ab);
            { const int hf = isctx ? chf : 0;
                const f16* ksrc = isctx ? (CK + (size_t)(b * CTXL + hf * 128) * AW + hc) : (Kb + (size_t)(b * SEQ + i * CHK) * AW + hc);
                const f16* vsrc = isctx ? (CV + (size_t)(b * CTXL + hf * 128) * AW + hc) : (VR + (size_t)(b * SEQ + i * CHK) * AW + hc);
                const int L = isctx ? CTXL : CHK;
#pragma unroll
                for (int it = 0; it < 4; ++it) { const int m = F.tid & 127, cc = ((F.tid >> 7) + 4 * it) * 8; const int l = hf * 128 + m;
                    const f16x8 kv = *(const f16x8*)(ksrc + (size_t)m * AW + cc); const f16x8 vv = *(const f16x8*)(vsrc + (size_t)m * AW + cc);
                    const float wf = __expf(lf * (float)(L - 1 - l)), wb = __expf(lb * (float)l);
#pragma unroll
                    for (int j = 0; j < 8; ++j) { im0[(cc + j) * IMG_LD + m] = vv[j]; im1[(cc + j) * IMG_LD + m] = (f16)((float)kv[j] * wf); im2[(cc + j) * IMG_LD + m] = (f16)((float)kv[j] * wb); } }
                __syncthreads();
                f16x8 a[4];
#pragma unroll
                for (int ks = 0; ks < 4; ++ks) a[ks] = *(const LAS f16x8*)(im0 + (16 * w + fr) * IMG_LD + 32 * ks + 8 * fq);
                wave_mma(af, a, im1, fr, fq); wave_mma(ab, a, im2, fr, fq);
                __syncthreads();
            }
            const int sf = isctx ? (chf ? 32 : 0) : i + 1, sb = isctx ? (chf ? 32 : 0) : 32 - i;
            f16* df = ST + st_index(0, bh, sf) + (16 * w + fr) * 128; f16* db = ST + st_index(1, bh, sb) + (16 * w + fr) * 128;
            if (isctx || sf != 32) {
#pragma unroll
                for (int t = 0; t < 8; ++t) { u32x2 o; o.x = pkh(af[t].x, af[t].y); o.y = pkh(af[t].z, af[t].w); *(u32x2*)(df + 16 * t + 4 * fq) = o; } }
            if (isctx || sb != 32) {
#pragma unroll
                for (int t = 0; t < 8; ++t) { u32x2 o; o.x = pkh(ab[t].x, ab[t].y); o.y = pkh(ab[t].z, ab[t].w); *(u32x2*)(db + 16 * t + 4 * fq) = o; } }
        }
    }
}
__device__ __forceinline__ void p6_fast(Frame& F) {
    const f16* Qb = (const f16*)(F.ws() + WS_PBUF) + (size_t)2 * NTOK * AW; const f16* Kb = Qb + (size_t)NTOK * AW; const f16* VR = Kb + (size_t)NTOK * AW; const f16* GS = VR + (size_t)NTOK * AW;
    const f16* ST = (const f16*)(F.ws() + WS_ST);
    const float* lgf = F.in[13]; const float* lgb = F.in[14]; const float* gng = F.in[15]; f16* AR = (f16*)(F.ws() + WS_AR);
    LAS f16* imK = (LAS f16*)(F.lds); LAS f16* imV = (LAS f16*)(F.lds + IMG_BYTES); LAS f16* imS = (LAS f16*)(F.lds + 2 * IMG_BYTES); LAS f16* imP = (LAS f16*)(F.lds + 3 * IMG_BYTES);
    const int fr = F.lane & 15, fq = F.lane >> 4, w = F.wave;
    constexpr float L2E = 1.4426950408889634f;
    for (int u = F.vcu; u < 512; u += F.G) {
        const int bh = u >> 5, i = u & 31, b = bh >> 3, h = bh & 7, hc = h * 128; const size_t t0 = (size_t)b * SEQ + i * CHK;
        const float lf = lgf[h] * L2E, lb = lgb[h] * L2E;
        stage_rows(imK, Kb + t0 * AW + hc, AW, F.tid);
#pragma unroll
        for (int it = 0; it < 4; ++it) { const int m = F.tid & 127, cc = ((F.tid >> 7) + 4 * it) * 8; const f16x8 vv = *(const f16x8*)(VR + (t0 + m) * AW + hc + cc);
#pragma unroll
            for (int j = 0; j < 8; ++j) imV[(cc + j) * IMG_LD + m] = vv[j]; }
        stage_rows<true>(imS, ST + st_index(0, bh, i), 128, F.tid);
        stage_rows<true>(imP, ST + st_index(1, bh, 31 - i), 128, F.tid);
        const int n = 16 * w + fr; const size_t trow = t0 + n;
        f16x8 qa[4];
#pragma unroll
        for (int ks = 0; ks < 4; ++ks) qa[ks] = __builtin_nontemporal_load((const f16x8*)(Qb + trow * AW + hc + 32 * ks + 8 * fq));
        f16x4 gsv[8];
#pragma unroll
        for (int t = 0; t < 8; ++t) gsv[t] = __builtin_nontemporal_load((const f16x4*)(GS + trow * AW + hc + 16 * t + 4 * fq));
        __syncthreads();
        f32x4 acc[8], o[8]; zero8(acc); wave_mma(acc, qa, imS, fr, fq);
        const float qf = exp2f(lf * (float)(n + 1)), qb = exp2f(lb * (float)(CHK - n));
#pragma unroll
        for (int t = 0; t < 8; ++t) o[t] = acc[t] * qf;
        zero8(acc); wave_mma(acc, qa, imP, fr, fq);
#pragma unroll
        for (int t = 0; t < 8; ++t) o[t] += acc[t] * qb;
        zero8(acc); wave_mma(acc, qa, imK, fr, fq);
        __syncthreads();
        int nn = n; asm volatile("" : "+v"(nn));
        LAS f16* pw = imP + (16 * w) * IMG_LD;
#pragma unroll
        for (int t = 0; t < 8; ++t) { float pv[4];
#pragma unroll
            for (int r = 0; r < 4; ++r) { const float dm = (float)(nn - (16 * t + 4 * fq + r)); const float dec = exp2f(lf * fmaxf(dm, 0.f) + lb * fmaxf(-dm, 0.f)) + (1.0f - fminf(fabsf(dm), 1.0f)); pv[r] = acc[t][r] * dec; }
            u32x2 pk; pk.x = pkh(pv[0], pv[1]); pk.y = pkh(pv[2], pv[3]); *(LAS u32x2*)(pw + fr * IMG_LD + 16 * t + 4 * fq) = pk; }
        f16x8 pa[4];
#pragma unroll
        for (int ks = 0; ks < 4; ++ks) pa[ks] = *(const LAS f16x8*)(pw + fr * IMG_LD + 32 * ks + 8 * fq);
        wave_mma(o, pa, imV, fr, fq);
        float s = 0.f;
#pragma unroll
        for (int t = 0; t < 8; ++t) s += (o[t].x + o[t].y) + (o[t].z + o[t].w);
        s += __shfl_xor(s, 16); s += __shfl_xor(s, 32);
        const float mean = s * (1.0f / 128.0f); float q = 0.f;
#pragma unroll
        for (int t = 0; t < 8; ++t) { o[t] = o[t] - mean; q += (o[t].x * o[t].x + o[t].y * o[t].y) + (o[t].z * o[t].z + o[t].w * o[t].w); }
        q += __shfl_xor(q, 16); q += __shfl_xor(q, 32);
        const float rstd = 1.0f / sqrtf(q * (1.0f / 128.0f) + EPS);
#pragma unroll
        for (int t = 0; t < 8; ++t) { const int col = hc + 16 * t + 4 * fq; const f32x4 g = *(const f32x4*)(gng + col); const f16x4 gs = gsv[t];
            u32x2 pk; pk.x = pkh(o[t].x * rstd * g.x * (float)gs.x, o[t].y * rstd * g.y * (float)gs.y); pk.y = pkh(o[t].z * rstd * g.z * (float)gs.z, o[t].w * rstd * g.w * (float)gs.w);
            *(u32x2*)(AR + trow * DM + AW + col) = pk; }
        __syncthreads();
    }
}
__device__ __forceinline__ void p5_naive(Frame& F) {
    const int gw = F.vcu * NWAVES + F.wave, NGW = F.G * NWAVES; const int gt = F.vcu * 512 + F.tid, NGT = F.G * 512;
    const f16* ARAW = (const f16*)(F.ws() + WS_ARAW); f16* AR = (f16*)(F.ws() + WS_AR); const float* aog = F.in[12];
    f32x4 agv[2][2];
#pragma unroll
    for (int j = 0; j < 2; ++j) { const int col = 8 * F.lane + 512 * j; agv[j][0] = *(const f32x4*)(aog + col); agv[j][1] = *(const f32x4*)(aog + col + 4); }
    for (int row = gw; row < NTOK; row += NGW) {
        f16x8 v[2]; float ss = 0.f;
#pragma unroll
        for (int j = 0; j < 2; ++j) { v[j] = __builtin_nontemporal_load((const f16x8*)(ARAW + (size_t)row * AW + 8 * F.lane + 512 * j));
#pragma unroll
            for (int k = 0; k < 8; ++k) ss += (float)v[j][k] * (float)v[j][k]; }
        const float rstd = 1.0f / sqrtf(wave_sum(ss) * (1.0f / AW) + EPS);
#pragma unroll
        for (int j = 0; j < 2; ++j) { const int col = 8 * F.lane + 512 * j; const f32x4 ga = agv[j][0], gb = agv[j][1];
            u32x4 o; o.x = pkh((float)v[j][0] * rstd * ga.x, (float)v[j][1] * rstd * ga.y); o.y = pkh((float)v[j][2] * rstd * ga.z, (float)v[j][3] * rstd * ga.w);
            o.z = pkh((float)v[j][4] * rstd * gb.x, (float)v[j][5] * rstd * gb.y); o.w = pkh((float)v[j][6] * rstd * gb.z, (float)v[j][7] * rstd * gb.w);
            *(u32x4*)(AR + (size_t)row * DM + col) = o; }
    }
    f16* ST = (f16*)(F.ws() + WS_ST); const float* lgf = F.in[13]; const float* lgb = F.in[14];
    for (int idx = gt; idx < 2 * 16 * 8192; idx += NGT) {
        const int e = (idx & 8191) * 2, bh = (idx >> 13) & 15, dir = idx >> 17, h = bh & 7;
        const float cd = __expf((dir ? lgb[h] : lgf[h]) * (float)CHK);
        f16* p0 = ST + st_index(dir, bh, 0) + e; f16x2 uv[32];
#pragma unroll
        for (int s = 0; s < 32; ++s) uv[s] = *(const f16x2*)(p0 + (size_t)s * 16384);
        const f16x2 c2 = *(const f16x2*)(p0 + (size_t)32 * 16384);
        float a0 = (float)uv[0][0] + (float)c2[0], a1 = (float)uv[0][1] + (float)c2[1];
        { f16x2 o; o[0] = (f16)a0; o[1] = (f16)a1; *(f16x2*)p0 = o; }
#pragma unroll
        for (int s = 1; s < 32; ++s) { a0 = cd * a0 + (float)uv[s][0]; a1 = cd * a1 + (float)uv[s][1]; f16x2 o; o[0] = (f16)a0; o[1] = (f16)a1; *(f16x2*)(p0 + (size_t)s * 16384) = o; }
    }
}
struct DenseSched { int G, c, nM, nN, K; const char* Bt;
    __device__ __forceinline__ bool next(int i, g8::Unit& u, const int (&R)[2], const int (&C)[2]) const {
        int pm, pn; if (!g8::dense_order(i * G + c, nM, nN, pm, pn)) return false;
#pragma unroll
        for (int h = 0; h < 2; ++h)
#pragma unroll
            for (int k = 0; k < 2; ++k) u.ao[h][k] = (unsigned)((pm * 256 + h * 128 + R[k]) * K + C[k]) * 2u;
        u.B = Bt + (size_t)pn * 256 * K * 2; u.row0 = pm * 256; u.pn = pn; u.aux = 0; u.full = 1; return true; } };
template <int CTRL> __device__ __forceinline__ float dpp_f(float v) { return __builtin_bit_cast(float, __builtin_amdgcn_update_dpp(0, __builtin_bit_cast(int, v), CTRL, 0xf, 0xf, false)); }
__device__ __forceinline__ float max8(float v) {
    v = fmaxf(v, dpp_f<0xB1>(v)); v = fmaxf(v, dpp_f<0x4E>(v)); return fmaxf(v, dpp_f<0x141>(v)); }
__device__ __forceinline__ void p9_router(Frame& F) {
    const float* X1 = (const float*)(F.ws() + WS_X1); unsigned char* HX2 = (unsigned char*)(F.ws() + WS_HX2);
    const float* g2 = F.in[7]; const float* rbias = F.in[18];
    const f16* RWH = (const f16*)(F.ws() + WS_RWT); const f16* RWL = RWH + NE * DM;
    int* EIDX = (int*)(F.ws() + WS_EIDX); float* EW = (float*)(F.ws() + WS_EW); int* CNT = (int*)(F.ws() + WS_CNT);
    LAS float* RED = (LAS float*)F.lds; LAS float* LOG = (LAS float*)(F.lds + 32768); LAS float* PART = (LAS float*)(F.lds + 36864); LAS int* lcnt = (LAS int*)(F.lds + 37888);
    LAS float* C1 = (LAS float*)(F.lds + 40960); LAS float* C2 = (LAS float*)(F.lds + 49152);
    const int r = F.lane & 15, q = F.lane >> 4, w = F.wave;
    typedef unsigned int v4u_t __attribute__((__vector_size__(16)));
    typedef unsigned int v2u_t __attribute__((__vector_size__(8)));
    const auto rw_rs = __builtin_amdgcn_make_buffer_rsrc((void*)RWH, (short)0, (int)(2 * NE * DM * 2), 0x00020000);
    const auto x_rs = __builtin_amdgcn_make_buffer_rsrc((void*)X1, (short)0, (int)(NTOK * DM * 4), 0x00020000);
    const auto h_rs = __builtin_amdgcn_make_buffer_rsrc((void*)HX2, (short)0, (int)(NTOK * DM), 0x00020000);
    const int rwo = F.lane * 16, rws = w * 32768;
    for (int u = F.vcu; u < 512; u += F.G) {
        if (F.tid < 64) lcnt[F.tid] = 0;
        const int row = u * 16 + r; const int kb = 256 * w + 8 * q;
        const float* mod = (const float*)(F.ws() + WS_MOD) + ((u * 16) >> 12) * 12288;
        const int xo = (row * DM + kb) * 4, ho = row * DM + kb;
        struct KS { f16x8 bh[4], bl[4]; };
#define P9_LOAD(S_, ks_) do { \
            _Pragma("unroll") for (int nt = 0; nt < 4; ++nt) { S_.bh[nt] = __builtin_bit_cast(f16x8, __builtin_amdgcn_raw_buffer_load_b128(rw_rs, rwo, rws + (ks_) * 4096 + nt * 1024, 0)); \
                S_.bl[nt] = __builtin_bit_cast(f16x8, __builtin_amdgcn_raw_buffer_load_b128(rw_rs, rwo, rws + NE * DM * 2 + (ks_) * 4096 + nt * 1024, 0)); } } while (0)
        f32x4 xa[8], xb[8];
#pragma unroll
        for (int ks = 0; ks < 8; ++ks) { xa[ks] = __builtin_bit_cast(f32x4, __builtin_amdgcn_raw_buffer_load_b128(x_rs, xo + 128 * ks, 0, 0)); xb[ks] = __builtin_bit_cast(f32x4, __builtin_amdgcn_raw_buffer_load_b128(x_rs, xo + 128 * ks + 16, 0, 0)); }
        {   const int c = 4 * F.tid; const f32x4 g = *(const f32x4*)(g2 + c), sh = *(const f32x4*)(mod + 3 * 2048 + c), sc = *(const f32x4*)(mod + 4 * 2048 + c);
            *(LAS f32x4*)(C1 + c) = g * (sc + 1.0f); *(LAS f32x4*)(C2 + c) = sh; }
        KS A, B; P9_LOAD(A, 0); P9_LOAD(B, 1);
        float ss = 0.f;
#pragma unroll
        for (int ks = 0; ks < 8; ++ks) ss += (xa[ks].x * xa[ks].x + xa[ks].y * xa[ks].y) + (xa[ks].z * xa[ks].z + xa[ks].w * xa[ks].w) + (xb[ks].x * xb[ks].x + xb[ks].y * xb[ks].y) + (xb[ks].z * xb[ks].z + xb[ks].w * xb[ks].w);
        ss += __shfl_xor(ss, 16); ss += __shfl_xor(ss, 32);
        if (q == 0) PART[w * 16 + r] = ss;
        __syncthreads();
        float tot = 0.f;
#pragma unroll
        for (int ww = 0; ww < 8; ++ww) tot += PART[ww * 16 + r];
        const float rstd = 1.0f / sqrtf(tot * (1.0f / DM) + EPS);
        f32x4 am[4], al[4];
#pragma unroll
        for (int nt = 0; nt < 4; ++nt) { am[nt] = (f32x4){0.f, 0.f, 0.f, 0.f}; al[nt] = am[nt]; }
#define P9_STEP(S_, ks_) do { const int col_ = kb + 32 * (ks_); \
            const f32x4 c1a_ = *(const LAS f32x4*)(C1 + col_), c1b_ = *(const LAS f32x4*)(C1 + col_ + 4), c2a_ = *(const LAS f32x4*)(C2 + col_), c2b_ = *(const LAS f32x4*)(C2 + col_ + 4); \
            const f32x4 ha = (xa[ks_] * rstd) * c1a_ + c2a_, hb = (xb[ks_] * rstd) * c1b_ + c2b_; f16x8 hi, lo; \
            hi[0] = (f16)ha.x; hi[1] = (f16)ha.y; hi[2] = (f16)ha.z; hi[3] = (f16)ha.w; hi[4] = (f16)hb.x; hi[5] = (f16)hb.y; hi[6] = (f16)hb.z; hi[7] = (f16)hb.w; \
            lo[0] = (f16)((ha.x - (float)hi[0]) * 2048.0f); lo[1] = (f16)((ha.y - (float)hi[1]) * 2048.0f); lo[2] = (f16)((ha.z - (float)hi[2]) * 2048.0f); lo[3] = (f16)((ha.w - (float)hi[3]) * 2048.0f); \
            lo[4] = (f16)((hb.x - (float)hi[4]) * 2048.0f); lo[5] = (f16)((hb.y - (float)hi[5]) * 2048.0f); lo[6] = (f16)((hb.z - (float)hi[6]) * 2048.0f); lo[7] = (f16)((hb.w - (float)hi[7]) * 2048.0f); \
            { const f32x4 qa_ = ha * SX8, qb_ = hb * SX8; int d0_ = __builtin_amdgcn_cvt_pk_fp8_f32(qa_.x, qa_.y, 0, false); d0_ = __builtin_amdgcn_cvt_pk_fp8_f32(qa_.z, qa_.w, d0_, true); \
              int d1_ = __builtin_amdgcn_cvt_pk_fp8_f32(qb_.x, qb_.y, 0, false); d1_ = __builtin_amdgcn_cvt_pk_fp8_f32(qb_.z, qb_.w, d1_, true); \
              v2u_t q8_; q8_[0] = (unsigned)d0_; q8_[1] = (unsigned)d1_; __builtin_amdgcn_raw_buffer_store_b64(q8_, h_rs, ho + 32 * (ks_), 0, 0); } \
            _Pragma("unroll") for (int nt = 0; nt < 4; ++nt) { am[nt] = __builtin_amdgcn_mfma_f32_16x16x32_f16(hi, S_.bh[nt], am[nt], 0, 0, 0); al[nt] = __builtin_amdgcn_mfma_f32_16x16x32_f16(lo, S_.bh[nt], al[nt], 0, 0, 0); \
                al[nt] = __builtin_amdgcn_mfma_f32_16x16x32_f16(hi, S_.bl[nt], al[nt], 0, 0, 0); } } while (0)
        P9_STEP(A, 0); FENCE(); P9_LOAD(A, 2); P9_STEP(B, 1); FENCE(); P9_LOAD(B, 3); P9_STEP(A, 2); FENCE(); P9_LOAD(A, 4); P9_STEP(B, 3); FENCE();
        P9_LOAD(B, 5); P9_STEP(A, 4); FENCE(); P9_LOAD(A, 6); P9_STEP(B, 5); FENCE(); P9_LOAD(B, 7); P9_STEP(A, 6); FENCE(); P9_STEP(B, 7); FENCE();
#undef P9_LOAD
#undef P9_STEP
#pragma unroll
        for (int nt = 0; nt < 4; ++nt)
#pragma unroll
            for (int rg = 0; rg < 4; ++rg) RED[(w * 16 + 4 * q + rg) * 64 + 16 * nt + r] = am[nt][rg] + al[nt][rg] * (1.0f / 2048.0f);
        __syncthreads();
#pragma unroll
        for (int o2 = 0; o2 < 2; ++o2) { const int o = F.tid + 512 * o2; float sacc = 0.f;
#pragma unroll
            for (int ww = 0; ww < 8; ++ww) sacc += RED[ww * 1024 + o];
            LOG[o] = sacc; }
        __syncthreads();
#pragma unroll 1
        for (int rr = 0; rr < 2; ++rr) { const int rl = 2 * w + rr, trow = u * 16 + rl;
            const float logit = LOG[rl * 64 + F.lane];
            const float s = 1.0f / (1.0f + expf(-logit)); const float sel = s + rbias[F.lane];
            const float m1 = max8(sel);
            const unsigned long long bm = __ballot(sel == m1); const int gbase = F.lane & ~7; const unsigned gb = (unsigned)(bm >> gbase) & 0xffu; const int first = gbase + __builtin_ctz(gb);
            const float m2 = max8((F.lane == first) ? -INFINITY : sel);
            const float gs = m1 + m2; const int myg = F.lane >> 3; int beat = 0;
#pragma unroll
            for (int g = 0; g < 8; ++g) { const float og = __builtin_bit_cast(float, __builtin_amdgcn_readlane(__builtin_bit_cast(int, gs), g * 8)); beat += (og > gs || (og == gs && g < myg)) ? 1 : 0; }
            const float cand = (beat < 4) ? sel : -INFINITY; int rank = 0;
#pragma unroll 8
            for (int e = 0; e < NE; ++e) { const float oc = __builtin_bit_cast(float, __builtin_amdgcn_readlane(__builtin_bit_cast(int, cand), e)); rank += (oc > cand) ? 1 : 0; }
            unsigned long long mask = __ballot(rank < TOPK && beat < 4);
            if (__builtin_popcountll(mask) != TOPK) { rank = 0;
#pragma unroll 8
                for (int e = 0; e < NE; ++e) { const float oc = __builtin_bit_cast(float, __builtin_amdgcn_readlane(__builtin_bit_cast(int, cand), e)); rank += (oc > cand || (oc == cand && e < F.lane)) ? 1 : 0; }
                mask = __ballot(rank < TOPK && beat < 4); }
            const bool chosen = (mask >> F.lane) & 1ull;
            const int slot = (int)__builtin_amdgcn_mbcnt_hi((unsigned)(mask >> 32), __builtin_amdgcn_mbcnt_lo((unsigned)mask, 0u));
            float wsum = 0.f; { unsigned long long mm = mask;
#pragma unroll
                for (int i = 0; i < TOPK; ++i) { const int l = __builtin_ctzll(mm); mm &= mm - 1ull; wsum += __builtin_bit_cast(float, __builtin_amdgcn_readlane(__builtin_bit_cast(int, s), l)); } }
            if (chosen) { EIDX[trow * 8 + slot] = F.lane; EW[trow * 8 + slot] = s / wsum * 2.5f; __hip_atomic_fetch_add(&lcnt[F.lane], 1, __ATOMIC_RELAXED, __HIP_MEMORY_SCOPE_WORKGROUP); }
        }
        __syncthreads();
        if (F.tid < 64) CNT[u * 64 + F.tid] = lcnt[F.tid];
        __syncthreads();
    }
}
__device__ __forceinline__ void p9_router_pair(Frame& F) {
    const float* X1 = (const float*)(F.ws() + WS_X1); unsigned char* HX2 = (unsigned char*)(F.ws() + WS_HX2);
    const float* g2 = F.in[7]; const float* rbias = F.in[18];
    const f16* RWH = (const f16*)(F.ws() + WS_RWT);
    int* EIDX = (int*)(F.ws() + WS_EIDX); float* EW = (float*)(F.ws() + WS_EW); int* CNT = (int*)(F.ws() + WS_CNT);
    LAS float* RED = (LAS float*)F.lds; LAS float* LOG = (LAS float*)(F.lds + 65536); LAS float* PART = (LAS float*)(F.lds + 73728); LAS int* lcnt = (LAS int*)(F.lds + 74752);
    LAS float* C1 = (LAS float*)(F.lds + 81920);
    const int r = F.lane & 15, q = F.lane >> 4, w = F.wave;
    typedef unsigned int v2u_t __attribute__((__vector_size__(8)));
    const auto rw_rs = __builtin_amdgcn_make_buffer_rsrc((void*)RWH, (short)0, (int)(2 * NE * DM * 2), 0x00020000);
    const auto x_rs = __builtin_amdgcn_make_buffer_rsrc((void*)X1, (short)0, (int)(NTOK * DM * 4), 0x00020000);
    const auto h_rs = __builtin_amdgcn_make_buffer_rsrc((void*)HX2, (short)0, (int)(NTOK * DM), 0x00020000);
    const int rwo = F.lane * 16, rws = w * 32768;
    const int ub0 = F.vcu, ub1 = F.vcu + F.G;
    if (F.tid < 128) lcnt[F.tid] = 0;
    const int kb = 256 * w + 8 * q;
    const int row0 = ub0 * 16 + r, row1 = ub1 * 16 + r;
    const int xo0 = (row0 * DM + kb) * 4, xo1 = (row1 * DM + kb) * 4, ho0 = row0 * DM + kb, ho1 = row1 * DM + kb;
    struct KS { f16x8 bh[4], bl[4]; f32x4 xq[2]; };
#define P9_LOAD(S_, ks_) do { \
        _Pragma("unroll") for (int nt = 0; nt < 4; ++nt) { S_.bh[nt] = __builtin_bit_cast(f16x8, __builtin_amdgcn_raw_buffer_load_b128(rw_rs, rwo, rws + (ks_) * 4096 + nt * 1024, 0)); \
            S_.bl[nt] = __builtin_bit_cast(f16x8, __builtin_amdgcn_raw_buffer_load_b128(rw_rs, rwo, rws + NE * DM * 2 + (ks_) * 4096 + nt * 1024, 0)); } \
        S_.xq[0] = __builtin_bit_cast(f32x4, __builtin_amdgcn_raw_buffer_load_b128(x_rs, xo1 + 128 * (ks_), 0, 0)); S_.xq[1] = __builtin_bit_cast(f32x4, __builtin_amdgcn_raw_buffer_load_b128(x_rs, xo1 + 128 * (ks_) + 16, 0, 0)); } while (0)
    f32x4 xa[8], xb[8]; float ss0 = 0.f, ss1 = 0.f;
#pragma unroll
    for (int ks = 0; ks < 8; ++ks) { xa[ks] = __builtin_bit_cast(f32x4, __builtin_amdgcn_raw_buffer_load_b128(x_rs, xo1 + 128 * ks, 0, 0)); xb[ks] = __builtin_bit_cast(f32x4, __builtin_amdgcn_raw_buffer_load_b128(x_rs, xo1 + 128 * ks + 16, 0, 0)); }
#pragma unroll
    for (int b = 0; b < 2; ++b) { const float* mod = (const float*)(F.ws() + WS_MOD) + (((b ? ub1 : ub0) * 16) >> 12) * 12288; const int c = 4 * F.tid;
        const f32x4 g = *(const f32x4*)(g2 + c), sh = *(const f32x4*)(mod + 3 * 2048 + c), sc = *(const f32x4*)(mod + 4 * 2048 + c);
        *(LAS f32x4*)(C1 + b * 4096 + c) = g * (sc + 1.0f); *(LAS f32x4*)(C1 + b * 4096 + 2048 + c) = sh; }
#pragma unroll
    for (int ks = 0; ks < 8; ++ks) ss1 += (xa[ks].x * xa[ks].x + xa[ks].y * xa[ks].y) + (xa[ks].z * xa[ks].z + xa[ks].w * xa[ks].w) + (xb[ks].x * xb[ks].x + xb[ks].y * xb[ks].y) + (xb[ks].z * xb[ks].z + xb[ks].w * xb[ks].w);
    asm volatile("" : "+v"(ss1));
#pragma unroll
    for (int ks = 0; ks < 8; ++ks) { xa[ks] = __builtin_bit_cast(f32x4, __builtin_amdgcn_raw_buffer_load_b128(x_rs, xo0 + 128 * ks, 0, 2)); xb[ks] = __builtin_bit_cast(f32x4, __builtin_amdgcn_raw_buffer_load_b128(x_rs, xo0 + 128 * ks + 16, 0, 2)); }
    KS A, B; P9_LOAD(A, 0); P9_LOAD(B, 1);
#pragma unroll
    for (int ks = 0; ks < 8; ++ks) ss0 += (xa[ks].x * xa[ks].x + xa[ks].y * xa[ks].y) + (xa[ks].z * xa[ks].z + xa[ks].w * xa[ks].w) + (xb[ks].x * xb[ks].x + xb[ks].y * xb[ks].y) + (xb[ks].z * xb[ks].z + xb[ks].w * xb[ks].w);
    ss0 += __shfl_xor(ss0, 16); ss0 += __shfl_xor(ss0, 32); ss1 += __shfl_xor(ss1, 16); ss1 += __shfl_xor(ss1, 32);
    if (q == 0) { PART[w * 16 + r] = ss0; PART[128 + w * 16 + r] = ss1; }
    __syncthreads();
    float tot0 = 0.f, tot1 = 0.f;
#pragma unroll
    for (int ww = 0; ww < 8; ++ww) { tot0 += PART[ww * 16 + r]; tot1 += PART[128 + ww * 16 + r]; }
    const float rstd0 = 1.0f / sqrtf(tot0 * (1.0f / DM) + EPS), rstd1 = 1.0f / sqrtf(tot1 * (1.0f / DM) + EPS);
    f32x4 am[2][4], al[2][4];
#pragma unroll
    for (int b = 0; b < 2; ++b)
#pragma unroll
        for (int nt = 0; nt < 4; ++nt) { am[b][nt] = (f32x4){0.f, 0.f, 0.f, 0.f}; al[b][nt] = am[b][nt]; }
#define P9_HALF(b_, XA_, XB_, RSTD_, HO_, S_, ks_) do { const int col_ = kb + 32 * (ks_); LAS const float* cb_ = C1 + (b_) * 4096 + col_; \
        const f32x4 c1a_ = *(const LAS f32x4*)(cb_), c1b_ = *(const LAS f32x4*)(cb_ + 4), c2a_ = *(const LAS f32x4*)(cb_ + 2048), c2b_ = *(const LAS f32x4*)(cb_ + 2052); \
        const f32x4 ha = ((XA_) * (RSTD_)) * c1a_ + c2a_, hb = ((XB_) * (RSTD_)) * c1b_ + c2b_; f16x8 hi, lo; \
        hi[0] = (f16)ha.x; hi[1] = (f16)ha.y; hi[2] = (f16)ha.z; hi[3] = (f16)ha.w; hi[4] = (f16)hb.x; hi[5] = (f16)hb.y; hi[6] = (f16)hb.z; hi[7] = (f16)hb.w; \
        lo[0] = (f16)((ha.x - (float)hi[0]) * 2048.0f); lo[1] = (f16)((ha.y - (float)hi[1]) * 2048.0f); lo[2] = (f16)((ha.z - (float)hi[2]) * 2048.0f); lo[3] = (f16)((ha.w - (float)hi[3]) * 2048.0f); \
        lo[4] = (f16)((hb.x - (float)hi[4]) * 2048.0f); lo[5] = (f16)((hb.y - (float)hi[5]) * 2048.0f); lo[6] = (f16)((hb.z - (float)hi[6]) * 2048.0f); lo[7] = (f16)((hb.w - (float)hi[7]) * 2048.0f); \
        { const f32x4 qa_ = ha * SX8, qb_ = hb * SX8; int d0_ = __builtin_amdgcn_cvt_pk_fp8_f32(qa_.x, qa_.y, 0, false); d0_ = __builtin_amdgcn_cvt_pk_fp8_f32(qa_.z, qa_.w, d0_, true); \
          int d1_ = __builtin_amdgcn_cvt_pk_fp8_f32(qb_.x, qb_.y, 0, false); d1_ = __builtin_amdgcn_cvt_pk_fp8_f32(qb_.z, qb_.w, d1_, true); \
          v2u_t q8_; q8_[0] = (unsigned)d0_; q8_[1] = (unsigned)d1_; __builtin_amdgcn_raw_buffer_store_b64(q8_, h_rs, (HO_) + 32 * (ks_), 0, 0); } \
        _Pragma("unroll") for (int nt = 0; nt < 4; ++nt) { am[b_][nt] = __builtin_amdgcn_mfma_f32_16x16x32_f16(hi, S_.bh[nt], am[b_][nt], 0, 0, 0); al[b_][nt] = __builtin_amdgcn_mfma_f32_16x16x32_f16(lo, S_.bh[nt], al[b_][nt], 0, 0, 0); \
            al[b_][nt] = __builtin_amdgcn_mfma_f32_16x16x32_f16(hi, S_.bl[nt], al[b_][nt], 0, 0, 0); } } while (0)
#define P9_STEP(S_, ks_) do { P9_HALF(0, xa[ks_], xb[ks_], rstd0, ho0, S_, ks_); P9_HALF(1, S_.xq[0], S_.xq[1], rstd1, ho1, S_, ks_); } while (0)
    P9_STEP(A, 0); FENCE(); P9_LOAD(A, 2); P9_STEP(B, 1); FENCE(); P9_LOAD(B, 3); P9_STEP(A, 2); FENCE(); P9_LOAD(A, 4); P9_STEP(B, 3); FENCE();
    P9_LOAD(B, 5); P9_STEP(A, 4); FENCE(); P9_LOAD(A, 6); P9_STEP(B, 5); FENCE(); P9_LOAD(B, 7); P9_STEP(A, 6); FENCE(); P9_STEP(B, 7); FENCE();
#undef P9_LOAD
#undef P9_STEP
#undef P9_HALF
#pragma unroll
    for (int b = 0; b < 2; ++b)
#pragma unroll
        for (int nt = 0; nt < 4; ++nt)
#pragma unroll
            for (int rg = 0; rg < 4; ++rg) RED[((w * 2 + b) * 16 + 4 * q + rg) * 64 + 16 * nt + r] = am[b][nt][rg] + al[b][nt][rg] * (1.0f / 2048.0f);
    __syncthreads();
#pragma unroll
    for (int o2 = 0; o2 < 4; ++o2) { const int o = F.tid + 512 * o2; float sacc = 0.f;
#pragma unroll
        for (int ww = 0; ww < 8; ++ww) sacc += RED[ww * 2048 + o];
        LOG[o] = sacc; }
    __syncthreads();
#pragma unroll 1
    for (int rr = 0; rr < 4; ++rr) { const int rl = 4 * w + rr, b = rl >> 4, trow = (b ? ub1 : ub0) * 16 + (rl & 15);
        const float logit = LOG[rl * 64 + F.lane];
        const float s = 1.0f / (1.0f + expf(-logit)); const float sel = s + rbias[F.lane];
        const float m1 = max8(sel);
        const unsigned long long bm = __ballot(sel == m1); const int gbase = F.lane & ~7; const unsigned gb = (unsigned)(bm >> gbase) & 0xffu; const int first = gbase + __builtin_ctz(gb);
        const float m2 = max8((F.lane == first) ? -INFINITY : sel);
        const float gs = m1 + m2; const int myg = F.lane >> 3; int beat = 0;
#pragma unroll
        for (int g = 0; g < 8; ++g) { const float og = __builtin_bit_cast(float, __builtin_amdgcn_readlane(__builtin_bit_cast(int, gs), g * 8)); beat += (og > gs || (og == gs && g < myg)) ? 1 : 0; }
        const float cand = (beat < 4) ? sel : -INFINITY; int rank = 0;
#pragma unroll 8
        for (int e = 0; e < NE; ++e) { const float oc = __builtin_bit_cast(float, __builtin_amdgcn_readlane(__builtin_bit_cast(int, cand), e)); rank += (oc > cand) ? 1 : 0; }
        unsigned long long mask = __ballot(rank < TOPK && beat < 4);
        if (__builtin_popcountll(mask) != TOPK) { rank = 0;
#pragma unroll 8
            for (int e = 0; e < NE; ++e) { const float oc = __builtin_bit_cast(float, __builtin_amdgcn_readlane(__builtin_bit_cast(int, cand), e)); rank += (oc > cand || (oc == cand && e < F.lane)) ? 1 : 0; }
            mask = __ballot(rank < TOPK && beat < 4); }
        const bool chosen = (mask >> F.lane) & 1ull;
        const int slot = (int)__builtin_amdgcn_mbcnt_hi((unsigned)(mask >> 32), __builtin_amdgcn_mbcnt_lo((unsigned)mask, 0u));
        float wsum = 0.f; { unsigned long long mm = mask;
#pragma unroll
            for (int i = 0; i < TOPK; ++i) { const int l = __builtin_ctzll(mm); mm &= mm - 1ull; wsum += __builtin_bit_cast(float, __builtin_amdgcn_readlane(__builtin_bit_cast(int, s), l)); } }
        if (chosen) { EIDX[trow * 8 + slot] = F.lane; EW[trow * 8 + slot] = s / wsum * 2.5f; __hip_atomic_fetch_add(&lcnt[b * 64 + F.lane], 1, __ATOMIC_RELAXED, __HIP_MEMORY_SCOPE_WORKGROUP); }
    }
    __syncthreads();
    if (F.tid < 128) CNT[((F.tid >> 6) ? ub1 : ub0) * 64 + (F.tid & 63)] = lcnt[F.tid];
    __syncthreads();
}
__device__ __forceinline__ void p10_lists(Frame& F) {
    LAS int* pre = (LAS int*)(F.lds);
    LAS int* tot = pre + 128; LAS int* rb = pre + 256; LAS int* lfill = pre + 384;
    const int* CNT = (const int*)(F.ws() + WS_CNT);
    const int* EIDX = (const int*)(F.ws() + WS_EIDX);
    int* TILEE = (int*)(F.ws() + WS_TILEE); int* ROWTOK = (int*)(F.ws() + WS_ROWTOK); int* ROWDST = (int*)(F.ws() + WS_ROWDST);
    const int u1 = F.vcu, u2 = F.vcu + F.G;
    const int myk = (F.tid >> 7) & 1, myu = myk ? u2 : u1; const bool has = F.tid < 256 && myu < 512;
    const int myi = myu * 128 + (F.tid & 127); int mye = 0; if (has) mye = EIDX[myi];
    if (F.tid < 128) lfill[F.tid] = 0;
    {
        LAS int* segs = pre + 512;
        const int e = F.tid & 63, seg = F.tid >> 6; int run = 0, q1 = 0, q2 = 0;
        { int cv[64];
#pragma unroll
            for (int j = 0; j < 64; ++j) cv[j] = CNT[(seg * 64 + j) * 64 + e];
#pragma unroll
            for (int j = 0; j < 64; ++j) { const int uu = seg * 64 + j; if (uu == u1) q1 = run; if (uu == u2) q2 = run; run += cv[j]; } }
        segs[seg * 64 + e] = run; if ((u1 >> 6) == seg) segs[512 + e] = q1; if ((u2 >> 6) == seg) segs[576 + e] = q2;
        __syncthreads();
        if (F.tid < 64) { int r2 = 0, p1 = 0, p2 = 0;
#pragma unroll
            for (int sg = 0; sg < 8; ++sg) { if (sg == (u1 >> 6)) p1 = r2 + segs[512 + e]; if (sg == (u2 >> 6)) p2 = r2 + segs[576 + e]; r2 += segs[sg * 64 + e]; }
            pre[e] = p1; pre[64 + e] = p2; tot[e] = r2;
            const int nt = (r2 + 255) >> 8; int inc = nt;
#pragma unroll
            for (int d = 1; d < 64; d <<= 1) { const int o = __shfl_up(inc, d); if (e >= d) inc += o; }
            const int first = inc - nt, all = __shfl(inc, 63);
            rb[e] = first * 256; if (e == 0) { tot[NE] = NTOK; rb[NE] = all * 256; rb[NE1] = (all + NTOK / 256) * 256; }
            if (F.vcu == 0) { for (int j = 0; j < nt; ++j) { TILEE[first + j] = e; TILEE[512 + first + j] = (j + 1 < nt) ? 256 : (r2 - 256 * j); }
                if (e < NTOK / 256) { TILEE[all + e] = NE; TILEE[512 + all + e] = 256; }
                if (e == 0) TILEE[511] = all + NTOK / 256; } }
    }
    __syncthreads();
    if (has) { const int pos = pre[myk * 64 + mye] + __hip_atomic_fetch_add(&lfill[myk * 64 + mye], 1, __ATOMIC_RELAXED, __HIP_MEMORY_SCOPE_WORKGROUP);
        const int row = rb[mye] + pos; ROWTOK[row] = myi >> 3; ROWDST[(myi >> 3) * NSLOT + (myi & 7)] = row; }
    else if (F.tid >= 256 && F.tid < 288) { const int u = (F.tid & 16) ? u2 : u1; if (u < 512) { const int t = u * 16 + (F.tid & 15); const int row = rb[NE] + t; ROWTOK[row] = t; ROWDST[t * NSLOT + 8] = row; } }
    if (F.vcu < NE1) { const int e = F.vcu; const int lo = rb[e] + tot[e], hi = rb[e + 1]; for (int r = lo + F.tid; r < hi; r += 512) ROWTOK[r] = 0; }
}
struct MoeSched { int G, c, nN, K, gather; const int* TILEE; const int* ROWTOK; const char* Bt; size_t bstride_e;
    LAS const int* tl;
    __device__ __forceinline__ int tile_word(int w) const { return __builtin_amdgcn_readfirstlane(tl[w]); }
    LAS int* rl; int tid; int ulo, uhi;
    __device__ __forceinline__ bool locate(int i, int ntile, int& j, int& pn) const {
        i += ulo; if (i >= uhi) return false;
        const int total = ntile * nN, per = (total + 7) >> 3, x = c & 7, lc = c >> 3, li = i * (G >> 3) + lc;
        if (li >= per) return false; const int idx = x * per + li; if (idx >= total) return false;
        j = idx / nN; pn = idx % nN; return true; }
    __device__ __forceinline__ void fetch_rows(int j, int buf) const {
        const int wv = __builtin_amdgcn_readfirstlane(tid >> 6);
        if (wv < 4) __builtin_amdgcn_global_load_lds((const unsigned*)(ROWTOK + j * 256 + tid), (LAS unsigned*)(rl + buf * 256 + wv * 64), 4, 0, 0); }
    __device__ __forceinline__ bool next(int i, g8::Unit& u, const int (&R)[2], const int (&C)[2]) const {
        const int ntile = tile_word(511); int j, pn; if (!locate(i, ntile, j, pn)) return false;
        const int e = tile_word(j);
        if (gather && i == 0) { fetch_rows(j, 0); asm volatile("s_waitcnt vmcnt(0)" ::: "memory"); __syncthreads(); }
#pragma unroll
        for (int h = 0; h < 2; ++h)
#pragma unroll
            for (int k = 0; k < 2; ++k) { const int src = gather ? rl[(i & 1) * 256 + h * 128 + R[k]] : (j * 256 + h * 128 + R[k]); u.ao[h][k] = (unsigned)(src * K + C[k]) * 2u; }
        if (gather) { int j1, pn1; if (locate(i + 1, ntile, j1, pn1)) fetch_rows(j1, (i + 1) & 1); }
        u.B = Bt + (size_t)e * bstride_e + (size_t)pn * 256 * K * 2; u.row0 = j * 256; u.pn = pn; u.aux = e; u.full = tile_word(512 + j) > 128; return true; } };
struct EpiHid {
    static constexpr bool PERM = true;
    unsigned char* HID;
    struct Pre {}; __device__ __forceinline__ Pre prefetch(const g8::Unit&, int, int) const { return Pre{}; }
    __device__ __forceinline__ void operator()(const f32x4 (&acc)[2][2][4][2], const g8::Unit& u, int wr, int wc, int fr, int fq, const Pre&) const {
        const int row0 = u.row0 + wr * 64 + fr, col0 = u.pn * 128 + wc * 32 + 8 * fq;
#pragma unroll
        for (int ai = 0; ai < 2; ++ai)
#pragma unroll
            for (int m = 0; m < 4; ++m) { constexpr float DS = 1.0f / (SX8 * SW13); const f32x4 a0 = acc[ai][0][m][0] * DS, a1 = acc[ai][0][m][1] * DS, b0 = acc[ai][1][m][0] * (DS * SH8), b1 = acc[ai][1][m][1] * (DS * SH8);
                int d0 = __builtin_amdgcn_cvt_pk_fp8_f32(silu_f(a0[0]) * b0[0], silu_f(a0[1]) * b0[1], 0, false); d0 = __builtin_amdgcn_cvt_pk_fp8_f32(silu_f(a0[2]) * b0[2], silu_f(a0[3]) * b0[3], d0, true);
                int d1 = __builtin_amdgcn_cvt_pk_fp8_f32(silu_f(a1[0]) * b1[0], silu_f(a1[1]) * b1[1], 0, false); d1 = __builtin_amdgcn_cvt_pk_fp8_f32(silu_f(a1[2]) * b1[2], silu_f(a1[3]) * b1[3], d1, true);
                u32x2 w; w.x = (unsigned)d0; w.y = (unsigned)d1;
                *(u32x2*)(HID + (size_t)(row0 + ai * 128 + m * 16) * EH + col0) = w; }
    }
};
constexpr float YS_SCALE = SH8 * SW2;
struct EpiYs {
    static constexpr bool PERM = true;
    unsigned char* YS;
    struct Pre {}; __device__ __forceinline__ Pre prefetch(const g8::Unit&, int, int) const { return Pre{}; }
    __device__ __forceinline__ void operator()(const f32x4 (&acc)[2][2][4][2], const g8::Unit& u, int wr, int wc, int fr, int fq, const Pre&) const {
        unsigned char* base = YS + (size_t)(u.row0 + wr * 64 + fr) * DM + u.pn * 256 + wc * 64 + fq * 16;
#pragma unroll
        for (int ai = 0; ai < 2; ++ai)
#pragma unroll
            for (int m = 0; m < 4; ++m) { u32x4 o;
#pragma unroll
                for (int bj = 0; bj < 2; ++bj) { const f32x4 a0 = acc[ai][bj][m][0], a1 = acc[ai][bj][m][1];
                    int d0 = __builtin_amdgcn_cvt_pk_fp8_f32(a0[0], a0[1], 0, false); d0 = __builtin_amdgcn_cvt_pk_fp8_f32(a0[2], a0[3], d0, true);
                    int d1 = __builtin_amdgcn_cvt_pk_fp8_f32(a1[0], a1[1], 0, false); d1 = __builtin_amdgcn_cvt_pk_fp8_f32(a1[2], a1[3], d1, true);
                    if (bj == 0) { o.x = (unsigned)d0; o.y = (unsigned)d1; } else { o.z = (unsigned)d0; o.w = (unsigned)d1; } }
                *(u32x4*)(base + (size_t)(ai * 128 + m * 16) * DM) = o; }
    }
};
__device__ __forceinline__ void p13_combine(Frame& F) {
    const int gw = F.vcu * NWAVES + F.wave, NGW = F.G * NWAVES;
    const float* X1 = (const float*)(F.ws() + WS_X1); const unsigned char* YS = (const unsigned char*)(F.ws() + WS_YS); const float* fg = F.in[25]; float* outp = F.out();
    const int* INV = (const int*)(F.ws() + WS_ROWDST); const float* EW = (const float*)(F.ws() + WS_EW);
    const unsigned char* yb = YS + 16 * F.lane;
    const int nc0 = 256 * (F.lane >> 4) + 32 * ((F.lane >> 2) & 3) + 8 * (F.lane & 3);
    float nwt = (F.lane < 8 && gw < NTOK) ? EW[gw * 8 + F.lane] : 1.0f;
    int ninv = (F.lane < NSLOT && gw < NTOK) ? INV[gw * NSLOT + F.lane] : 0;
    f32x4 fgv[2][2][2], g2v[2][2][2]; int curb = -1;
#pragma unroll
    for (int j = 0; j < 2; ++j)
#pragma unroll
        for (int g = 0; g < 2; ++g) { const int col = nc0 + 1024 * j + 128 * g; fgv[j][g][0] = *(const f32x4*)(fg + col); fgv[j][g][1] = *(const f32x4*)(fg + col + 4); }
    for (int row = gw; row < NTOK; row += NGW) {
        if ((row >> 12) != curb) { curb = row >> 12; const float* g2 = (const float*)(F.ws() + WS_MOD) + curb * 12288 + 5 * 2048;
#pragma unroll
            for (int j = 0; j < 2; ++j)
#pragma unroll
                for (int g = 0; g < 2; ++g) { const int col = nc0 + 1024 * j + 128 * g; g2v[j][g][0] = *(const f32x4*)(g2 + col) * (1.0f / YS_SCALE); g2v[j][g][1] = *(const f32x4*)(g2 + col + 4) * (1.0f / YS_SCALE); } }
        const float* xrow = X1 + (size_t)row * DM + nc0;
        const int myinv = ninv; const float mywt = nwt; { const int nrow = row + NGW; ninv = (F.lane < NSLOT && nrow < NTOK) ? INV[nrow * NSLOT + F.lane] : 0; nwt = (F.lane < 8 && nrow < NTOK) ? EW[nrow * 8 + F.lane] : 1.0f; }
        f32x4 a[2][2][2];
#pragma unroll
        for (int j = 0; j < 2; ++j)
#pragma unroll
            for (int g = 0; g < 2; ++g) { a[j][g][0] = (f32x4){0.f, 0.f, 0.f, 0.f}; a[j][g][1] = a[j][g][0]; }
        u32x4 y[3][2];
#define P13_LOAD(buf_, sl_) do { const int r_ = __builtin_amdgcn_readlane(myinv, (sl_)); \
            _Pragma("unroll") for (int j = 0; j < 2; ++j) y[buf_][j] = __builtin_nontemporal_load((const u32x4*)(yb + (size_t)r_ * DM + 1024 * j)); } while (0)
        P13_LOAD(0, 0); P13_LOAD(1, 1); P13_LOAD(2, 2);
        f32x4 xv[2][2][2];
#pragma unroll
        for (int j = 0; j < 2; ++j)
#pragma unroll
            for (int g = 0; g < 2; ++g) { xv[j][g][0] = __builtin_nontemporal_load((const f32x4*)(xrow + 1024 * j + 128 * g)); xv[j][g][1] = __builtin_nontemporal_load((const f32x4*)(xrow + 1024 * j + 128 * g + 4)); }
        FENCE();
#pragma unroll
        for (int sl = 0; sl < NSLOT; ++sl) {
            const float ws_ = __builtin_bit_cast(float, __builtin_amdgcn_readlane(__builtin_bit_cast(int, mywt), sl));
#pragma unroll
            for (int j = 0; j < 2; ++j) { const u32x4 yy = y[sl % 3][j];
#pragma unroll
                for (int g = 0; g < 2; ++g) { const int d0 = (int)(g ? yy.z : yy.x), d1 = (int)(g ? yy.w : yy.y);
                    const f32x2 p0 = __builtin_amdgcn_cvt_pk_f32_fp8(d0, false), p1 = __builtin_amdgcn_cvt_pk_f32_fp8(d0, true), p2 = __builtin_amdgcn_cvt_pk_f32_fp8(d1, false), p3 = __builtin_amdgcn_cvt_pk_f32_fp8(d1, true);
                    a[j][g][0].x += ws_ * p0.x; a[j][g][0].y += ws_ * p0.y; a[j][g][0].z += ws_ * p1.x; a[j][g][0].w += ws_ * p1.y; a[j][g][1].x += ws_ * p2.x; a[j][g][1].y += ws_ * p2.y; a[j][g][1].z += ws_ * p3.x; a[j][g][1].w += ws_ * p3.y;
                    asm volatile("" : "+v"(a[j][g][0]), "+v"(a[j][g][1])); } }
            FENCE();
            if (sl + 3 < NSLOT) { P13_LOAD(sl % 3, sl + 3); FENCE(); } }
#undef P13_LOAD
        float ss = 0.f; f32x4 v[2][2][2];
#pragma unroll
        for (int j = 0; j < 2; ++j)
#pragma unroll
            for (int g = 0; g < 2; ++g) { const int col = nc0 + 1024 * j + 128 * g;
                v[j][g][0] = xv[j][g][0] + g2v[j][g][0] * a[j][g][0]; v[j][g][1] = xv[j][g][1] + g2v[j][g][1] * a[j][g][1];
#pragma unroll
                for (int k = 0; k < 2; ++k) { const f32x4 t = v[j][g][k]; ss += (t.x * t.x + t.y * t.y) + (t.z * t.z + t.w * t.w); } }
        const float rstd = 1.0f / sqrtf(wave_sum(ss) * (1.0f / DM) + EPS);
#pragma unroll
        for (int j = 0; j < 2; ++j)
#pragma unroll
            for (int g = 0; g < 2; ++g) { const int col = nc0 + 1024 * j + 128 * g;
                __builtin_nontemporal_store(v[j][g][0] * rstd * fgv[j][g][0], (f32x4*)(outp + (size_t)row * DM + col)); __builtin_nontemporal_store(v[j][g][1] * rstd * fgv[j][g][1], (f32x4*)(outp + (size_t)row * DM + col + 4)); }
    }
}

struct Args { const float* in[26]; float* out; unsigned char* ws; int ph_lo, ph_hi, li, pad; };
__global__ void __launch_bounds__(NWAVES * 64, 2) fwd(Args args) {
    extern __shared__ __attribute__((aligned(16))) unsigned char lds[];
    Frame F;
    F.lds = (LAS unsigned char*)lds;
    F.tid = threadIdx.x; F.lane = F.tid & 63; F.wave = __builtin_amdgcn_readfirstlane(F.tid >> 6);
    F.G = gridDim.x; { const int bx = blockIdx.x; F.vcu = (bx & 7) * (F.G >> 3) + (bx >> 3); }
    F.in.base = (LAS const unsigned*)(F.lds + LDSCTL_OFF + 512);
    {
        const unsigned* ka = (const unsigned*)__builtin_amdgcn_kernarg_segment_ptr();
        if (F.tid < 128) ((LAS unsigned*)(F.lds + LDSCTL_OFF))[F.tid] = 0u;
        if (F.tid >= 128 && F.tid < 128 + 60) ((LAS unsigned*)(F.lds + LDSCTL_OFF + 512))[F.tid - 128] = ka[F.tid - 128];
    }
    __syncthreads();
    const int ph_lo = (int)__builtin_amdgcn_readfirstlane(((LAS const unsigned*)(F.lds + LDSCTL_OFF + 512))[56]), ph_hi = (int)__builtin_amdgcn_readfirstlane(((LAS const unsigned*)(F.lds + LDSCTL_OFF + 512))[57]);
    if (MK_N_LAUNCHES == 1) xcd_barrier_post((unsigned*)(F.ws() + WS_CTL) + CW_BAR);
    const int lo = ph_lo, hi = ph_hi;
#define REFRESH() do { int t_ = threadIdx.x; asm volatile("" : "+v"(t_)); F.tid = t_; F.lane = t_ & 63; F.wave = __builtin_amdgcn_readfirstlane(t_ >> 6); } while (0)
#define IN(k) (lo <= (k) && (k) < hi)
#define SEAM(k) do { if (IN(k) && IN((k) + 1)) { XcdBarrier bar_; bar_.bar = (unsigned*)(F.ws() + WS_CTL) + CW_BAR; bar_.st = (volatile LAS unsigned*)((LAS unsigned char*)lds + MISC_OFF) + 8; xcd_barrier(bar_); } } while (0)
    const int cblk = (int)blockIdx.x;
    if (IN(0)) for (int rep_ = 0; rep_ <= ((PROBE_DUP >> 0) & 1); ++rep_) { if (rep_) __syncthreads(); REFRESH(); p0_prologue(F); } SEAM(0);
    if (IN(1)) for (int rep_ = 0; rep_ <= ((PROBE_DUP >> 1) & 1); ++rep_) { if (rep_) __syncthreads(); REFRESH(); p1_norm(F); } SEAM(1);
    if (IN(2)) for (int rep_ = 0; rep_ <= ((PROBE_DUP >> 2) & 1); ++rep_) { if (rep_) __syncthreads(); REFRESH(); InSched S{F.G, cblk, (const char*)(F.ws() + WS_WINT), 0, 1000};
        EpiIn E{(f16*)(F.ws() + WS_PBUF), (f16*)(F.ws() + WS_CK), (f16*)(F.ws() + WS_CV), (float*)(F.ws() + WS_VSTAT), (const float*)(F.ws() + WS_ROPE)};
        const int grp = (cblk >> 3) & 3;
        for (int part = 0; part < 2; ++part) {
            S.ulo = part ? grp : 0; S.uhi = part ? 1000 : grp;
            if (S.uhi > S.ulo) g8::gemm_phase<EpiIn, InSched, true>(F.lds + RING_OFF, (const char*)(F.ws() + WS_HX), DM, S, E);
            if (part == 0) { __syncthreads(); REFRESH(); if (F.vcu < 64) { p2_ctx_unit(F, F.vcu); __syncthreads(); } p2_expert_copies(F); __syncthreads(); } } } SEAM(2);
    if (IN(4)) for (int rep_ = 0; rep_ <= ((PROBE_DUP >> 4) & 1); ++rep_) { if (rep_) __syncthreads(); REFRESH(); p4_fast(F); } SEAM(4);
    if (IN(5)) for (int rep_ = 0; rep_ <= ((PROBE_DUP >> 5) & 1); ++rep_) { if (rep_) __syncthreads(); REFRESH(); p5_naive(F); } SEAM(5);
    if (IN(6)) for (int rep_ = 0; rep_ <= ((PROBE_DUP >> 6) & 1); ++rep_) { if (rep_) __syncthreads(); REFRESH(); p6_fast(F); } SEAM(6);
    if (IN(8)) for (int rep_ = 0; rep_ <= ((PROBE_DUP >> 8) & 1); ++rep_) { if (rep_) __syncthreads(); REFRESH(); DenseSched S{F.G, cblk, 32, 8, DM, (const char*)(F.ws() + WS_WOUTT)}; EpiX1 E{F.in[0], (const float*)(F.ws() + WS_MOD), (float*)(F.ws() + WS_X1)};
        g8::gemm_phase<EpiX1, DenseSched, true>(F.lds + RING_OFF, (const char*)(F.ws() + WS_AR), DM, S, E); } SEAM(8);
    if (IN(9)) for (int rep_ = 0; rep_ <= ((PROBE_DUP >> 9) & 1); ++rep_) { if (rep_) __syncthreads(); REFRESH(); if (F.G == 256) p9_router_pair(F); else p9_router(F); } SEAM(9);
    if (IN(10)) for (int rep_ = 0; rep_ <= ((PROBE_DUP >> 10) & 1); ++rep_) { if (rep_) __syncthreads(); REFRESH(); p10_lists(F); } SEAM(10);
    if (IN(11)) for (int rep_ = 0; rep_ <= ((PROBE_DUP >> 11) & 1); ++rep_) { if (rep_) __syncthreads(); REFRESH(); MoeSched S{F.G, cblk, 4, DM / 2, 1, (const int*)(F.ws() + WS_TILEE), (const int*)(F.ws() + WS_ROWTOK), (const char*)(F.ws() + WS_W13T), (size_t)1024 * DM, (LAS const int*)(F.lds + TILE_LDS), (LAS int*)(F.lds + TILE_LDS + 4096), F.tid, 0, 1000};
        { LAS int* tl_ = (LAS int*)(F.lds + TILE_LDS); tl_[F.tid] = S.TILEE[F.tid]; tl_[F.tid + 512] = S.TILEE[F.tid + 512]; __syncthreads(); }
        EpiHid E{(unsigned char*)(F.ws() + WS_HID)};
        const int grp = (cblk >> 3) & 3;
        for (int part = 0; part < 2; ++part) {
            S.ulo = part ? grp : 0; S.uhi = part ? 1000 : grp;
            if (S.uhi > S.ulo) g8::gemm_phase<EpiHid, MoeSched, true, true>(F.lds + RING_OFF, (const char*)(F.ws() + WS_HX2), DM / 2, S, E);
            if (part == 0) { __syncthreads(); REFRESH(); p11_expert_copies(F, S.tile_word(511)); __syncthreads(); } } } SEAM(11);
    if (IN(12)) for (int rep_ = 0; rep_ <= ((PROBE_DUP >> 12) & 1); ++rep_) { if (rep_) __syncthreads(); REFRESH(); MoeSched S{F.G, cblk, 8, EH / 2, 0, (const int*)(F.ws() + WS_TILEE), (const int*)(F.ws() + WS_ROWTOK), (const char*)(F.ws() + WS_W2T), (size_t)DM * EH, (LAS const int*)(F.lds + TILE_LDS), (LAS int*)(F.lds + TILE_LDS + 4096), F.tid, 0, 1000};
        { LAS int* tl_ = (LAS int*)(F.lds + TILE_LDS); tl_[F.tid] = S.TILEE[F.tid]; tl_[F.tid + 512] = S.TILEE[F.tid + 512]; __syncthreads(); }
        EpiYs E{(unsigned char*)(F.ws() + WS_YS)};
        g8::gemm_phase<EpiYs, MoeSched, true, true>(F.lds + RING_OFF, (const char*)(F.ws() + WS_HID), EH / 2, S, E); } SEAM(12);
    if (IN(13)) for (int rep_ = 0; rep_ <= ((PROBE_DUP >> 13) & 1); ++rep_) { if (rep_) __syncthreads(); REFRESH(); p13_combine(F); }
#undef IN
#undef SEAM
}

extern "C" void kernel_launch(void* const* d_in, const int* in_sizes, int n_in, void* d_out, int out_size, void* d_ws, size_t ws_size, hipStream_t stream) {
    static int grid = 0;
    if (grid == 0) {
        if (n_in != 26 || in_sizes[0] != NTOK * DM || out_size != NTOK * DM || ws_size < WS_END) {
            fprintf(stderr, "kernel_launch: unexpected problem (n_in %d, in0 %d, out %d, ws %zu); nothing launched\n", n_in, n_in > 0 ? in_sizes[0] : -1, out_size, ws_size); grid = -1; return; }
        int dev = 0, cus = 0, per_cu = 0;
        if (hipGetDevice(&dev) != hipSuccess || hipDeviceGetAttribute(&cus, hipDeviceAttributeMultiprocessorCount, dev) != hipSuccess) { grid = -1; return; }
        if (hipFuncSetAttribute((const void*)fwd, hipFuncAttributeMaxDynamicSharedMemorySize, LDS_BYTES) != hipSuccess) { fprintf(stderr, "kernel_launch: hipFuncSetAttribute failed\n"); grid = -1; return; }
        if (hipOccupancyMaxActiveBlocksPerMultiprocessor(&per_cu, (const void*)fwd, NWAVES * 64, LDS_BYTES) != hipSuccess || per_cu < 1)
            fprintf(stderr, "kernel_launch: occupancy query reports %d workgroups per CU\n", per_cu);
        (void)hipGetLastError();
        grid = cus & ~7;
    }
    if (grid < 0) return;
    if (hipMemsetAsync((char*)d_ws + WS_CTL, 0, CTL_ZERO_BYTES, stream) != hipSuccess) return;
    Args a{};
    for (int i = 0; i < 26; ++i) a.in[i] = (const float*)d_in[i];
    a.out = (float*)d_out; a.ws = (unsigned char*)d_ws;
    if (MK_N_LAUNCHES == 1) { a.ph_lo = 0; a.ph_hi = NPHASE; a.li = 0; hipLaunchKernelGGL(fwd, dim3(grid), dim3(NWAVES * 64), LDS_BYTES, stream, a); }
    else { for (int li = 0; li < NPHASE; ++li) { a.ph_lo = li; a.ph_hi = li + 1; a.li = li; hipLaunchKernelGGL(fwd, dim3(grid), dim3(NWAVES * 64), LDS_BYTES, stream, a); } }
}
```
